# Optimizing an MI355X kernel written in HIP

```python
import jax, jax.numpy as jnp
from jax import lax
import numpy as np

D_MODEL = 1024
BATCH = 16
SEQ = 2048
DEPTH = 2

GRID_W = 64
CTX_LEN = 256
EPS = 1e-6
RET_HEADS = 4
RET_DK = 64
RET_DV = 128
RET_CHUNK = 128
RET_DECAY_EXP = (5.0, 7.0, 9.0, 11.0)
RET_ROPE_BASE = 10000.0
POOL_GROUPS = 4
POOL_GW = 128
POOL_WINDOWS = (2, 4, 8, 16)
ATT_HEADS = 8
ATT_KV_HEADS = 2
ATT_HD = 64
ATT_WINDOW = 128
ATT_BLOCK = 128
ROPE_BASE = 10000.0
MLP_HIDDEN = 4 * D_MODEL
N_BRANCH = 3

RET_QK_W = RET_HEADS * RET_DK
RET_V_W = RET_HEADS * RET_DV
ATT_Q_W = ATT_HEADS * ATT_HD
ATT_KV_W = ATT_KV_HEADS * ATT_HD
POOL_W = POOL_GROUPS * POOL_GW
CTX_SIDE_SIZES = (RET_QK_W, RET_V_W, ATT_KV_W, ATT_KV_W)
QUERY_SIDE_SIZES = (RET_QK_W, RET_V_W, ATT_Q_W, POOL_W, N_BRANCH * D_MODEL)
IN_SIZES = CTX_SIDE_SIZES + QUERY_SIDE_SIZES
CTX_SIDE_COLS = sum(CTX_SIDE_SIZES)
IN_COLS = sum(IN_SIZES)

kernel_name = 'hybrid_retention_pool_swa_dit_block'

F32 = jnp.float32


def rmsnorm(x, w=None):
    xf = x.astype(F32)
    y = xf * lax.rsqrt(jnp.mean(xf * xf, axis=-1, keepdims=True) + EPS)
    if w is not None:
        y = y * w.astype(F32)
    return y.astype(x.dtype)


def modulate(h, shift, scale):
    return h * (1 + scale) + shift


def split_cols(z, sizes):
    out, start = [], 0
    for s in sizes:
        out.append(z[..., start:start + s])
        start += s
    return out


def heads(t, n):
    return t.reshape(t.shape[0], t.shape[1], n, -1)


def rope(x, pos, base):
    half = x.shape[-1] // 2
    freq = base ** (-jnp.arange(half, dtype=F32) / half)
    ang = pos.astype(F32)[:, None] * freq[None, :]
    cos, sin = jnp.cos(ang)[:, None, :], jnp.sin(ang)[:, None, :]
    x1, x2 = x[..., :half].astype(F32), x[..., half:].astype(F32)
    return jnp.concatenate([x1 * cos - x2 * sin, x1 * sin + x2 * cos], axis=-1).astype(x.dtype)


def axial_rope(x, row, col):
    h = x.shape[-1] // 2
    return jnp.concatenate([rope(x[..., :h], row, ROPE_BASE), rope(x[..., h:], col, ROPE_BASE)], axis=-1)


def retention_scan(q, k, v, log_gamma, r0):
    B, L, H, dk = q.shape
    dv = v.shape[-1]
    C = RET_CHUNK
    n = L // C
    qc = q.reshape(B, n, C, H, dk)
    kc = k.reshape(B, n, C, H, dk)
    vc = v.reshape(B, n, C, H, dv)
    idx = jnp.arange(C, dtype=F32)
    rel = idx[:, None] - idx[None, :]
    decay = jnp.where(rel[None] >= 0, jnp.exp(jnp.maximum(rel, 0.0)[None] * log_gamma[:, None, None]), 0.0).astype(q.dtype)
    scores = jnp.einsum('bnihd,bnjhd->bnhij', qc, kc) * decay
    y_inner = jnp.einsum('bnhij,bnjhe->bnihe', scores, vc)
    zeta = jnp.exp((C - 1 - idx)[:, None] * log_gamma[None, :]).astype(q.dtype)
    u = jnp.einsum('bnjhd,jh,bnjhe->nbhde', kc, zeta, vc)
    chunk_decay = jnp.exp(C * log_gamma).astype(q.dtype)[:, None, None]

    def step(r, u_i):
        return chunk_decay * r + u_i, r

    r_final, r_prev = lax.scan(step, r0, u)
    xi = jnp.exp((idx + 1)[:, None] * log_gamma[None, :]).astype(q.dtype)
    y_cross = jnp.einsum('bnihd,ih,nbhde->bnihe', qc, xi, r_prev)
    return (y_inner + y_cross).reshape(B, L, H, dv), r_final


def retention_final_state(k, v, log_gamma):
    L = k.shape[1]
    w = jnp.exp((L - 1 - jnp.arange(L, dtype=F32))[:, None] * log_gamma[None, :]).astype(k.dtype)
    return jnp.einsum('blhd,lh,blhe->bhde', k, w, v)


def bidir_retention(q, k, v, log_gamma, r0_f, r0_b):
    y_f, r_f = retention_scan(q, k, v, log_gamma[0], r0_f)
    y_b, r_b = retention_scan(q[:, ::-1], k[:, ::-1], v[:, ::-1], log_gamma[1], r0_b)
    return y_f + y_b[:, ::-1], r_f, r_b


def retention_output(y, g):
    B, L = y.shape[:2]
    return jax.nn.silu(g) * rmsnorm(y).reshape(B, L, RET_V_W)


def multiscale_pool(u, w_grp, scale):
    B, L, _ = u.shape
    ug = u.reshape(B, L, POOL_GROUPS, POOL_GW)
    cs = jnp.cumsum(ug.astype(F32), axis=1)
    cs = jnp.concatenate([jnp.zeros_like(cs[:, :1]), cs], axis=1)
    t = jnp.arange(L)
    means = []
    for g, w in enumerate(POOL_WINDOWS):
        lo = jnp.clip(t - w // 2, 0, L)
        hi = jnp.clip(t + w // 2, 0, L)
        csg = cs[:, :, g]
        means.append((csg[:, hi] - csg[:, lo]) / (hi - lo).astype(F32)[:, None])
    pooled = jnp.stack(means, axis=2).astype(u.dtype)
    mixed = jnp.einsum('blgc,gcd->blgd', pooled - ug, w_grp)
    return mixed.reshape(B, L, POOL_W) * scale


def softmax_with_sink(logits, sink):
    lf = logits.astype(F32)
    s = jnp.broadcast_to(sink.astype(F32).reshape(ATT_KV_HEADS, -1, 1, 1), lf.shape[:-1] + (1,))
    p = jax.nn.softmax(jnp.concatenate([lf, s], axis=-1), axis=-1)
    return p[..., :-1]


def context_attention(q, k, v, sink):
    B, L, H, dh = q.shape
    G = H // ATT_KV_HEADS
    qg = q.reshape(B, L, ATT_KV_HEADS, G, dh)
    s = jnp.einsum('bikgd,bjkd->bkgij', qg, k) * dh ** -0.5
    p = softmax_with_sink(s, sink).astype(v.dtype)
    return jnp.einsum('bkgij,bjkd->bikgd', p, v).reshape(B, L, H * dh)


def windowed_attention(q, k, v, kc, vc, sink):
    B, S, H, dh = q.shape
    nb = S // ATT_BLOCK
    G = H // ATT_KV_HEADS
    scale = dh ** -0.5
    qb = q.reshape(B, nb, ATT_BLOCK, ATT_KV_HEADS, G, dh)

    def band(t):
        tb = t.reshape(B, nb, ATT_BLOCK, ATT_KV_HEADS, dh)
        tp = jnp.pad(tb, ((0, 0), (1, 1), (0, 0), (0, 0), (0, 0)))
        return jnp.concatenate([tp[:, :-2], tp[:, 1:-1], tp[:, 2:]], axis=2)

    kb, vb = band(k), band(v)
    blk = jnp.arange(nb)[:, None]
    qpos = blk * ATT_BLOCK + jnp.arange(ATT_BLOCK)[None, :]
    kpos = (blk - 1) * ATT_BLOCK + jnp.arange(3 * ATT_BLOCK)[None, :]
    valid = ((jnp.abs(qpos[:, :, None] - kpos[:, None, :]) <= ATT_WINDOW)
             & (kpos[:, None, :] >= 0) & (kpos[:, None, :] < S))
    s_loc = jnp.einsum('bnikgd,bnjkd->bnkgij', qb, kb) * scale
    s_loc = jnp.where(valid[None, :, None, None], s_loc, -jnp.inf)
    s_ctx = jnp.einsum('bnikgd,bjkd->bnkgij', qb, kc) * scale
    p = softmax_with_sink(jnp.concatenate([s_loc, s_ctx], axis=-1), sink).astype(v.dtype)
    nl = 3 * ATT_BLOCK
    o = (jnp.einsum('bnkgij,bnjkd->bnikgd', p[..., :nl], vb)
         + jnp.einsum('bnkgij,bjkd->bnikgd', p[..., nl:], vc))
    return o.reshape(B, S, H * dh)


def merge_branches(y_ret, y_pool, y_att, gates, w_ret_out, w_pool_out, w_attn_out, w_out):
    g_r, g_p, g_a = split_cols(jax.nn.sigmoid(gates), (D_MODEL,) * N_BRANCH)
    y = g_r * (y_ret @ w_ret_out) + g_p * (y_pool @ w_pool_out) + g_a * (y_att @ w_attn_out)
    return y @ w_out


def sq_relu_mlp(h, w1, w2):
    return jnp.square(jax.nn.relu(h @ w1)) @ w2


def setup_inputs(seed: int = 0) -> dict:
    key = jax.random.key(seed)
    ks = jax.random.split(key, 21)

    def nrm(k, shape, fan_in):
        return jax.random.normal(k, shape, F32) * fan_in ** -0.5

    def near_one(k, shape):
        return 1.0 + 0.02 * jax.random.normal(k, shape, F32)

    return {
        'x': jax.random.normal(ks[0], (BATCH, SEQ, D_MODEL), F32),
        'c': jax.random.normal(ks[1], (BATCH, D_MODEL), F32),
        'ctx': jax.random.normal(ks[2], (BATCH, CTX_LEN, D_MODEL), F32),
        'c_ctx': jax.random.normal(ks[3], (D_MODEL,), F32),
        'norm1_w': near_one(ks[4], (DEPTH, D_MODEL)),
        'norm2_w': near_one(ks[5], (DEPTH, D_MODEL)),
        'ada_w': nrm(ks[6], (DEPTH, D_MODEL, 6 * D_MODEL), D_MODEL),
        'ada_b': 0.02 * jax.random.normal(ks[7], (DEPTH, 6 * D_MODEL), F32),
        'w_in': nrm(ks[8], (DEPTH, D_MODEL, IN_COLS), D_MODEL),
        'ret_decay': jnp.asarray(RET_DECAY_EXP, F32)[None, None, :]
                     + 0.1 * jax.random.normal(ks[9], (DEPTH, 2, RET_HEADS), F32),
        'pool_w': nrm(ks[10], (DEPTH, POOL_GROUPS, POOL_GW, POOL_GW), POOL_GW),
        'pool_scale': near_one(ks[11], (DEPTH, POOL_W)),
        'q_norm_w': near_one(ks[12], (DEPTH, ATT_HD)),
        'k_norm_w': near_one(ks[13], (DEPTH, ATT_HD)),
        'attn_sink': 0.5 * jax.random.normal(ks[14], (DEPTH, ATT_HEADS), F32),
        'w_ret_out': nrm(ks[15], (DEPTH, RET_V_W, D_MODEL), RET_V_W),
        'w_pool_out': nrm(ks[16], (DEPTH, POOL_W, D_MODEL), POOL_W),
        'w_attn_out': nrm(ks[17], (DEPTH, ATT_Q_W, D_MODEL), ATT_Q_W),
        'w_out': nrm(ks[18], (DEPTH, D_MODEL, D_MODEL), D_MODEL),
        'w_mlp1': nrm(ks[19], (DEPTH, D_MODEL, MLP_HIDDEN), D_MODEL),
        'w_mlp2': nrm(ks[20], (DEPTH, MLP_HIDDEN, D_MODEL), MLP_HIDDEN),
    }


def reference(x, c, ctx, c_ctx, norm1_w, norm2_w, ada_w, ada_b, w_in, ret_decay, pool_w, pool_scale,
              q_norm_w, k_norm_w, attn_sink, w_ret_out, w_pool_out, w_attn_out, w_out, w_mlp1, w_mlp2):
    B, S, _ = x.shape
    ROWS = S // GRID_W
    row = jnp.repeat(jnp.arange(ROWS), GRID_W)
    col = jnp.tile(jnp.arange(GRID_W), ROWS)
    seq_pos = jnp.arange(S)
    xc = ctx
    for l in range(DEPTH):
        last = l == DEPTH - 1
        log_gamma = jnp.log1p(-jnp.exp2(-ret_decay[l].astype(F32)))
        mod_x = jax.nn.silu(c) @ ada_w[l] + ada_b[l]
        sh1, sc1, g1, sh2, sc2, g2 = [m[:, None, :] for m in split_cols(mod_x, (D_MODEL,) * 6)]
        mod_c = jax.nn.silu(c_ctx) @ ada_w[l] + ada_b[l]
        csh1, csc1, cg1, csh2, csc2, cg2 = split_cols(mod_c, (D_MODEL,) * 6)

        uc = modulate(rmsnorm(xc, norm1_w[l]), csh1, csc1)
        if last:
            rk_c, rv_c, ak_c, av_c = split_cols(uc @ w_in[l][:, :CTX_SIDE_COLS], CTX_SIDE_SIZES)
        else:
            rk_c, rv_c, ak_c, av_c, rq_c, rg_c, aq_c, pu_c, gt_c = split_cols(uc @ w_in[l], IN_SIZES)
        rk_c = heads(rk_c, RET_HEADS) * RET_DK ** -0.5
        rv_c = heads(rv_c, RET_HEADS)
        ak_c = rmsnorm(heads(ak_c, ATT_KV_HEADS), k_norm_w[l])
        av_c = heads(av_c, ATT_KV_HEADS)
        if last:
            r_f = retention_final_state(rk_c, rv_c, log_gamma[0])
            r_b = retention_final_state(rk_c[:, ::-1], rv_c[:, ::-1], log_gamma[1])
        else:
            zero = jnp.zeros((B, RET_HEADS, RET_DK, RET_DV), rv_c.dtype)
            yr_c, r_f, r_b = bidir_retention(heads(rq_c, RET_HEADS), rk_c, rv_c, log_gamma, zero, zero)
            ya_c = context_attention(rmsnorm(heads(aq_c, ATT_HEADS), q_norm_w[l]), ak_c, av_c, attn_sink[l])
            yp_c = multiscale_pool(pu_c, pool_w[l], pool_scale[l])
            mix_c = merge_branches(retention_output(yr_c, rg_c), yp_c, ya_c, gt_c,
                                   w_ret_out[l], w_pool_out[l], w_attn_out[l], w_out[l])

        ux = modulate(rmsnorm(x, norm1_w[l]), sh1, sc1)
        rk, rv, ak, av, rq, rg, aq, pu, gt = split_cols(ux @ w_in[l], IN_SIZES)
        rq = rope(heads(rq, RET_HEADS), seq_pos, RET_ROPE_BASE)
        rk = rope(heads(rk, RET_HEADS), seq_pos, RET_ROPE_BASE) * RET_DK ** -0.5
        yr, _, _ = bidir_retention(rq, rk, heads(rv, RET_HEADS), log_gamma, r_f, r_b)
        aq = axial_rope(rmsnorm(heads(aq, ATT_HEADS), q_norm_w[l]), row, col)
        ak = axial_rope(rmsnorm(heads(ak, ATT_KV_HEADS), k_norm_w[l]), row, col)
        ya = windowed_attention(aq, ak, heads(av, ATT_KV_HEADS), ak_c, av_c, attn_sink[l])
        yp = multiscale_pool(pu, pool_w[l], pool_scale[l])
        mix = merge_branches(retention_output(yr, rg), yp, ya, gt,
                             w_ret_out[l], w_pool_out[l], w_attn_out[l], w_out[l])
        x = x + g1 * mix
        x = x + g2 * sq_relu_mlp(modulate(rmsnorm(x, norm2_w[l]), sh2, sc2), w_mlp1[l], w_mlp2[l])

        if not last:
            xc = xc + cg1 * mix_c
            xc = xc + cg2 * sq_relu_mlp(modulate(rmsnorm(xc, norm2_w[l]), csh2, csc2), w_mlp1[l], w_mlp2[l])
    return x
```

```cpp
#include <hip/hip_runtime.h>
#include <hip/hip_cooperative_groups.h>
#include <cstdio>
namespace cg = cooperative_groups;

#define DEVI __device__ __forceinline__
#define LAS __attribute__((address_space(3)))
typedef unsigned short bf16_t;
typedef short bf16x8 __attribute__((ext_vector_type(8)));
typedef float f32x4 __attribute__((ext_vector_type(4)));
typedef unsigned u32x4 __attribute__((ext_vector_type(4)));
typedef unsigned u32x2 __attribute__((ext_vector_type(2)));

constexpr int DM = 1024, NB = 16, SEQ = 2048, LCTX = 256, NLAT = NB * SEQ, NCTX = NB * LCTX, RT_ = NLAT + NCTX;
constexpr int ZM = 2816, ZGW = 3072, INC = 5888, HID = 4096;
constexpr int C_RK = 0, C_RV = 256, C_AK = 768, C_AV = 896, C_RQ = 1024, C_RG = 1280, C_AQ = 1792, C_PU = 2304;
constexpr float EPS = 1e-6f;
constexpr int NTHREADS = 512;
constexpr int LDS_BYTES = 131072;
constexpr int LDS_TOTAL = LDS_BYTES + 16;

constexpr size_t OFF_ZG = 0;
constexpr size_t OFF_YB = OFF_ZG + (size_t)RT_ * ZGW * 2;
constexpr size_t OFF_UB = OFF_YB + (size_t)RT_ * 1536 * 2;
constexpr size_t OFF_XC = OFF_UB + (size_t)RT_ * 1024 * 2;
constexpr size_t OFF_WB = OFF_XC + (size_t)NCTX * 1024 * 4;
constexpr size_t W_IN = 0, W_BR = W_IN + (size_t)INC * 1024, W_O = W_BR + 3 * 512 * 1024, W_1 = W_O + 1024 * 1024, W_2 = W_1 + 4096 * 1024, W_END = W_2 + 4096 * 1024;
constexpr size_t OFF_RS = OFF_WB + W_END * 2;
constexpr size_t OFF_MOD = OFF_RS + (size_t)NB * 4 * 2 * 18 * 8192 * 2;
constexpr size_t OFF_RT = OFF_MOD + 2 * 17 * 6144 * 4;
constexpr size_t OFF_AT = OFF_RT + 2048 * 32 * 8;
constexpr size_t OFF_BAR = OFF_AT + 64 * 16 * 8;
constexpr size_t BAR_BYTES = 16384;
constexpr size_t OFF_SSQ2 = OFF_BAR + BAR_BYTES;
constexpr size_t OFF_SHW2 = OFF_SSQ2 + (size_t)2 * RT_ * 4;
constexpr size_t OFF_A2 = OFF_SHW2 + (size_t)2 * 17 * 4096 * 4;
constexpr size_t WS_END = OFF_A2 + (size_t)2 * 17 * 1024 * 4;
constexpr size_t OFF_U2 = OFF_ZG;
constexpr size_t OFF_H = OFF_ZG + (size_t)RT_ * 1024 * 2;
static_assert(OFF_H + (size_t)RT_ * 4096 * 2 <= OFF_XC, "H overlaps the ctx stream");

struct Params { const float* in[21]; float* out; unsigned char* ws; int ph_lo, ph_hi; };

DEVI int opaque_tid(int wv) { int ln; asm volatile("v_mbcnt_lo_u32_b32 %0, -1, 0\n\tv_mbcnt_hi_u32_b32 %0, -1, %0" : "=v"(ln)); return wv * 64 + ln; }
DEVI float bf2f(bf16_t h) { return __uint_as_float(((unsigned)h) << 16); }
DEVI float bflo(unsigned w) { return __uint_as_float(w << 16); }
DEVI float bfhi(unsigned w) { return __uint_as_float(w & 0xffff0000u); }
DEVI unsigned cvt_pk_bf16(float lo, float hi) { unsigned r; asm volatile("v_cvt_pk_bf16_f32 %0, %1, %2" : "=v"(r) : "v"(lo), "v"(hi)); return r; }
DEVI bf16_t f2bf(float f) { return (bf16_t)(cvt_pk_bf16(f, 0.f) & 0xffffu); }
DEVI float wsum(float v) {
#pragma unroll
    for (int o = 32; o > 0; o >>= 1) v += __shfl_xor(v, o);
    return v; }
DEVI float wmax(float v) {
#pragma unroll
    for (int o = 32; o > 0; o >>= 1) v = fmaxf(v, __shfl_xor(v, o));
    return v; }
DEVI float sigmoidf_(float g) { return __builtin_amdgcn_rcpf(1.0f + __expf(-g)); }
DEVI const float* xrow_in(const Params& p, int l, int row) {
    if (l == 0) return row < NLAT ? p.in[0] + (size_t)row * DM : p.in[2] + (size_t)(row - NLAT) * DM;
    return row < NLAT ? p.out + (size_t)row * DM : (const float*)(p.ws + OFF_XC) + (size_t)(row - NLAT) * DM;
}
DEVI float* xrow_out(const Params& p, int row) { return row < NLAT ? p.out + (size_t)row * DM : (float*)(p.ws + OFF_XC) + (size_t)(row - NLAT) * DM; }
DEVI const float* modrow(const Params& p, int l, int row) { const int bi = row < NLAT ? (row >> 11) : 16; return (const float*)(p.ws + OFF_MOD) + (size_t)(l * 17 + bi) * 6144; }

namespace pg8 {
constexpr int BM = 256, BK = 64, HALF = 128, HTB = HALF * BK * 2, NXCD = 8, WGM = 8;
DEVI int lds_byte(int r, int c) { const int st = (r >> 4) * 2 + (c >> 5), rr = r & 15, cc = c & 31, ob = rr * 64 + cc * 2; return st * 1024 + (ob ^ (((ob >> 9) & 1) << 5)); }
DEVI void stage_rc(int b, int& R, int& C) { const int st = b / 1024, sb = b % 1024, swz = sb ^ (((sb >> 9) & 1) << 5); R = (st >> 1) * 16 + swz / 64; C = (st & 1) * 32 + (swz % 64) / 2; }
DEVI int perm32(int rho) { const int n = rho >> 4, i = rho & 15; return 8 * (i >> 2) + 4 * n + (i & 3); }

struct Unit { int pm, pn, pb; };
struct Gemm { const bf16_t* A; const bf16_t* Bt; int lda, ldb, K; size_t a_bs, b_bs; };
struct Order {
    int nM, nN, nwg, G, c, nb, tail_units, tail_nN;
    DEVI void init(int M, int N, int G_, int c_, int nb_) { nM = M / BM; nN = N / BM; nwg = nM * nN; G = G_; c = c_; nb = nb_; tail_units = 0; tail_nN = 1; }
    DEVI void set_tail(int tail_rows, int tail_nN_) { tail_nN = tail_nN_; tail_units = (tail_rows / BM) * tail_nN_; }
    DEVI bool next(int i, Unit& u) const {
        const int ti = i / nb; u.pb = i - ti * nb;
        const long L = (long)ti * G + c;
        if (L >= nwg) { const int t = (int)(L - nwg); if (t >= tail_units) return false; u.pm = nM + t / tail_nN; u.pn = t % tail_nN; return true; }
        int wgid = (int)L; { const int q = nwg / NXCD, r = nwg % NXCD, xcd = wgid % NXCD, off = wgid / NXCD; wgid = (xcd < r ? xcd * (q + 1) : r * (q + 1) + (xcd - r) * q) + off; }
        const int nig = WGM * nN, gid = wgid / nig, fm = gid * WGM, gsz = (nM - fm) < WGM ? (nM - fm) : WGM;
        u.pm = fm + ((wgid % nig) % gsz); u.pn = (wgid % nig) / gsz; return true;
    }
};

template <int ACT  , bool RS = false  > struct EpiBf16 {
    static constexpr bool PERM = true;
    bf16_t* O; int ldc; const float* ssq; const float* shw; int ldshw;
    DEVI bool keep(const Unit&) const { return false; }
    DEVI void operator()(f32x4 (&acc)[2][2][4][2], const Unit& u, int wr, int wc, int fr, int fq) const {
        const int row0 = u.pm * BM + wr * 64 + fr, col0 = u.pn * BM + wc * 32 + 8 * fq;
        f32x4 sh[2][2];
        if (RS) { const int bi = u.pm * BM < NLAT ? (u.pm * BM) >> 11 : 16;
#pragma unroll
            for (int bj = 0; bj < 2; ++bj) { sh[bj][0] = *(const f32x4*)(shw + (size_t)bi * ldshw + col0 + bj * HALF); sh[bj][1] = *(const f32x4*)(shw + (size_t)bi * ldshw + col0 + bj * HALF + 4); } }
#pragma unroll
        for (int ai = 0; ai < 2; ++ai)
#pragma unroll
            for (int m = 0; m < 4; ++m) { bf16_t* rowp = O + (size_t)(row0 + ai * HALF + m * 16) * ldc + col0;
                float rstd = 1.0f; if (RS) rstd = rsqrtf(ssq[row0 + ai * HALF + m * 16] * (1.0f / 1024.0f) + EPS);
#pragma unroll
                for (int bj = 0; bj < 2; ++bj) { f32x4 v0 = acc[ai][bj][m][0], v1 = acc[ai][bj][m][1];
                    if (RS) { v0 = v0 * rstd + sh[bj][0]; v1 = v1 * rstd + sh[bj][1]; }
                    if (ACT == 1) {
#pragma unroll
                        for (int j = 0; j < 4; ++j) { const float a = fmaxf(v0[j], 0.f), b = fmaxf(v1[j], 0.f); v0[j] = a * a; v1[j] = b * b; } }
                    if (ACT == 2) {
#pragma unroll
                        for (int j = 0; j < 4; ++j) { v0[j] = 1.0f + __expf(-fminf(fmaxf(v0[j], -30.f), 30.f)); v1[j] = 1.0f + __expf(-fminf(fmaxf(v1[j], -30.f), 30.f)); } }
                    u32x4 w; w.x = cvt_pk_bf16(v0[0], v0[1]); w.y = cvt_pk_bf16(v0[2], v0[3]); w.z = cvt_pk_bf16(v1[0], v1[1]); w.w = cvt_pk_bf16(v1[2], v1[3]);
                    *(u32x4*)(rowp + bj * HALF) = w; } }
    }
};
struct EpiMerge {
    static constexpr bool PERM = true;
    const bf16_t* Gt; bf16_t* O;
    DEVI bool keep(const Unit& u) const { return u.pb < 2; }
    DEVI void operator()(f32x4 (&acc)[2][2][4][2], const Unit& u, int wr, int wc, int fr, int fq) const {
        const int row0 = u.pm * BM + wr * 64 + fr, col0 = u.pn * BM + wc * 32 + 8 * fq;
        const bool mid = u.pb < 2;
#pragma unroll
        for (int ai = 0; ai < 2; ++ai) {
            u32x4 ga[4][2], gb[4][2];
#pragma unroll
            for (int m = 0; m < 4; ++m)
#pragma unroll
                for (int bj = 0; bj < 2; ++bj) { const bf16_t* gp = Gt + (size_t)(row0 + ai * HALF + m * 16) * ZGW + u.pb * 1024 + col0 + bj * HALF;
                    ga[m][bj] = *(const u32x4*)gp; gb[m][bj] = mid ? *(const u32x4*)(gp + 1024) : (u32x4){0x3f803f80u, 0x3f803f80u, 0x3f803f80u, 0x3f803f80u}; }
#pragma unroll
            for (int m = 0; m < 4; ++m)
#pragma unroll
                for (int bj = 0; bj < 2; ++bj) {
                    const u32x4 a = ga[m][bj], b = gb[m][bj];
                    float sc[8];
                    sc[0] = bflo(b.x) * __builtin_amdgcn_rcpf(bflo(a.x)); sc[1] = bfhi(b.x) * __builtin_amdgcn_rcpf(bfhi(a.x)); sc[2] = bflo(b.y) * __builtin_amdgcn_rcpf(bflo(a.y)); sc[3] = bfhi(b.y) * __builtin_amdgcn_rcpf(bfhi(a.y));
                    sc[4] = bflo(b.z) * __builtin_amdgcn_rcpf(bflo(a.z)); sc[5] = bfhi(b.z) * __builtin_amdgcn_rcpf(bfhi(a.z)); sc[6] = bflo(b.w) * __builtin_amdgcn_rcpf(bflo(a.w)); sc[7] = bfhi(b.w) * __builtin_amdgcn_rcpf(bfhi(a.w));
                    f32x4 v0 = acc[ai][bj][m][0], v1 = acc[ai][bj][m][1];
#pragma unroll
                    for (int j = 0; j < 4; ++j) { v0[j] *= sc[j]; v1[j] *= sc[4 + j]; }
                    if (mid) { acc[ai][bj][m][0] = v0; acc[ai][bj][m][1] = v1; }
                    else { u32x4 w; w.x = cvt_pk_bf16(v0[0], v0[1]); w.y = cvt_pk_bf16(v0[2], v0[3]); w.z = cvt_pk_bf16(v1[0], v1[1]); w.w = cvt_pk_bf16(v1[2], v1[3]);
                        *(u32x4*)(O + (size_t)(row0 + ai * HALF + m * 16) * DM + col0 + bj * HALF) = w; }
                }
        }
    }
};
struct EpiRes {
    static constexpr bool PERM = false;
    Params p; int l, goff;
    int in_is_stream;
    int emit;
    DEVI bool keep(const Unit&) const { return false; }
    DEVI void operator()(f32x4 (&acc)[2][2][4][2], const Unit& u, int wr, int wc, int fr, int fq) const {
        const int row0 = u.pm * BM + wr * 64 + fr, col0 = u.pn * BM + wc * 32 + 4 * fq;
        const float* gr = modrow(p, l, u.pm * BM) + goff + col0;
        f32x4 gv[2][2];
#pragma unroll
        for (int bj = 0; bj < 2; ++bj)
#pragma unroll
            for (int n = 0; n < 2; ++n) gv[bj][n] = *(const f32x4*)(gr + bj * HALF + n * 16);
        f32x4 av[2][2];
        if (emit) { const int bi = u.pm * BM < NLAT ? (u.pm * BM) >> 11 : 16; const float* ar = (const float*)(p.ws + OFF_A2) + (size_t)(l * 17 + bi) * 1024 + col0;
#pragma unroll
            for (int bj = 0; bj < 2; ++bj)
#pragma unroll
                for (int n = 0; n < 2; ++n) av[bj][n] = *(const f32x4*)(ar + bj * HALF + n * 16); }
        constexpr int DEPTH = 2;
        f32x4 xq[8][2][2];
#define ER_LOAD(GI) do { const int r_ = row0 + ((GI) >> 2) * HALF + ((GI) & 3) * 16; \
            const float* xi_ = (in_is_stream ? (const float*)xrow_out(p, r_) : xrow_in(p, l, r_)) + col0; \
            _Pragma("unroll") for (int bj = 0; bj < 2; ++bj) _Pragma("unroll") for (int n = 0; n < 2; ++n) xq[GI][bj][n] = *(const f32x4*)(xi_ + bj * HALF + n * 16); } while (0)
#pragma unroll
        for (int gi = 0; gi < DEPTH; ++gi) ER_LOAD(gi);
#pragma unroll
        for (int gi = 0; gi < 8; ++gi) {
            if (gi + DEPTH < 8) ER_LOAD(gi + DEPTH);
            const int ai = gi >> 2, m = gi & 3; const int r = row0 + ai * HALF + m * 16; float* xo = xrow_out(p, r) + col0;
            float ssp = 0.f;
#pragma unroll
            for (int bj = 0; bj < 2; ++bj)
#pragma unroll
                for (int n = 0; n < 2; ++n) { const f32x4 xn = xq[gi][bj][n] + gv[bj][n] * acc[ai][bj][m][n]; *(f32x4*)(xo + bj * HALF + n * 16) = xn;
                    if (emit) { ssp += xn[0] * xn[0] + xn[1] * xn[1] + xn[2] * xn[2] + xn[3] * xn[3];
                        const f32x4 ua = xn * av[bj][n]; u32x2 w; w.x = cvt_pk_bf16(ua[0], ua[1]); w.y = cvt_pk_bf16(ua[2], ua[3]);
                        *(u32x2*)((bf16_t*)(p.ws + OFF_U2) + (size_t)r * DM + col0 + bj * HALF + n * 16) = w; } }
            if (emit) { ssp += __shfl_xor(ssp, 16); ssp += __shfl_xor(ssp, 32); if (fq == 0) atomicAdd((float*)(p.ws + OFF_SSQ2) + (size_t)l * RT_ + r, ssp); }
        }
#undef ER_LOAD
    }
};

template <class Epi>
DEVI void gemm_phase(const int wv, LAS unsigned char* lds, const Gemm g, const Order& S, const Epi& E) {
    const int tid = opaque_tid(wv), wid = wv, lane = tid & 63, wr = wid >> 2, wc = wid & 3, fr = lane & 15, fq = lane >> 4;
    const int K = g.K, nt = K / BK;
    unsigned voffA[2], voffB[2];
#pragma unroll
    for (int i = 0; i < 2; ++i) { int R, C; stage_rc(tid * 16 + i * 8192, R, C); const int Rb = Epi::PERM ? ((R & ~31) + perm32(R & 31)) : R;
        voffA[i] = (unsigned)(R * g.lda + C) * 2u; voffB[i] = (unsigned)(Rb * g.ldb + C) * 2u; }
    const size_t kstep = (size_t)(BK * 2);
    const size_t hstepA = (size_t)HALF * g.lda * 2, hstepB = (size_t)HALF * g.ldb * 2;
    const size_t tstepA = 2 * hstepA, tstepB = 2 * hstepB;
    const unsigned ldsw = (unsigned)wid * 1024u;
    const int aoff = lds_byte(wr * 64 + fr, fq * 8), boff = lds_byte(wc * 32 + fr, fq * 8);
#define PG8_SA(b, h) (((b) * 2 + (h)) * HTB)
#define PG8_SB(b, h) ((4 + (b) * 2 + (h)) * HTB)
#define PG8_STAGE(bufoff, gbase, voff) do { _Pragma("unroll") for (int _i = 0; _i < 2; ++_i) \
        __builtin_amdgcn_global_load_lds((const unsigned*)((const char*)(gbase) + (voff)[_i]), (LAS unsigned*)(lds + (bufoff) + ldsw + _i * 8192), 16, 0, 0); } while (0)
#define PG8_LDA(dst, b, h) do { _Pragma("unroll") for (int m = 0; m < 4; ++m) _Pragma("unroll") for (int k = 0; k < 2; ++k) dst[m][k] = *(const LAS bf16x8*)(lds + PG8_SA(b, h) + aoff + m * 2048 + k * 1024); } while (0)
#define PG8_LDB(dst, b, h) do { _Pragma("unroll") for (int n = 0; n < 2; ++n) _Pragma("unroll") for (int k = 0; k < 2; ++k) dst[n][k] = *(const LAS bf16x8*)(lds + PG8_SB(b, h) + boff + n * 2048 + k * 1024); } while (0)
#define PG8_MMA(ai, bj, At, Bt) do { __builtin_amdgcn_s_setprio(1); _Pragma("unroll") for (int m = 0; m < 4; ++m) _Pragma("unroll") for (int n = 0; n < 2; ++n) _Pragma("unroll") for (int k = 0; k < 2; ++k) \
        acc[ai][bj][m][n] = __builtin_amdgcn_mfma_f32_16x16x32_bf16(Bt[n][k], At[m][k], acc[ai][bj][m][n], 0, 0, 0); __builtin_amdgcn_s_setprio(0); } while (0)
#define PG8_WAIT_V(n) asm volatile("s_waitcnt vmcnt(" #n ")" ::: "memory")
#define PG8_WAIT_L(n) asm volatile("s_waitcnt lgkmcnt(" #n ")" ::: "memory")
#define PG8_BAR __builtin_amdgcn_s_barrier()
#define PG8_SCHED __builtin_amdgcn_sched_barrier(0)
    Unit cur, nxt; int ui = 0;
    if (!S.next(0, cur)) return;
    f32x4 acc[2][2][4][2];
#pragma unroll
    for (int a = 0; a < 2; ++a)
#pragma unroll
        for (int b = 0; b < 2; ++b)
#pragma unroll
            for (int m = 0; m < 4; ++m)
#pragma unroll
                for (int n = 0; n < 2; ++n) acc[a][b][m][n] = (f32x4){0.f, 0.f, 0.f, 0.f};
    bf16x8 At[4][2], B0[2][2], B1[2][2];
    const char* cA = (const char*)g.A + (size_t)cur.pb * g.a_bs + (size_t)cur.pm * tstepA; const char* cB = (const char*)g.Bt + (size_t)cur.pb * g.b_bs + (size_t)cur.pn * tstepB;
    PG8_STAGE(PG8_SB(0, 0), cB, voffB); PG8_STAGE(PG8_SA(0, 0), cA, voffA); PG8_STAGE(PG8_SB(0, 1), cB + hstepB, voffB); PG8_STAGE(PG8_SA(0, 1), cA + hstepA, voffA);
    if (wr == 1) PG8_BAR;
    PG8_WAIT_V(4); PG8_BAR;
    PG8_STAGE(PG8_SB(1, 0), cB + kstep, voffB); PG8_STAGE(PG8_SA(1, 0), cA + kstep, voffA); PG8_STAGE(PG8_SB(1, 1), cB + hstepB + kstep, voffB);
    PG8_WAIT_V(6); PG8_BAR;
    for (;;) {
        const bool has_next = S.next(ui + 1, nxt);
        const char* nA = has_next ? (const char*)g.A + (size_t)nxt.pb * g.a_bs + (size_t)nxt.pm * tstepA : cA;
        const char* nB = has_next ? (const char*)g.Bt + (size_t)nxt.pb * g.b_bs + (size_t)nxt.pn * tstepB : cB;
        for (int t = 0; t < nt; t += 2) {
            const bool last = (t == nt - 2);
            const char* a1 = cA + (size_t)(t + 1) * kstep;
            const char* a2 = last ? nA : cA + (size_t)(t + 2) * kstep; const char* b2 = last ? nB : cB + (size_t)(t + 2) * kstep;
            const char* a3 = a2 + kstep; const char* b3 = b2 + kstep;
            PG8_LDB(B0, 0, 0); PG8_SCHED; PG8_LDA(At, 0, 0); PG8_STAGE(PG8_SA(1, 1), a1 + hstepA, voffA);
            PG8_WAIT_L(8); PG8_BAR; PG8_WAIT_L(0); PG8_MMA(0, 0, At, B0); PG8_BAR; PG8_SCHED;
            PG8_LDB(B1, 0, 1); PG8_STAGE(PG8_SB(0, 0), b2, voffB);
            PG8_BAR; PG8_WAIT_L(0); PG8_MMA(0, 1, At, B1); PG8_BAR;
            PG8_LDA(At, 0, 1); PG8_STAGE(PG8_SA(0, 0), a2, voffA);
            PG8_BAR; PG8_WAIT_L(0); PG8_MMA(1, 0, At, B0); PG8_BAR; PG8_SCHED;
            PG8_STAGE(PG8_SB(0, 1), b2 + hstepB, voffB);
            PG8_WAIT_V(6); PG8_BAR; PG8_MMA(1, 1, At, B1); PG8_BAR;
            PG8_LDB(B0, 1, 0); PG8_SCHED; PG8_LDA(At, 1, 0); PG8_STAGE(PG8_SA(0, 1), a2 + hstepA, voffA);
            PG8_WAIT_L(8); PG8_BAR; PG8_WAIT_L(0); PG8_MMA(0, 0, At, B0); PG8_BAR; PG8_SCHED;
            PG8_LDB(B1, 1, 1); PG8_STAGE(PG8_SB(1, 0), b3, voffB);
            PG8_BAR; PG8_WAIT_L(0); PG8_MMA(0, 1, At, B1); PG8_BAR;
            PG8_LDA(At, 1, 1); PG8_STAGE(PG8_SA(1, 0), a3, voffA);
            PG8_BAR; PG8_WAIT_L(0); PG8_MMA(1, 0, At, B0); PG8_BAR; PG8_SCHED;
            PG8_STAGE(PG8_SB(1, 1), b3 + hstepB, voffB);
            PG8_WAIT_V(6); PG8_BAR; PG8_MMA(1, 1, At, B1); PG8_BAR;
        }
        E(acc, cur, wr, wc, fr, fq);
        if (!E.keep(cur)) {
#pragma unroll
            for (int a = 0; a < 2; ++a)
#pragma unroll
                for (int b = 0; b < 2; ++b)
#pragma unroll
                    for (int m = 0; m < 4; ++m)
#pragma unroll
                        for (int n = 0; n < 2; ++n) acc[a][b][m][n] = (f32x4){0.f, 0.f, 0.f, 0.f};
        }
        if (!has_next) break;
        cur = nxt; cA = nA; cB = nB; ++ui;
    }
    PG8_WAIT_V(0);
    if (wr == 0) PG8_BAR;
    PG8_BAR;
#undef PG8_SA
#undef PG8_SB
#undef PG8_STAGE
#undef PG8_LDA
#undef PG8_LDB
#undef PG8_MMA
#undef PG8_WAIT_V
#undef PG8_WAIT_L
#undef PG8_BAR
#undef PG8_SCHED
}
}

#define XB_TMO      128
#define XB_XCNT(j)  (256  + 64 * (j))
#define XB_XSUB(j)  (1280 + 64 * (j))
#define XB_XGEN(j)  (2304 + 64 * (j))
#define XB_TOP      3328
#define XB_TOPGEN   3392
#define XCD_BAR_WORDS 3456
#define XB_SPIN_CAP (1u << 22)
DEVI unsigned xb_ld(unsigned* p)              { return __hip_atomic_load(p, __ATOMIC_RELAXED, __HIP_MEMORY_SCOPE_AGENT); }
DEVI unsigned xb_add(unsigned* p, unsigned v) { return __hip_atomic_fetch_add(p, v, __ATOMIC_RELAXED, __HIP_MEMORY_SCOPE_AGENT); }
DEVI unsigned xb_xcc_id() { return (unsigned)__builtin_amdgcn_s_getreg((3 << 11) | 20) & 0xFu; }
#define XB_SPIN(cond, bar) do { unsigned _sp = 0; while (cond) { __builtin_amdgcn_s_sleep(1); \
    if ((++_sp & 255u) == 0u) { if (xb_ld(&(bar)[XB_TMO])) break; if (_sp > XB_SPIN_CAP) { atomicAdd(&(bar)[XB_TMO], 1u); break; } } } } while (0)
struct XcdBarrier { unsigned* bar; unsigned x; volatile LAS unsigned* st; };
DEVI void xcd_barrier_complete(unsigned* bar, unsigned x, unsigned& nloc, unsigned& nx) {
    const unsigned G = gridDim.x;
    unsigned sum, cnt, mine, sp = 0u;
    for (;;) {
        sum = 0u; cnt = 0u; mine = 0u;
#pragma unroll
        for (unsigned j = 0; j < 16; ++j) { const unsigned c = xb_ld(&bar[XB_XCNT(j)]); sum += c; cnt += (c > 0u) ? 1u : 0u; mine = (j == x) ? c : mine; }
        if (sum == G) break;
        __builtin_amdgcn_s_sleep(1);
        if ((++sp & 255u) == 0u) { if (xb_ld(&bar[XB_TMO])) break; if (sp > XB_SPIN_CAP) { atomicAdd(&bar[XB_TMO], 1u); break; } }
    }
    nloc = mine > 0u ? mine : 1u; nx = cnt > 0u ? cnt : 1u;
}
DEVI void xcd_barrier(const XcdBarrier& b, const int wv) {
    asm volatile("s_waitcnt vmcnt(0)" ::: "memory");
    __syncthreads();
    if (opaque_tid(wv) == 0) {
        unsigned* bar = b.bar;
        __builtin_amdgcn_s_waitcnt(0);
        unsigned nloc = b.st[0], nx = b.st[1];
        if (nloc == 0u) { xcd_barrier_complete(bar, b.x, nloc, nx); b.st[0] = nloc; b.st[1] = nx; }
        const unsigned old = xb_add(&bar[XB_XSUB(b.x)], 1u);
        const unsigned gen = old / nloc;
        if (old + 1u == (gen + 1u) * nloc) {
            __builtin_amdgcn_fence(__ATOMIC_RELEASE, "agent");
            asm volatile("s_waitcnt vmcnt(0)" ::: "memory");
            const unsigned og = xb_add(&bar[XB_TOP], 1u);
            const unsigned tg = og / nx;
            if (og + 1u == (tg + 1u) * nx) xb_add(&bar[XB_TOPGEN], 1u);
            else XB_SPIN(xb_ld(&bar[XB_TOPGEN]) == tg, bar);
            __builtin_amdgcn_fence(__ATOMIC_ACQUIRE, "agent");
            xb_add(&bar[XB_XGEN(b.x)], 1u);
            asm volatile("s_waitcnt vmcnt(0)" ::: "memory");
        } else {
            XB_SPIN(xb_ld(&bar[XB_XGEN(b.x)]) == gen, bar);
            __builtin_amdgcn_fence(__ATOMIC_ACQUIRE, "agent");
            asm volatile("s_waitcnt vmcnt(0)" ::: "memory");
        }
    }
    __syncthreads();
}

DEVI void ph_setup(const int wv, const Params& p, unsigned char* lds) {
    const int tid = opaque_tid(wv);
    for (int e = blockIdx.x * NTHREADS + tid; e < 2 * RT_; e += gridDim.x * NTHREADS) ((float*)(p.ws + OFF_SSQ2))[e] = 0.f;
    float* scv = (float*)lds;
    float* red = scv + 17 * 1024;
    for (int it = blockIdx.x; it < 192 + 130; it += gridDim.x) {
        if (it < 192) {
            const int l = it / 96, n0 = (it % 96) * 64;
            for (int e = tid; e < 17 * 1024; e += NTHREADS) { const int r = e >> 10, k = e & 1023; const float v = r < 16 ? p.in[1][r * 1024 + k] : p.in[3][k]; scv[e] = v / (1.0f + expf(-v)); }
            __syncthreads();
            const int n = tid & 63, kg = tid >> 6;
            float acc[17];
#pragma unroll
            for (int r = 0; r < 17; ++r) acc[r] = 0.f;
            const float* w = p.in[6] + (size_t)l * 1024 * 6144 + n0 + n;
            for (int k = kg * 128; k < kg * 128 + 128; ++k) { const float wv = w[(size_t)k * 6144];
#pragma unroll
                for (int r = 0; r < 17; ++r) acc[r] += scv[r * 1024 + k] * wv; }
#pragma unroll
            for (int r = 0; r < 17; ++r) red[(kg * 17 + r) * 64 + n] = acc[r];
            __syncthreads();
            float* mod = (float*)(p.ws + OFF_MOD);
            for (int e = tid; e < 17 * 64; e += NTHREADS) { const int r = e >> 6, nn = e & 63; float s = 0.f;
#pragma unroll
                for (int q = 0; q < 8; ++q) s += red[(q * 17 + r) * 64 + nn];
                mod[(size_t)(l * 17 + r) * 6144 + n0 + nn] = s + p.in[7][l * 6144 + n0 + nn]; }
            __syncthreads();
        } else {
            const int e = (it - 192) * NTHREADS + tid;
            if (e < 65536) { const int pos = e >> 5, i = e & 31; const float fr = powf(10000.0f, -(float)i / 32.0f); const float ang = (float)pos * fr;
                const double tr = (double)ang * 0.15915494309189535; const float tf = (float)(tr - floor(tr));
                ((float2*)(p.ws + OFF_RT))[e] = make_float2(__builtin_amdgcn_cosf(tf), __builtin_amdgcn_sinf(tf)); }
            else { const int e2 = e - 65536; const int pos = e2 >> 4, i = e2 & 15; const float fr = powf(10000.0f, -(float)i / 16.0f); const float ang = (float)pos * fr;
                const double tr = (double)ang * 0.15915494309189535; const float tf = (float)(tr - floor(tr));
                ((float2*)(p.ws + OFF_AT))[e2] = make_float2(__builtin_amdgcn_cosf(tf), __builtin_amdgcn_sinf(tf)); }
        }
    }
}

DEVI void ph_shw(const int wv, const Params& p, int l, unsigned char* lds, int blk_lo) {
    const int tid = opaque_tid(wv);
    if ((int)blockIdx.x < blk_lo) return;
    const int bx = blockIdx.x - blk_lo, nbx = gridDim.x - blk_lo;
    float* shv = (float*)lds;
    float* red = shv + 17 * 1024;
    const float* mod = (const float*)(p.ws + OFF_MOD) + (size_t)l * 17 * 6144;
    for (int e = bx * NTHREADS + tid; e < 17 * 1024; e += nbx * NTHREADS) { const int r = e >> 10, k = e & 1023;
        ((float*)(p.ws + OFF_A2))[(size_t)l * 17 * 1024 + e] = p.in[5][l * 1024 + k] * (1.0f + mod[(size_t)r * 6144 + 4096 + k]); }
    for (int it = bx; it < 256; it += nbx) {
        const int n0 = it * 16;
        __syncthreads();
        for (int e = tid; e < 17 * 1024; e += NTHREADS) { const int r = e >> 10, k = e & 1023; shv[e] = mod[(size_t)r * 6144 + 3072 + k]; }
        __syncthreads();
        const int n = tid & 15, kg = tid >> 4;
        float acc[17];
#pragma unroll
        for (int r = 0; r < 17; ++r) acc[r] = 0.f;
        const float* w = p.in[19] + (size_t)l * 1024 * 4096 + n0 + n;
#pragma unroll 8
        for (int k = kg * 32; k < kg * 32 + 32; ++k) { const float wvv = w[(size_t)k * 4096];
#pragma unroll
            for (int r = 0; r < 17; ++r) acc[r] += shv[r * 1024 + k] * wvv; }
#pragma unroll
        for (int r = 0; r < 17; ++r) red[(kg * 17 + r) * 16 + n] = acc[r];
        __syncthreads();
        for (int e = tid; e < 17 * 16; e += NTHREADS) { const int r = e >> 4, nn = e & 15; float sacc = 0.f;
#pragma unroll
            for (int q = 0; q < 32; ++q) sacc += red[(q * 17 + r) * 16 + nn];
            ((float*)(p.ws + OFF_SHW2))[(size_t)(l * 17 + r) * 4096 + n0 + nn] = sacc; }
    }
    __syncthreads();
}

DEVI void ph_convert(const int wv, const Params& p, int l, unsigned char* lds, int mode  , int blk_lo) {
    const int tid = opaque_tid(wv);
    float* tile = (float*)lds;
    bf16_t* WB = (bf16_t*)(p.ws + OFF_WB);
    if ((int)blockIdx.x < blk_lo) return;
    const int nitems = mode == 0 ? 4032 + 64 : (mode == 1 ? 3008 + 64 : 1024);
    for (int j = blockIdx.x - blk_lo; j < nitems; j += gridDim.x - blk_lo) {
        const int it = mode == 0 ? j : (mode == 1 ? (j < 3008 ? j : j + 1024) : j + 3008);
        if (it < 4032) {
            const float* src; bf16_t* dst; int K, N, t;
            if (it < 1472) { t = it; src = p.in[8] + (size_t)l * 1024 * INC; dst = WB + W_IN; K = 1024; N = INC; }
            else if (it < 1600) { t = it - 1472; src = p.in[15] + (size_t)l * 512 * 1024; dst = WB + W_BR; K = 512; N = 1024; }
            else if (it < 1728) { t = it - 1600; src = p.in[17] + (size_t)l * 512 * 1024; dst = WB + W_BR + 2 * 512 * 1024; K = 512; N = 1024; }
            else if (it < 1984) { t = it - 1728; src = p.in[18] + (size_t)l * 1024 * 1024; dst = WB + W_O; K = 1024; N = 1024; }
            else if (it < 3008) { t = it - 1984; src = p.in[19] + (size_t)l * 1024 * 4096; dst = WB + W_1; K = 1024; N = 4096; }
            else { t = it - 3008; src = p.in[20] + (size_t)l * 4096 * 1024; dst = WB + W_2; K = 4096; N = 1024; }
            const int nkt = K / 64, k0 = (t % nkt) * 64, n0 = (t / nkt) * 64;
            for (int e = tid; e < 4096; e += NTHREADS) { const int kk = e >> 6, nn = e & 63; tile[kk * 65 + nn] = src[(size_t)(k0 + kk) * N + n0 + nn]; }
            __syncthreads();
            for (int e = tid; e < 4096; e += NTHREADS) { const int nn = e >> 6, kk = e & 63; dst[(size_t)(n0 + nn) * K + k0 + kk] = f2bf(tile[kk * 65 + nn]); }
            __syncthreads();
        } else {
            const int pi = it - 4032, g = pi >> 4, n0 = (pi & 15) * 64;
            const int n = tid & 63, ig = tid >> 6;
            const float* pw = p.in[10] + (size_t)l * 4 * 128 * 128 + (size_t)g * 128 * 128 + (size_t)(ig * 16) * 128;
            const float* ps = p.in[11] + l * 512 + g * 128;
            const float* wpo = p.in[16] + (size_t)l * 512 * 1024 + (size_t)(g * 128) * 1024 + n0 + n;
            float acc[16];
#pragma unroll
            for (int ii = 0; ii < 16; ++ii) acc[ii] = 0.f;
            for (int j = 0; j < 128; ++j) { const float wv = ps[j] * wpo[(size_t)j * 1024];
#pragma unroll
                for (int ii = 0; ii < 16; ++ii) acc[ii] += pw[ii * 128 + j] * wv; }
            bf16_t* dst = WB + W_BR + 512 * 1024 + (size_t)(n0 + n) * 512 + g * 128 + ig * 16;
            u32x4 w0, w1;
            w0.x = cvt_pk_bf16(acc[0], acc[1]); w0.y = cvt_pk_bf16(acc[2], acc[3]); w0.z = cvt_pk_bf16(acc[4], acc[5]); w0.w = cvt_pk_bf16(acc[6], acc[7]);
            w1.x = cvt_pk_bf16(acc[8], acc[9]); w1.y = cvt_pk_bf16(acc[10], acc[11]); w1.z = cvt_pk_bf16(acc[12], acc[13]); w1.w = cvt_pk_bf16(acc[14], acc[15]);
            *(u32x4*)dst = w0; *(u32x4*)(dst + 8) = w1;
        }
    }
}

DEVI void ph_norm(const int wv, const Params& p, int l, int which  , int nrows) {
    const int tid = opaque_tid(wv); const int lane = tid & 63, wave = wv;
    const float* nw = p.in[which ? 5 : 4] + l * 1024;
    const int shoff = which ? 3072 : 0, scoff = which ? 4096 : 1024;
    bf16_t* U = (bf16_t*)(p.ws + OFF_UB);
    const int stride = gridDim.x * 8;
    for (int row0 = blockIdx.x * 8 + wave; row0 < nrows; row0 += 2 * stride) {
        f32x4 v[2][4]; float ss[2];
#pragma unroll
        for (int q = 0; q < 2; ++q) { const int row = row0 + q * stride; ss[q] = 0.f;
            if (row < nrows) { const float* x = which ? (const float*)xrow_out(p, row) : xrow_in(p, l, row);
#pragma unroll
                for (int i = 0; i < 4; ++i) v[q][i] = *(const f32x4*)(x + i * 256 + lane * 4); }
            else {
#pragma unroll
                for (int i = 0; i < 4; ++i) v[q][i] = (f32x4){0.f, 0.f, 0.f, 0.f}; } }
#pragma unroll
        for (int q = 0; q < 2; ++q) {
#pragma unroll
            for (int i = 0; i < 4; ++i) ss[q] += v[q][i][0] * v[q][i][0] + v[q][i][1] * v[q][i][1] + v[q][i][2] * v[q][i][2] + v[q][i][3] * v[q][i][3];
            ss[q] = wsum(ss[q]); }
#pragma unroll
        for (int q = 0; q < 2; ++q) { const int row = row0 + q * stride;
            if (row < nrows) { const float* md = modrow(p, l, row); const float rstd = rsqrtf(ss[q] * (1.0f / 1024.0f) + EPS);
#pragma unroll
                for (int i = 0; i < 4; ++i) { const int c = i * 256 + lane * 4;
                    const f32x4 w = *(const f32x4*)(nw + c), sc = *(const f32x4*)(md + scoff + c), sh = *(const f32x4*)(md + shoff + c);
                    const f32x4 o = v[q][i] * rstd * w * (1.0f + sc) + sh;
                    u32x2 pk; pk.x = cvt_pk_bf16(o[0], o[1]); pk.y = cvt_pk_bf16(o[2], o[3]);
                    *(u32x2*)(U + (size_t)row * 1024 + c) = pk; } } }
    }
}

DEVI void unpack8(const u32x4 w, float (&v)[8]) { v[0] = bflo(w.x); v[1] = bfhi(w.x); v[2] = bflo(w.y); v[3] = bfhi(w.y); v[4] = bflo(w.z); v[5] = bfhi(w.z); v[6] = bflo(w.w); v[7] = bfhi(w.w); }
DEVI void ph_prep(const int wv, const Params& p, int l, int nrows_pool, unsigned char* lds_raw) {
    const int tid = opaque_tid(wv); const int lane = tid & 63;
    bf16_t* Z = (bf16_t*)(p.ws + OFF_ZG); bf16_t* YB = (bf16_t*)(p.ws + OFF_YB);
    const float* RTf = (const float*)(p.ws + OFF_RT); const float* ATf = (const float*)(p.ws + OFF_AT);
    const int sub = lane & 7, hslot = lane >> 3, d0 = sub * 8;
    constexpr int NINST = RT_ * 18;
    for (int base = (blockIdx.x * 8 + wv) * 32; base < NINST; base += gridDim.x * 8 * 32) {
        u32x4 w[4]; int rowv[4], hhv[4], colv[4];
#pragma unroll
        for (int u = 0; u < 4; ++u) { const int hi = base + u * 8 + hslot; const int row = hi / 18, hh = hi - row * 18; rowv[u] = row; hhv[u] = hh;
            colv[u] = (hh < 4 ? C_RK + hh * 64 : hh < 8 ? C_RQ + (hh - 4) * 64 : hh < 10 ? C_AK + (hh - 8) * 64 : C_AQ + (hh - 10) * 64) + d0;
            w[u] = *(const u32x4*)(Z + (size_t)row * ZM + colv[u]); }
#pragma unroll
        for (int u = 0; u < 4; ++u) {
            const int row = rowv[u], hh = hhv[u]; const bool lat = row < NLAT; const int pos = row & 2047;
            float v[8]; unpack8(w[u], v);
            if (hh >= 8) {
                float ss = 0.f;
#pragma unroll
                for (int e = 0; e < 8; ++e) ss += v[e] * v[e];
                ss += __shfl_xor(ss, 1); ss += __shfl_xor(ss, 2); ss += __shfl_xor(ss, 4);
                const float rstd = rsqrtf(ss * (1.0f / 64.0f) + EPS) * (hh >= 10 ? 0.125f * 1.4426950408889634f : 1.0f);
                const float* wp = p.in[hh < 10 ? 13 : 12] + l * 64 + d0;
                const f32x4 w0 = *(const f32x4*)wp, w1 = *(const f32x4*)(wp + 4);
#pragma unroll
                for (int e = 0; e < 4; ++e) { v[e] *= rstd * w0[e]; v[4 + e] *= rstd * w1[e]; }
                if (lat) { const int pp = (sub & 4) ? (pos & 63) : (pos >> 6); const float* cp = ATf + (size_t)(pp * 16 + (d0 & 15)) * 2; const bool up = (sub & 2) != 0;
#pragma unroll
                    for (int e = 0; e < 8; ++e) { const float o = __shfl_xor(v[e], 2); const float cc = cp[2 * e], sn = cp[2 * e + 1]; v[e] = up ? o * sn + v[e] * cc : v[e] * cc - o * sn; } }
            } else {
                if (lat) { const float* cp = RTf + (size_t)(pos * 32 + (d0 & 31)) * 2; const bool up = (sub & 4) != 0;
#pragma unroll
                    for (int e = 0; e < 8; ++e) { const float o = __shfl_xor(v[e], 4); const float cc = cp[2 * e], sn = cp[2 * e + 1]; v[e] = up ? o * sn + v[e] * cc : v[e] * cc - o * sn; } }
                if (hh < 4) {
#pragma unroll
                    for (int e = 0; e < 8; ++e) v[e] *= 0.125f; }
            }
            u32x4 o; o.x = cvt_pk_bf16(v[0], v[1]); o.y = cvt_pk_bf16(v[2], v[3]); o.z = cvt_pk_bf16(v[4], v[5]); o.w = cvt_pk_bf16(v[6], v[7]);
            *(u32x4*)(Z + (size_t)row * ZM + colv[u]) = o;
        }
    }
    LAS unsigned char* slab = (LAS unsigned char*)lds_raw;
    for (int it = blockIdx.x; it < nrows_pool / 64; it += gridDim.x) {
        const int r0 = it * 64; int sbase, L;
        if (r0 < NLAT) { sbase = r0 & ~2047; L = 2048; } else { sbase = NLAT + ((r0 - NLAT) & ~255); L = 256; }
        const int t0 = r0 - sbase, lo_row = max(t0 - 8, 0), hi_row = min(t0 + 72, L), nchunks = (hi_row - lo_row) * 64;
        __syncthreads();
        for (int e = tid; e < nchunks; e += NTHREADS) { const int rr = e >> 6, cch = e & 63; *(LAS u32x4*)(slab + rr * 1024 + cch * 16) = *(const u32x4*)(Z + (size_t)(sbase + lo_row + rr) * ZM + C_PU + cch * 8); }
        __syncthreads();
#pragma unroll 2
        for (int o = tid; o < 4096; o += NTHREADS) {
            const int rr = o >> 6, cch = o & 63, hw = 1 << (cch >> 4), t = t0 + rr, lo = max(t - hw, 0), hi = min(t + hw, L);
            float sacc[8];
#pragma unroll
            for (int j = 0; j < 8; ++j) sacc[j] = 0.f;
            for (int tt = lo; tt < hi; ++tt) { float v[8]; unpack8(*(const LAS u32x4*)(slab + (tt - lo_row) * 1024 + cch * 16), v);
#pragma unroll
                for (int j = 0; j < 8; ++j) sacc[j] += v[j]; }
            float own[8]; unpack8(*(const LAS u32x4*)(slab + (t - lo_row) * 1024 + cch * 16), own);
            const float inv = 1.0f / (float)(hi - lo);
            u32x4 ow; ow.x = cvt_pk_bf16(sacc[0] * inv - own[0], sacc[1] * inv - own[1]); ow.y = cvt_pk_bf16(sacc[2] * inv - own[2], sacc[3] * inv - own[3]);
            ow.z = cvt_pk_bf16(sacc[4] * inv - own[4], sacc[5] * inv - own[5]); ow.w = cvt_pk_bf16(sacc[6] * inv - own[6], sacc[7] * inv - own[7]);
            *(u32x4*)(YB + (size_t)(sbase + t) * 1536 + 512 + cch * 8) = ow;
        }
    }
    __syncthreads();
}

#define MFMA16(X, Y, ACC) __builtin_amdgcn_mfma_f32_16x16x32_bf16((X), (Y), (ACC), 0, 0, 0)
DEVI bf16x8 mk_frag(unsigned a, unsigned b, unsigned c, unsigned d) { u32x4 w; w.x = a; w.y = b; w.z = c; w.w = d; return __builtin_bit_cast(bf16x8, w); }
typedef short s16x4 __attribute__((ext_vector_type(4)));
DEVI bf16x8 tr_frag(LAS unsigned char* tile, int rs, int rowA, int rowB, int n0, int fr) {
    const s16x4 a = __builtin_amdgcn_ds_read_tr16_b64_v4i16((LAS s16x4*)(tile + (rowA + (fr >> 2)) * rs + n0 * 2 + 8 * (fr & 3)));
    const s16x4 b = __builtin_amdgcn_ds_read_tr16_b64_v4i16((LAS s16x4*)(tile + (rowB + (fr >> 2)) * rs + n0 * 2 + 8 * (fr & 3)));
    return __builtin_shufflevector(a, b, 0, 1, 2, 3, 4, 5, 6, 7);
}
DEVI void lds_put8_t(LAS unsigned char* base, int rowstride, int r0, int j, const u32x4 w) {
    *(LAS unsigned short*)(base + (r0 + 0) * rowstride + 2 * j) = (unsigned short)(w.x & 0xffffu); *(LAS unsigned short*)(base + (r0 + 1) * rowstride + 2 * j) = (unsigned short)(w.x >> 16);
    *(LAS unsigned short*)(base + (r0 + 2) * rowstride + 2 * j) = (unsigned short)(w.y & 0xffffu); *(LAS unsigned short*)(base + (r0 + 3) * rowstride + 2 * j) = (unsigned short)(w.y >> 16);
    *(LAS unsigned short*)(base + (r0 + 4) * rowstride + 2 * j) = (unsigned short)(w.z & 0xffffu); *(LAS unsigned short*)(base + (r0 + 5) * rowstride + 2 * j) = (unsigned short)(w.z >> 16);
    *(LAS unsigned short*)(base + (r0 + 6) * rowstride + 2 * j) = (unsigned short)(w.w & 0xffffu); *(LAS unsigned short*)(base + (r0 + 7) * rowstride + 2 * j) = (unsigned short)(w.w >> 16);
}

DEVI void ph_attn(const int wv, const Params& p, int l, unsigned char* lds_raw, int it_lo = 0) {
    const int tid = opaque_tid(wv), lane = tid & 63, wave = wv, fr = lane & 15, fq = lane >> 4;
    LAS unsigned char* Kl = (LAS unsigned char*)lds_raw;
    LAS unsigned char* Vl = Kl + 18432;
    const bf16_t* Z = (const bf16_t*)(p.ws + OFF_ZG); bf16_t* YB = (bf16_t*)(p.ws + OFF_YB);
    const int nitems = 1024 + (l == 0 ? 128 : 0);
    for (int it = blockIdx.x + it_lo; it < nitems; it += gridDim.x) {
        int b, n, kvh, hp, qrow0; const bool isl = it < 1024;
        if (isl) { b = it >> 6; n = (it >> 2) & 15; kvh = (it >> 1) & 1; hp = it & 1; qrow0 = b * 2048 + n * 128; }
        else { const int i2 = it - 1024; b = i2 >> 3; n = (i2 >> 2) & 1; kvh = (i2 >> 1) & 1; hp = i2 & 1; qrow0 = NLAT + b * 256 + n * 128; }
        const int hq0 = kvh * 4 + hp * 2;
        const int ii = wave * 16 + fr;
        bf16x8 Qf[2][2];
#pragma unroll
        for (int g = 0; g < 2; ++g)
#pragma unroll
            for (int ks = 0; ks < 2; ++ks) Qf[g][ks] = *(const bf16x8*)(Z + (size_t)(qrow0 + ii) * ZM + C_AQ + (hq0 + g) * 64 + ks * 32 + fq * 8);
        float mrun[2], lrun[2]; f32x4 O[2][4];
#pragma unroll
        for (int g = 0; g < 2; ++g) { mrun[g] = p.in[14][l * 8 + hq0 + g] * 1.4426950408889634f; lrun[g] = fq == 0 ? 1.0f : 0.0f;
#pragma unroll
            for (int dt = 0; dt < 4; ++dt) O[g][dt] = (f32x4){0.f, 0.f, 0.f, 0.f}; }
        int t = isl ? (n > 0 ? 0 : 1) : 3;
        u32x4 pk[2], pv[2];
        { const int krow0 = t < 3 ? b * 2048 + (n - 1 + t) * 128 : NLAT + b * 256 + (t - 3) * 128;
#pragma unroll
          for (int rep = 0; rep < 2; ++rep) { const int pi = tid + 512 * rep;
              pk[rep] = *(const u32x4*)(Z + (size_t)(krow0 + (pi >> 3)) * ZM + C_AK + kvh * 64 + (pi & 7) * 8);
              pv[rep] = *(const u32x4*)(Z + (size_t)(krow0 + (pi >> 3)) * ZM + C_AV + kvh * 64 + (pi & 7) * 8); } }
        while (t < 5) {
            const int tn = (isl && t == 1 && n == 15) ? 3 : t + 1;
            const int msgn = t == 0 ? 1 : (t == 2 ? -1 : 0);
            const int dbase = 4 * fq - ii;
            __syncthreads();
#pragma unroll
            for (int rep = 0; rep < 2; ++rep) { const int pi = tid + 512 * rep;
                *(LAS u32x4*)(Kl + (pi >> 3) * 144 + (pi & 7) * 16) = pk[rep];
                *(LAS u32x4*)(Vl + (pi >> 3) * 144 + (pi & 7) * 16) = pv[rep]; }
            __syncthreads();
            if (tn < 5) { const int krow0 = tn < 3 ? b * 2048 + (n - 1 + tn) * 128 : NLAT + b * 256 + (tn - 3) * 128;
#pragma unroll
                for (int rep = 0; rep < 2; ++rep) { const int pi = tid + 512 * rep;
                    pk[rep] = *(const u32x4*)(Z + (size_t)(krow0 + (pi >> 3)) * ZM + C_AK + kvh * 64 + (pi & 7) * 8);
                    pv[rep] = *(const u32x4*)(Z + (size_t)(krow0 + (pi >> 3)) * ZM + C_AV + kvh * 64 + (pi & 7) * 8); } }
            const int jlo = msgn > 0 ? wave : 0, jhi = msgn < 0 ? wave : 7;
            f32x4 sc[2][8];
#pragma unroll
            for (int jt = 0; jt < 8; ++jt) {
                if (jt < jlo || jt > jhi) { sc[0][jt] = (f32x4){-INFINITY, -INFINITY, -INFINITY, -INFINITY}; sc[1][jt] = sc[0][jt]; continue; }
                sc[0][jt] = (f32x4){0.f, 0.f, 0.f, 0.f}; sc[1][jt] = (f32x4){0.f, 0.f, 0.f, 0.f};
#pragma unroll
                for (int ks = 0; ks < 2; ++ks) { const bf16x8 kf = *(const LAS bf16x8*)(Kl + (jt * 16 + fr) * 144 + ks * 64 + fq * 16);
                    sc[0][jt] = MFMA16(kf, Qf[0][ks], sc[0][jt]); sc[1][jt] = MFMA16(kf, Qf[1][ks], sc[1][jt]); } }
#pragma unroll
            for (int g = 0; g < 2; ++g) {
                float mx = mrun[g];
                if (msgn != 0) {
#pragma unroll
                    for (int jt = 0; jt < 8; ++jt)
#pragma unroll
                        for (int i = 0; i < 4; ++i) { const int d = msgn * (dbase + jt * 16 + i); sc[g][jt][i] = d >= 0 ? sc[g][jt][i] : -INFINITY; }
                }
#pragma unroll
                for (int jt = 0; jt < 8; ++jt) { mx = fmaxf(fmaxf(mx, sc[g][jt][0]), sc[g][jt][1]); mx = fmaxf(fmaxf(mx, sc[g][jt][2]), sc[g][jt][3]); }
                mx = fmaxf(mx, __shfl_xor(mx, 16)); mx = fmaxf(mx, __shfl_xor(mx, 32));
                const float alpha = __builtin_amdgcn_exp2f(mrun[g] - mx); mrun[g] = mx;
                float ps = 0.f;
#pragma unroll
                for (int jt = 0; jt < 8; ++jt)
#pragma unroll
                    for (int i = 0; i < 4; ++i) { const float e = __builtin_amdgcn_exp2f(sc[g][jt][i] - mx); sc[g][jt][i] = e; ps += e; }
                lrun[g] = lrun[g] * alpha + ps;
#pragma unroll
                for (int dt = 0; dt < 4; ++dt) O[g][dt] *= alpha;
            }
#pragma unroll
            for (int sI = 0; sI < 4; ++sI) {
                if (2 * sI + 1 < jlo || 2 * sI > jhi) continue;
                const bf16x8 pf0 = mk_frag(cvt_pk_bf16(sc[0][2 * sI][0], sc[0][2 * sI][1]), cvt_pk_bf16(sc[0][2 * sI][2], sc[0][2 * sI][3]), cvt_pk_bf16(sc[0][2 * sI + 1][0], sc[0][2 * sI + 1][1]), cvt_pk_bf16(sc[0][2 * sI + 1][2], sc[0][2 * sI + 1][3]));
                const bf16x8 pf1 = mk_frag(cvt_pk_bf16(sc[1][2 * sI][0], sc[1][2 * sI][1]), cvt_pk_bf16(sc[1][2 * sI][2], sc[1][2 * sI][3]), cvt_pk_bf16(sc[1][2 * sI + 1][0], sc[1][2 * sI + 1][1]), cvt_pk_bf16(sc[1][2 * sI + 1][2], sc[1][2 * sI + 1][3]));
#pragma unroll
                for (int dt = 0; dt < 4; ++dt) {
                    const bf16x8 vf = tr_frag(Vl, 144, (2 * sI) * 16 + 4 * fq, (2 * sI + 1) * 16 + 4 * fq, dt * 16, fr);
                    O[0][dt] = MFMA16(vf, pf0, O[0][dt]); O[1][dt] = MFMA16(vf, pf1, O[1][dt]); }
            }
            t = tn;
        }
#pragma unroll
        for (int g = 0; g < 2; ++g) { float lt = lrun[g]; lt += __shfl_xor(lt, 16); lt += __shfl_xor(lt, 32); const float inv = 1.0f / lt;
#pragma unroll
            for (int dt = 0; dt < 4; ++dt) { u32x2 w; w.x = cvt_pk_bf16(O[g][dt][0] * inv, O[g][dt][1] * inv); w.y = cvt_pk_bf16(O[g][dt][2] * inv, O[g][dt][3] * inv);
                *(u32x2*)(YB + (size_t)(qrow0 + ii) * 1536 + 1024 + (hq0 + g) * 64 + dt * 16 + 4 * fq) = w; } }
    }
    __syncthreads();
}

DEVI void ph_ret_state(const int wv, const Params& p, int l, unsigned char* lds_raw) {
    const int tid = opaque_tid(wv), lane = tid & 63, wave = wv, fr = lane & 15, fq = lane >> 4;
    LAS unsigned char* Kt = (LAS unsigned char*)lds_raw;
    LAS unsigned char* Vt = Kt + 18432;
    const bf16_t* Z = (const bf16_t*)(p.ws + OFF_ZG); bf16_t* RS = (bf16_t*)(p.ws + OFF_RS);
    for (int it = blockIdx.x; it < 256; it += gridDim.x) {
        const int b = it >> 4, h = (it >> 2) & 3, dir = (it >> 1) & 1, half = it & 1;
        const float e_ = p.in[9][(l * 2 + dir) * 4 + h];
        const float lg2 = log1pf(-exp2f(-e_)) * 1.4426950408889634f;
        const float gC = exp2f(128.0f * lg2);
        f32x4 R[2]; R[0] = (f32x4){0.f, 0.f, 0.f, 0.f}; R[1] = R[0];
        const int j0 = tid >> 3, g80 = tid & 7;
        const float wj0 = exp2f((float)(dir == 0 ? 127 - j0 : j0) * lg2), wj1 = exp2f((float)(dir == 0 ? 63 - j0 : j0 + 64) * lg2);
        u32x4 kwr[2], vwr[2];
        { const int cid0 = dir == 0 ? 0 : 1; const int row00 = NLAT + b * 256 + cid0 * 128;
#pragma unroll
          for (int rep = 0; rep < 2; ++rep) { const int jr = j0 + 64 * rep;
              kwr[rep] = *(const u32x4*)(Z + (size_t)(row00 + jr) * ZM + C_RK + h * 64 + g80 * 8);
              vwr[rep] = *(const u32x4*)(Z + (size_t)(row00 + jr) * ZM + C_RV + h * 128 + half * 64 + g80 * 8); } }
        for (int n = 0; n < 18; ++n) {
            const int cid = dir == 0 ? n : (n < 2 ? 1 - n : 19 - n);
#pragma unroll
            for (int tt = 0; tt < 2; ++tt) { const int t = wave * 2 + tt, dkt = t >> 2, dvt = t & 3;
                u32x2 w; w.x = cvt_pk_bf16(R[tt][0], R[tt][1]); w.y = cvt_pk_bf16(R[tt][2], R[tt][3]);
                *(u32x2*)(RS + ((size_t)((b * 4 + h) * 18 + cid) * 128 + half * 64 + dvt * 16 + fr) * 128 + dir * 64 + dkt * 16 + 4 * fq) = w; }
            if (n == 17) break;
            __syncthreads();
#pragma unroll
            for (int rep = 0; rep < 2; ++rep) { const int jr = j0 + 64 * rep; const float wj = rep ? wj1 : wj0;
                const u32x4 kw = kwr[rep];
                u32x4 ks; ks.x = cvt_pk_bf16(bflo(kw.x) * wj, bfhi(kw.x) * wj); ks.y = cvt_pk_bf16(bflo(kw.y) * wj, bfhi(kw.y) * wj); ks.z = cvt_pk_bf16(bflo(kw.z) * wj, bfhi(kw.z) * wj); ks.w = cvt_pk_bf16(bflo(kw.w) * wj, bfhi(kw.w) * wj);
                *(LAS u32x4*)(Kt + jr * 144 + g80 * 16) = ks; *(LAS u32x4*)(Vt + jr * 144 + g80 * 16) = vwr[rep]; }
            __syncthreads();
            if (n + 1 < 17) { const int n1 = n + 1; const int cid1 = dir == 0 ? n1 : (n1 < 2 ? 1 - n1 : 19 - n1);
                const int row01 = cid1 < 2 ? NLAT + b * 256 + cid1 * 128 : b * 2048 + (cid1 - 2) * 128;
#pragma unroll
                for (int rep = 0; rep < 2; ++rep) { const int jr = j0 + 64 * rep;
                    kwr[rep] = *(const u32x4*)(Z + (size_t)(row01 + jr) * ZM + C_RK + h * 64 + g80 * 8);
                    vwr[rep] = *(const u32x4*)(Z + (size_t)(row01 + jr) * ZM + C_RV + h * 128 + half * 64 + g80 * 8); } }
#pragma unroll
            for (int tt = 0; tt < 2; ++tt) { const int t = wave * 2 + tt, dkt = t >> 2, dvt = t & 3;
                f32x4 u = (f32x4){0.f, 0.f, 0.f, 0.f};
#pragma unroll
                for (int ks = 0; ks < 4; ++ks) { const bf16x8 xf = tr_frag(Kt, 144, ks * 32 + 8 * fq, ks * 32 + 8 * fq + 4, dkt * 16, fr), yf = tr_frag(Vt, 144, ks * 32 + 8 * fq, ks * 32 + 8 * fq + 4, dvt * 16, fr); u = MFMA16(xf, yf, u); }
                R[tt] = R[tt] * gC + u; }
        }
        __syncthreads();
    }
}

DEVI void ph_ret_out(const int wv, const Params& p, int l, unsigned char* lds_raw) {
    const int tid = opaque_tid(wv), lane = tid & 63, wave = wv, fr = lane & 15, fq = lane >> 4;
    LAS unsigned char* Kl = (LAS unsigned char*)lds_raw;
    LAS unsigned char* Ql = Kl + 18432;
    LAS unsigned char* Vt = Ql + 18432;
    LAS unsigned char* Rl = Vt + 36864;
    const bf16_t* Z = (const bf16_t*)(p.ws + OFF_ZG); const bf16_t* RS = (const bf16_t*)(p.ws + OFF_RS); bf16_t* YB = (bf16_t*)(p.ws + OFF_YB);
    const int nch = l == 0 ? 18 : 16, nitems = 64 * nch;
    u32x4 pk[2], pq[2], pr[4], pvv[4];
#define RO_LOAD(IT) do { const int bh_ = (IT) / nch, ci_ = (IT) - bh_ * nch, b_ = bh_ >> 2, h_ = bh_ & 3, cid_ = l == 0 ? ci_ : ci_ + 2; \
        const int row0_ = cid_ < 2 ? NLAT + b_ * 256 + cid_ * 128 : b_ * 2048 + (cid_ - 2) * 128; \
        _Pragma("unroll") for (int rep = 0; rep < 2; ++rep) { const int pi = tid + 512 * rep, r = pi >> 3, g8 = pi & 7; \
            pk[rep] = *(const u32x4*)(Z + (size_t)(row0_ + r) * ZM + C_RK + h_ * 64 + g8 * 8); pq[rep] = *(const u32x4*)(Z + (size_t)(row0_ + r) * ZM + C_RQ + h_ * 64 + g8 * 8); } \
        _Pragma("unroll") for (int rep = 0; rep < 4; ++rep) { const int pi = tid + 512 * rep; \
            pr[rep] = *(const u32x4*)(RS + ((size_t)(bh_ * 18 + cid_) * 128 + (pi >> 4)) * 128 + (pi & 15) * 8); \
            pvv[rep] = *(const u32x4*)(Z + (size_t)(row0_ + (pi >> 4)) * ZM + C_RV + h_ * 128 + (pi & 15) * 8); } } while (0)
    if ((int)blockIdx.x < nitems) RO_LOAD((int)blockIdx.x);
    for (int it = blockIdx.x; it < nitems; it += gridDim.x) {
        const int bh = it / nch, ci = it - bh * nch, b = bh >> 2, h = bh & 3, cid = l == 0 ? ci : ci + 2;
        const int row0 = cid < 2 ? NLAT + b * 256 + cid * 128 : b * 2048 + (cid - 2) * 128;
        const float lgf = log1pf(-exp2f(-p.in[9][(l * 2 + 0) * 4 + h])) * 1.4426950408889634f, lgb = log1pf(-exp2f(-p.in[9][(l * 2 + 1) * 4 + h])) * 1.4426950408889634f;
        __syncthreads();
#pragma unroll
        for (int rep = 0; rep < 2; ++rep) { const int pi = tid + 512 * rep, r = pi >> 3, g8 = pi & 7;
            *(LAS u32x4*)(Kl + r * 144 + g8 * 16) = pk[rep]; *(LAS u32x4*)(Ql + r * 144 + g8 * 16) = pq[rep]; }
#pragma unroll
        for (int rep = 0; rep < 4; ++rep) { const int pi = tid + 512 * rep;
            *(LAS u32x4*)(Rl + (pi >> 4) * 272 + (pi & 15) * 16) = pr[rep];
            *(LAS u32x4*)(Vt + (pi >> 4) * 288 + (pi & 15) * 16) = pvv[rep]; }
        __syncthreads();
        if (it + (int)gridDim.x < nitems) RO_LOAD(it + (int)gridDim.x);
        const int ii = wave * 16 + fr;
        bf16x8 Qf[2];
#pragma unroll
        for (int ks = 0; ks < 2; ++ks) Qf[ks] = *(const LAS bf16x8*)(Ql + ii * 144 + ks * 64 + fq * 16);
        f32x4 sc[8];
#pragma unroll
        for (int jt = 0; jt < 8; ++jt) { sc[jt] = (f32x4){0.f, 0.f, 0.f, 0.f};
#pragma unroll
            for (int ks = 0; ks < 2; ++ks) { const bf16x8 kf = *(const LAS bf16x8*)(Kl + (jt * 16 + fr) * 144 + ks * 64 + fq * 16); sc[jt] = MFMA16(kf, Qf[ks], sc[jt]); } }
#pragma unroll
        for (int jt = 0; jt < 8; ++jt)
#pragma unroll
            for (int i = 0; i < 4; ++i) { const int d = ii - (jt * 16 + 4 * fq + i); const float f = __builtin_amdgcn_exp2f(d > 0 ? (float)d * lgf : (float)(-d) * lgb); sc[jt][i] *= (d == 0 ? 2.0f : f); }
        f32x4 Y[8];
#pragma unroll
        for (int dt = 0; dt < 8; ++dt) Y[dt] = (f32x4){0.f, 0.f, 0.f, 0.f};
#pragma unroll
        for (int sI = 0; sI < 4; ++sI) {
            const bf16x8 pf = mk_frag(cvt_pk_bf16(sc[2 * sI][0], sc[2 * sI][1]), cvt_pk_bf16(sc[2 * sI][2], sc[2 * sI][3]), cvt_pk_bf16(sc[2 * sI + 1][0], sc[2 * sI + 1][1]), cvt_pk_bf16(sc[2 * sI + 1][2], sc[2 * sI + 1][3]));
#pragma unroll
            for (int dt = 0; dt < 8; ++dt) {
                Y[dt] = MFMA16(tr_frag(Vt, 288, (2 * sI) * 16 + 4 * fq, (2 * sI + 1) * 16 + 4 * fq, dt * 16, fr), pf, Y[dt]); }
        }
        u32x2 gwv[8];
#pragma unroll
        for (int dt = 0; dt < 8; ++dt) gwv[dt] = *(const u32x2*)(Z + (size_t)(row0 + ii) * ZM + C_RG + h * 128 + dt * 16 + 4 * fq);
        const float xf = __builtin_amdgcn_exp2f((float)(ii + 1) * lgf), xb = __builtin_amdgcn_exp2f((float)(128 - ii) * lgb);
#pragma unroll
        for (int ks = 0; ks < 4; ++ks) {
            const u32x4 qw = __builtin_bit_cast(u32x4, Qf[ks & 1]); const float xs = ks < 2 ? xf : xb;
            const bf16x8 qs = mk_frag(cvt_pk_bf16(bflo(qw.x) * xs, bfhi(qw.x) * xs), cvt_pk_bf16(bflo(qw.y) * xs, bfhi(qw.y) * xs), cvt_pk_bf16(bflo(qw.z) * xs, bfhi(qw.z) * xs), cvt_pk_bf16(bflo(qw.w) * xs, bfhi(qw.w) * xs));
#pragma unroll
            for (int dt = 0; dt < 8; ++dt) { const bf16x8 rf = *(const LAS bf16x8*)(Rl + (dt * 16 + fr) * 272 + ks * 64 + fq * 16); Y[dt] = MFMA16(rf, qs, Y[dt]); }
        }
        float ss = 0.f;
#pragma unroll
        for (int dt = 0; dt < 8; ++dt) ss += Y[dt][0] * Y[dt][0] + Y[dt][1] * Y[dt][1] + Y[dt][2] * Y[dt][2] + Y[dt][3] * Y[dt][3];
        ss += __shfl_xor(ss, 16); ss += __shfl_xor(ss, 32);
        const float rstd = rsqrtf(ss * (1.0f / 128.0f) + EPS);
#pragma unroll
        for (int dt = 0; dt < 8; ++dt) {
            const u32x2 gw = gwv[dt];
            const float g0 = bflo(gw.x), g1 = bfhi(gw.x), g2 = bflo(gw.y), g3 = bfhi(gw.y);
            u32x2 w; w.x = cvt_pk_bf16(g0 * sigmoidf_(g0) * Y[dt][0] * rstd, g1 * sigmoidf_(g1) * Y[dt][1] * rstd); w.y = cvt_pk_bf16(g2 * sigmoidf_(g2) * Y[dt][2] * rstd, g3 * sigmoidf_(g3) * Y[dt][3] * rstd);
            *(u32x2*)(YB + (size_t)(row0 + ii) * 1536 + h * 128 + dt * 16 + 4 * fq) = w; }
    }
#undef RO_LOAD
    __syncthreads();
}

#ifndef ATT_MFMA
#define ATT_MFMA 1
#endif
#ifndef RET_MFMA
#define RET_MFMA 1
#endif
constexpr int NPL = 10;
constexpr int NPH = 1 + 2 * NPL;

__global__ void __launch_bounds__(NTHREADS) mega(Params p) {
    extern __shared__ __attribute__((aligned(16))) unsigned char lds_raw[];
    cg::grid_group grid = cg::this_grid();
    const int wv = __builtin_amdgcn_readfirstlane(threadIdx.x >> 6);
    LAS unsigned char* lds = (LAS unsigned char*)lds_raw;
    const int G = gridDim.x, c = blockIdx.x;
    const int lo = p.ph_lo, hi = p.ph_hi;
    if (hi < 0) grid.sync();
    XcdBarrier xb; xb.bar = (unsigned*)(p.ws + OFF_BAR); xb.x = xb_xcc_id(); xb.st = (volatile LAS unsigned*)(lds + LDS_BYTES);
    { const int t0 = opaque_tid(wv); if (t0 == 0) { xb.st[0] = 0u; xb.st[1] = 0u; } __syncthreads(); if (t0 == 0) (void)xb_add(&xb.bar[XB_XCNT(xb.x)], 1u); }
    bf16_t* WB = (bf16_t*)(p.ws + OFF_WB);
    bf16_t* ZG = (bf16_t*)(p.ws + OFF_ZG); bf16_t* YB = (bf16_t*)(p.ws + OFF_YB); bf16_t* UB = (bf16_t*)(p.ws + OFF_UB);
#ifndef DUPMASK
#define DUPMASK 0
#endif
#define PHASE(ph, ...) if ((ph) >= lo && (ph) < hi) { __VA_ARGS__; if ((ph) + 1 < hi) xcd_barrier(xb, wv); }
#define PHASED(flag, ph, ...) if ((ph) >= lo && (ph) < hi) { __VA_ARGS__; if (DUPMASK & (flag)) { xcd_barrier(xb, wv); __VA_ARGS__; } if ((ph) + 1 < hi) xcd_barrier(xb, wv); }
    PHASED(64, 0, ph_setup(wv, p, lds_raw); __syncthreads(); ph_convert(wv, p, 0, lds_raw, 0, 0))
#pragma unroll 1
    for (int l = 0; l < 2; ++l) {
        const int b = 1 + l * NPL;
        const int Mrows = l == 0 ? RT_ : NLAT;
        PHASED(1, b + 0, if (l > 0) ph_convert(wv, p, l, lds_raw, 2, 0); ph_norm(wv, p, l, 0, RT_))
        PHASED(2, b + 1, { pg8::Gemm g{UB, WB + W_IN, 1024, 1024, 1024, 0, 0}; pg8::Order S; if (l == 0) S.init(RT_, ZM, G, c, 1); else { S.init(NLAT, ZM, G, c, 1); S.set_tail(NCTX, 4); }     pg8::EpiBf16<0> E{ZG, ZM, nullptr, nullptr, 0}; pg8::gemm_phase(wv, lds, g, S, E); })
        PHASE(b + 2, ph_prep(wv, p, l, Mrows, lds_raw))
        PHASED(4, b + 3, ph_ret_state(wv, p, l, lds_raw); ph_attn(wv, p, l, lds_raw))
        PHASED(8, b + 4, ph_ret_out(wv, p, l, lds_raw))
        PHASED(2, b + 5, { pg8::Gemm g{UB, WB + W_IN + (size_t)ZM * 1024, 1024, 1024, 1024, 0, 0}; pg8::Order S; S.init(Mrows, ZGW, G, c, 1); pg8::EpiBf16<2> E{ZG, ZGW, nullptr, nullptr, 0}; pg8::gemm_phase(wv, lds, g, S, E); })
        PHASED(32, b + 6, { pg8::Gemm g{YB, WB + W_BR, 1536, 512, 512, 512 * 2, (size_t)1024 * 512 * 2}; pg8::Order S; S.init(Mrows, 1024, G, c, 3); pg8::EpiMerge E{ZG, UB}; pg8::gemm_phase(wv, lds, g, S, E); if (l == 0) ph_shw(wv, p, 0, lds_raw, 64); })
        PHASE(b + 7, { pg8::Gemm g{UB, WB + W_O, 1024, 1024, 1024, 0, 0}; pg8::Order S; S.init(Mrows, 1024, G, c, 1); pg8::EpiRes E{p, l, 2048, 0, 1}; pg8::gemm_phase(wv, lds, g, S, E); })
        PHASED(16, b + 8, { pg8::Gemm g{(const bf16_t*)(p.ws + OFF_U2), WB + W_1, 1024, 1024, 1024, 0, 0}; pg8::Order S; S.init(Mrows, HID, G, c, 1); pg8::EpiBf16<1, true> E{(bf16_t*)(p.ws + OFF_H), HID, (const float*)(p.ws + OFF_SSQ2) + (size_t)l * RT_, (const float*)(p.ws + OFF_SHW2) + (size_t)l * 17 * 4096, 4096}; pg8::gemm_phase(wv, lds, g, S, E); })
        PHASE(b + 9, { pg8::Gemm g{(const bf16_t*)(p.ws + OFF_H), WB + W_2, HID, HID, HID, 0, 0}; pg8::Order S; S.init(Mrows, 1024, G, c, 1); pg8::EpiRes E{p, l, 5120, 1, 0}; pg8::gemm_phase(wv, lds, g, S, E); if (l == 0) { ph_convert(wv, p, 1, lds_raw, 1, 64); ph_shw(wv, p, 1, lds_raw, 64); } })
    }
    if (DUPMASK & 128) { for (int i = 0; i < 20; ++i) xcd_barrier(xb, wv); }
#undef PHASE
#undef PHASED
}

#ifndef MULTI_LAUNCH
#define MULTI_LAUNCH 0
#endif

extern "C" void kernel_launch(void* const* d_in, const int* in_sizes, int n_in, void* d_out, int out_size, void* d_ws, size_t ws_size, hipStream_t stream) {
    static int grid = 0;
    if (grid == 0) {
        if (ws_size < WS_END) { fprintf(stderr, "kernel_launch: workspace too small: %zu < %zu\n", ws_size, (size_t)WS_END); grid = -1; return; }
        int dev = 0, cus = 0, per_cu = 0;
        hipGetDevice(&dev);
        hipDeviceGetAttribute(&cus, hipDeviceAttributeMultiprocessorCount, dev);
        if (hipFuncSetAttribute((const void*)mega, hipFuncAttributeMaxDynamicSharedMemorySize, LDS_TOTAL) != hipSuccess) { fprintf(stderr, "kernel_launch: hipFuncSetAttribute failed\n"); grid = -1; return; }
        if (hipOccupancyMaxActiveBlocksPerMultiprocessor(&per_cu, (const void*)mega, NTHREADS, LDS_TOTAL) != hipSuccess || per_cu < 1) { fprintf(stderr, "kernel_launch: occupancy query gave %d\n", per_cu); per_cu = 1; }
        (void)hipGetLastError();
        grid = cus * per_cu;
        fprintf(stderr, "kernel_launch: grid %d (cus %d x %d)\n", grid, cus, per_cu);
    }
    if (grid < 0) return;
    if (hipMemsetAsync((char*)d_ws + OFF_BAR, 0, BAR_BYTES, stream) != hipSuccess) { fprintf(stderr, "kernel_launch: memset of barrier words failed\n"); return; }
    Params p{};
    for (int i = 0; i < 21; ++i) p.in[i] = (const float*)d_in[i];
    p.out = (float*)d_out; p.ws = (unsigned char*)d_ws;
#if MULTI_LAUNCH
    for (int ph = 0; ph < NPH; ++ph) {
        p.ph_lo = ph; p.ph_hi = ph + 1;
        hipLaunchKernelGGL(mega, dim3(grid), dim3(NTHREADS), LDS_TOTAL, stream, p);
    }
#else
    p.ph_lo = 0; p.ph_hi = NPH;
    void* args[] = {&p};
    hipError_t e = hipLaunchCooperativeKernel((const void*)mega, dim3(grid), dim3(NTHREADS), args, LDS_TOTAL, stream);
    if (e != hipSuccess) fprintf(stderr, "cooperative launch failed: %s (grid %d)\n", hipGetErrorString(e), grid);
#endif
}
```

```cpp
#include <hip/hip_runtime.h>
#include <hip/hip_cooperative_groups.h>
#include <cstdio>
namespace cg = cooperative_groups;

#define DEVI __device__ __forceinline__
#define LAS __attribute__((address_space(3)))
typedef unsigned short bf16_t;
typedef short bf16x8 __attribute__((ext_vector_type(8)));
typedef float f32x4 __attribute__((ext_vector_type(4)));
typedef unsigned u32x4 __attribute__((ext_vector_type(4)));
typedef unsigned u32x2 __attribute__((ext_vector_type(2)));

constexpr int DM = 1024, NB = 16, SEQ = 2048, LCTX = 256, NLAT = NB * SEQ, NCTX = NB * LCTX, RT_ = NLAT + NCTX;
constexpr int ZM = 2816, ZGW = 3072, INC = 5888, HID = 4096;
constexpr int C_RK = 0, C_RV = 256, C_AK = 768, C_AV = 896, C_RQ = 1024, C_RG = 1280, C_AQ = 1792, C_PU = 2304;
constexpr float EPS = 1e-6f;
constexpr int NTHREADS = 512;
constexpr int LDS_BYTES = 131072;
constexpr int LDS_TOTAL = LDS_BYTES + 16;

constexpr size_t OFF_ZG = 0;
constexpr size_t OFF_YB = OFF_ZG + (size_t)RT_ * ZGW * 2;
constexpr size_t OFF_UB = OFF_YB + (size_t)RT_ * 1536 * 2;
constexpr size_t OFF_XC = OFF_UB + (size_t)RT_ * 1024 * 2;
constexpr size_t OFF_WB = OFF_XC + (size_t)NCTX * 1024 * 4;
constexpr size_t W_IN = 0, W_BR = W_IN + (size_t)INC * 1024, W_O = W_BR + 3 * 512 * 1024, W_1 = W_O + 1024 * 1024, W_2 = W_1 + 4096 * 1024, W_END = W_2 + 4096 * 1024;
constexpr size_t OFF_RS = OFF_WB + W_END * 2;
constexpr size_t OFF_MOD = OFF_RS + (size_t)NB * 4 * 2 * 18 * 8192 * 2;
constexpr size_t OFF_RT = OFF_MOD + 2 * 17 * 6144 * 4;
constexpr size_t OFF_AT = OFF_RT + 2048 * 32 * 8;
constexpr size_t OFF_BAR = OFF_AT + 64 * 16 * 8;
constexpr size_t BAR_BYTES = 16384;
constexpr size_t OFF_SSQ2 = OFF_BAR + BAR_BYTES;
constexpr size_t OFF_SHW2 = OFF_SSQ2 + (size_t)2 * RT_ * 4;
constexpr size_t OFF_A2 = OFF_SHW2 + (size_t)2 * 17 * 4096 * 4;
constexpr size_t WS_END = OFF_A2 + (size_t)2 * 17 * 1024 * 4;
constexpr size_t OFF_U2 = OFF_ZG;
constexpr size_t OFF_H = OFF_ZG + (size_t)RT_ * 1024 * 2;
static_assert(OFF_H + (size_t)RT_ * 4096 * 2 <= OFF_XC, "H overlaps the ctx stream");

struct Params { const float* in[21]; float* out; unsigned char* ws; int ph_lo, ph_hi; };

DEVI int opaque_tid(int wv) { int ln; asm volatile("v_mbcnt_lo_u32_b32 %0, -1, 0\n\tv_mbcnt_hi_u32_b32 %0, -1, %0" : "=v"(ln)); return wv * 64 + ln; }
DEVI float bf2f(bf16_t h) { return __uint_as_float(((unsigned)h) << 16); }
DEVI float bflo(unsigned w) { return __uint_as_float(w << 16); }
DEVI float bfhi(unsigned w) { return __uint_as_float(w & 0xffff0000u); }
DEVI unsigned cvt_pk_bf16(float lo, float hi) { unsigned r; asm volatile("v_cvt_pk_bf16_f32 %0, %1, %2" : "=v"(r) : "v"(lo), "v"(hi)); return r; }
DEVI bf16_t f2bf(float f) { return (bf16_t)(cvt_pk_bf16(f, 0.f) & 0xffffu); }
DEVI float wsum(float v) {
#pragma unroll
    for (int o = 32; o > 0; o >>= 1) v += __shfl_xor(v, o);
    return v; }
DEVI float wmax(float v) {
#pragma unroll
    for (int o = 32; o > 0; o >>= 1) v = fmaxf(v, __shfl_xor(v, o));
    return v; }
DEVI float sigmoidf_(float g) { return __builtin_amdgcn_rcpf(1.0f + __expf(-g)); }
DEVI const float* xrow_in(const Params& p, int l, int row) {
    if (l == 0) return row < NLAT ? p.in[0] + (size_t)row * DM : p.in[2] + (size_t)(row - NLAT) * DM;
    return row < NLAT ? p.out + (size_t)row * DM : (const float*)(p.ws + OFF_XC) + (size_t)(row - NLAT) * DM;
}
DEVI float* xrow_out(const Params& p, int row) { return row < NLAT ? p.out + (size_t)row * DM : (float*)(p.ws + OFF_XC) + (size_t)(row - NLAT) * DM; }
DEVI const float* modrow(const Params& p, int l, int row) { const int bi = row < NLAT ? (row >> 11) : 16; return (const float*)(p.ws + OFF_MOD) + (size_t)(l * 17 + bi) * 6144; }

namespace pg8 {
constexpr int BM = 256, BK = 64, HALF = 128, HTB = HALF * BK * 2, NXCD = 8, WGM = 8;
DEVI int lds_byte(int r, int c) { const int st = (r >> 4) * 2 + (c >> 5), rr = r & 15, cc = c & 31, ob = rr * 64 + cc * 2; return st * 1024 + (ob ^ (((ob >> 9) & 1) << 5)); }
DEVI void stage_rc(int b, int& R, int& C) { const int st = b / 1024, sb = b % 1024, swz = sb ^ (((sb >> 9) & 1) << 5); R = (st >> 1) * 16 + swz / 64; C = (st & 1) * 32 + (swz % 64) / 2; }
DEVI int perm32(int rho) { const int n = rho >> 4, i = rho & 15; return 8 * (i >> 2) + 4 * n + (i & 3); }

struct Unit { int pm, pn, pb; };
struct Gemm { const bf16_t* A; const bf16_t* Bt; int lda, ldb, K; size_t a_bs, b_bs; };
struct Order {
    int nM, nN, nwg, G, c, nb, tail_units, tail_nN;
    DEVI void init(int M, int N, int G_, int c_, int nb_) { nM = M / BM; nN = N / BM; nwg = nM * nN; G = G_; c = c_; nb = nb_; tail_units = 0; tail_nN = 1; }
    DEVI void set_tail(int tail_rows, int tail_nN_) { tail_nN = tail_nN_; tail_units = (tail_rows / BM) * tail_nN_; }
    DEVI bool next(int i, Unit& u) const {
        const int ti = i / nb; u.pb = i - ti * nb;
        const long L = (long)ti * G + c;
        if (L >= nwg) { const int t = (int)(L - nwg); if (t >= tail_units) return false; u.pm = nM + t / tail_nN; u.pn = t % tail_nN; return true; }
        int wgid = (int)L; { const int q = nwg / NXCD, r = nwg % NXCD, xcd = wgid % NXCD, off = wgid / NXCD; wgid = (xcd < r ? xcd * (q + 1) : r * (q + 1) + (xcd - r) * q) + off; }
        const int nig = WGM * nN, gid = wgid / nig, fm = gid * WGM, gsz = (nM - fm) < WGM ? (nM - fm) : WGM;
        u.pm = fm + ((wgid % nig) % gsz); u.pn = (wgid % nig) / gsz; return true;
    }
};

template <int ACT  , bool RS = false  > struct EpiBf16 {
    static constexpr bool PERM = true;
    bf16_t* O; int ldc; const float* ssq; const float* shw; int ldshw;
    DEVI bool keep(const Unit&) const { return false; }
    DEVI void operator()(f32x4 (&acc)[2][2][4][2], const Unit& u, int wr, int wc, int fr, int fq) const {
        const int row0 = u.pm * BM + wr * 64 + fr, col0 = u.pn * BM + wc * 32 + 8 * fq;
        f32x4 sh[2][2];
        if (RS) { const int bi = u.pm * BM < NLAT ? (u.pm * BM) >> 11 : 16;
#pragma unroll
            for (int bj = 0; bj < 2; ++bj) { sh[bj][0] = *(const f32x4*)(shw + (size_t)bi * ldshw + col0 + bj * HALF); sh[bj][1] = *(const f32x4*)(shw + (size_t)bi * ldshw + col0 + bj * HALF + 4); } }
#pragma unroll
        for (int ai = 0; ai < 2; ++ai)
#pragma unroll
            for (int m = 0; m < 4; ++m) { bf16_t* rowp = O + (size_t)(row0 + ai * HALF + m * 16) * ldc + col0;
                float rstd = 1.0f; if (RS) rstd = rsqrtf(ssq[row0 + ai * HALF + m * 16] * (1.0f / 1024.0f) + EPS);
#pragma unroll
                for (int bj = 0; bj < 2; ++bj) { f32x4 v0 = acc[ai][bj][m][0], v1 = acc[ai][bj][m][1];
                    if (RS) { v0 = v0 * rstd + sh[bj][0]; v1 = v1 * rstd + sh[bj][1]; }
                    if (ACT == 1) {
#pragma unroll
                        for (int j = 0; j < 4; ++j) { const float a = fmaxf(v0[j], 0.f), b = fmaxf(v1[j], 0.f); v0[j] = a * a; v1[j] = b * b; } }
                    if (ACT == 2) {
#pragma unroll
                        for (int j = 0; j < 4; ++j) { v0[j] = 1.0f + __expf(-fminf(fmaxf(v0[j], -30.f), 30.f)); v1[j] = 1.0f + __expf(-fminf(fmaxf(v1[j], -30.f), 30.f)); } }
                    u32x4 w; w.x = cvt_pk_bf16(v0[0], v0[1]); w.y = cvt_pk_bf16(v0[2], v0[3]); w.z = cvt_pk_bf16(v1[0], v1[1]); w.w = cvt_pk_bf16(v1[2], v1[3]);
                    *(u32x4*)(rowp + bj * HALF) = w; } }
    }
};
struct EpiMerge {
    static constexpr bool PERM = true;
    const bf16_t* Gt; bf16_t* O;
    DEVI bool keep(const Unit& u) const { return u.pb < 2; }
    DEVI void operator()(f32x4 (&acc)[2][2][4][2], const Unit& u, int wr, int wc, int fr, int fq) const {
        const int row0 = u.pm * BM + wr * 64 + fr, col0 = u.pn * BM + wc * 32 + 8 * fq;
        const bool mid = u.pb < 2;
#pragma unroll
        for (int ai = 0; ai < 2; ++ai) {
            u32x4 ga[4][2], gb[4][2];
#pragma unroll
            for (int m = 0; m < 4; ++m)
#pragma unroll
                for (int bj = 0; bj < 2; ++bj) { const bf16_t* gp = Gt + (size_t)(row0 + ai * HALF + m * 16) * ZGW + u.pb * 1024 + col0 + bj * HALF;
                    ga[m][bj] = *(const u32x4*)gp; gb[m][bj] = mid ? *(const u32x4*)(gp + 1024) : (u32x4){0x3f803f80u, 0x3f803f80u, 0x3f803f80u, 0x3f803f80u}; }
#pragma unroll
            for (int m = 0; m < 4; ++m)
#pragma unroll
                for (int bj = 0; bj < 2; ++bj) {
                    const u32x4 a = ga[m][bj], b = gb[m][bj];
                    float sc[8];
                    sc[0] = bflo(b.x) * __builtin_amdgcn_rcpf(bflo(a.x)); sc[1] = bfhi(b.x) * __builtin_amdgcn_rcpf(bfhi(a.x)); sc[2] = bflo(b.y) * __builtin_amdgcn_rcpf(bflo(a.y)); sc[3] = bfhi(b.y) * __builtin_amdgcn_rcpf(bfhi(a.y));
                    sc[4] = bflo(b.z) * __builtin_amdgcn_rcpf(bflo(a.z)); sc[5] = bfhi(b.z) * __builtin_amdgcn_rcpf(bfhi(a.z)); sc[6] = bflo(b.w) * __builtin_amdgcn_rcpf(bflo(a.w)); sc[7] = bfhi(b.w) * __builtin_amdgcn_rcpf(bfhi(a.w));
                    f32x4 v0 = acc[ai][bj][m][0], v1 = acc[ai][bj][m][1];
#pragma unroll
                    for (int j = 0; j < 4; ++j) { v0[j] *= sc[j]; v1[j] *= sc[4 + j]; }
                    if (mid) { acc[ai][bj][m][0] = v0; acc[ai][bj][m][1] = v1; }
                    else { u32x4 w; w.x = cvt_pk_bf16(v0[0], v0[1]); w.y = cvt_pk_bf16(v0[2], v0[3]); w.z = cvt_pk_bf16(v1[0], v1[1]); w.w = cvt_pk_bf16(v1[2], v1[3]);
                        *(u32x4*)(O + (size_t)(row0 + ai * HALF + m * 16) * DM + col0 + bj * HALF) = w; }
                }
        }
    }
};
struct EpiRes {
    static constexpr bool PERM = false;
    Params p; int l, goff;
    int in_is_stream;
    int emit;
    DEVI bool keep(const Unit&) const { return false; }
    DEVI void operator()(f32x4 (&acc)[2][2][4][2], const Unit& u, int wr, int wc, int fr, int fq) const {
        const int row0 = u.pm * BM + wr * 64 + fr, col0 = u.pn * BM + wc * 32 + 4 * fq;
        const float* gr = modrow(p, l, u.pm * BM) + goff + col0;
        f32x4 gv[2][2];
#pragma unroll
        for (int bj = 0; bj < 2; ++bj)
#pragma unroll
            for (int n = 0; n < 2; ++n) gv[bj][n] = *(const f32x4*)(gr + bj * HALF + n * 16);
        f32x4 av[2][2];
        if (emit) { const int bi = u.pm * BM < NLAT ? (u.pm * BM) >> 11 : 16; const float* ar = (const float*)(p.ws + OFF_A2) + (size_t)(l * 17 + bi) * 1024 + col0;
#pragma unroll
            for (int bj = 0; bj < 2; ++bj)
#pragma unroll
                for (int n = 0; n < 2; ++n) av[bj][n] = *(const f32x4*)(ar + bj * HALF + n * 16); }
#pragma unroll
        for (int am = 0; am < 4; ++am) {
            const int ai = am >> 1, mb = (am & 1) * 2;
            f32x4 xv[2][2][2];
#pragma unroll
            for (int mm = 0; mm < 2; ++mm) { const int r = row0 + ai * HALF + (mb + mm) * 16;
                const float* xi = (in_is_stream ? (const float*)xrow_out(p, r) : xrow_in(p, l, r)) + col0;
#pragma unroll
                for (int bj = 0; bj < 2; ++bj)
#pragma unroll
                    for (int n = 0; n < 2; ++n) xv[mm][bj][n] = *(const f32x4*)(xi + bj * HALF + n * 16); }
#pragma unroll
            for (int mm = 0; mm < 2; ++mm) { const int m = mb + mm; const int r = row0 + ai * HALF + m * 16; float* xo = xrow_out(p, r) + col0;
                float ssp = 0.f;
#pragma unroll
                for (int bj = 0; bj < 2; ++bj)
#pragma unroll
                    for (int n = 0; n < 2; ++n) { const f32x4 xn = xv[mm][bj][n] + gv[bj][n] * acc[ai][bj][m][n]; *(f32x4*)(xo + bj * HALF + n * 16) = xn;
                        if (emit) { ssp += xn[0] * xn[0] + xn[1] * xn[1] + xn[2] * xn[2] + xn[3] * xn[3];
                            const f32x4 ua = xn * av[bj][n]; u32x2 w; w.x = cvt_pk_bf16(ua[0], ua[1]); w.y = cvt_pk_bf16(ua[2], ua[3]);
                            *(u32x2*)((bf16_t*)(p.ws + OFF_U2) + (size_t)r * DM + col0 + bj * HALF + n * 16) = w; } }
                if (emit) { ssp += __shfl_xor(ssp, 16); ssp += __shfl_xor(ssp, 32); if (fq == 0) atomicAdd((float*)(p.ws + OFF_SSQ2) + (size_t)l * RT_ + r, ssp); } }
        }
    }
};

template <class Epi>
DEVI void gemm_phase(const int wv, LAS unsigned char* lds, const Gemm g, const Order& S, const Epi& E) {
    const int tid = opaque_tid(wv), wid = wv, lane = tid & 63, wr = wid >> 2, wc = wid & 3, fr = lane & 15, fq = lane >> 4;
    const int K = g.K, nt = K / BK;
    unsigned voffA[2], voffB[2];
#pragma unroll
    for (int i = 0; i < 2; ++i) { int R, C; stage_rc(tid * 16 + i * 8192, R, C); const int Rb = Epi::PERM ? ((R & ~31) + perm32(R & 31)) : R;
        voffA[i] = (unsigned)(R * g.lda + C) * 2u; voffB[i] = (unsigned)(Rb * g.ldb + C) * 2u; }
    const size_t kstep = (size_t)(BK * 2);
    const size_t hstepA = (size_t)HALF * g.lda * 2, hstepB = (size_t)HALF * g.ldb * 2;
    const size_t tstepA = 2 * hstepA, tstepB = 2 * hstepB;
    const unsigned ldsw = (unsigned)wid * 1024u;
    const int aoff = lds_byte(wr * 64 + fr, fq * 8), boff = lds_byte(wc * 32 + fr, fq * 8);
#define PG8_SA(b, h) (((b) * 2 + (h)) * HTB)
#define PG8_SB(b, h) ((4 + (b) * 2 + (h)) * HTB)
#define PG8_STAGE(bufoff, gbase, voff) do { _Pragma("unroll") for (int _i = 0; _i < 2; ++_i) \
        __builtin_amdgcn_global_load_lds((const unsigned*)((const char*)(gbase) + (voff)[_i]), (LAS unsigned*)(lds + (bufoff) + ldsw + _i * 8192), 16, 0, 0); } while (0)
#define PG8_LDA(dst, b, h) do { _Pragma("unroll") for (int m = 0; m < 4; ++m) _Pragma("unroll") for (int k = 0; k < 2; ++k) dst[m][k] = *(const LAS bf16x8*)(lds + PG8_SA(b, h) + aoff + m * 2048 + k * 1024); } while (0)
#define PG8_LDB(dst, b, h) do { _Pragma("unroll") for (int n = 0; n < 2; ++n) _Pragma("unroll") for (int k = 0; k < 2; ++k) dst[n][k] = *(const LAS bf16x8*)(lds + PG8_SB(b, h) + boff + n * 2048 + k * 1024); } while (0)
#define PG8_MMA(ai, bj, At, Bt) do { __builtin_amdgcn_s_setprio(1); _Pragma("unroll") for (int m = 0; m < 4; ++m) _Pragma("unroll") for (int n = 0; n < 2; ++n) _Pragma("unroll") for (int k = 0; k < 2; ++k) \
        acc[ai][bj][m][n] = __builtin_amdgcn_mfma_f32_16x16x32_bf16(Bt[n][k], At[m][k], acc[ai][bj][m][n], 0, 0, 0); __builtin_amdgcn_s_setprio(0); } while (0)
#define PG8_WAIT_V(n) asm volatile("s_waitcnt vmcnt(" #n ")" ::: "memory")
#define PG8_WAIT_L(n) asm volatile("s_waitcnt lgkmcnt(" #n ")" ::: "memory")
#define PG8_BAR __builtin_amdgcn_s_barrier()
#define PG8_SCHED __builtin_amdgcn_sched_barrier(0)
    Unit cur, nxt; int ui = 0;
    if (!S.next(0, cur)) return;
    f32x4 acc[2][2][4][2];
#pragma unroll
    for (int a = 0; a < 2; ++a)
#pragma unroll
        for (int b = 0; b < 2; ++b)
#pragma unroll
            for (int m = 0; m < 4; ++m)
#pragma unroll
                for (int n = 0; n < 2; ++n) acc[a][b][m][n] = (f32x4){0.f, 0.f, 0.f, 0.f};
    bf16x8 At[4][2], B0[2][2], B1[2][2];
    const char* cA = (const char*)g.A + (size_t)cur.pb * g.a_bs + (size_t)cur.pm * tstepA; const char* cB = (const char*)g.Bt + (size_t)cur.pb * g.b_bs + (size_t)cur.pn * tstepB;
    PG8_STAGE(PG8_SB(0, 0), cB, voffB); PG8_STAGE(PG8_SA(0, 0), cA, voffA); PG8_STAGE(PG8_SB(0, 1), cB + hstepB, voffB); PG8_STAGE(PG8_SA(0, 1), cA + hstepA, voffA);
    if (wr == 1) PG8_BAR;
    PG8_WAIT_V(4); PG8_BAR;
    PG8_STAGE(PG8_SB(1, 0), cB + kstep, voffB); PG8_STAGE(PG8_SA(1, 0), cA + kstep, voffA); PG8_STAGE(PG8_SB(1, 1), cB + hstepB + kstep, voffB);
    PG8_WAIT_V(6); PG8_BAR;
    for (;;) {
        const bool has_next = S.next(ui + 1, nxt);
        const char* nA = has_next ? (const char*)g.A + (size_t)nxt.pb * g.a_bs + (size_t)nxt.pm * tstepA : cA;
        const char* nB = has_next ? (const char*)g.Bt + (size_t)nxt.pb * g.b_bs + (size_t)nxt.pn * tstepB : cB;
        for (int t = 0; t < nt; t += 2) {
            const bool last = (t == nt - 2);
            const char* a1 = cA + (size_t)(t + 1) * kstep;
            const char* a2 = last ? nA : cA + (size_t)(t + 2) * kstep; const char* b2 = last ? nB : cB + (size_t)(t + 2) * kstep;
            const char* a3 = a2 + kstep; const char* b3 = b2 + kstep;
            PG8_LDB(B0, 0, 0); PG8_SCHED; PG8_LDA(At, 0, 0); PG8_STAGE(PG8_SA(1, 1), a1 + hstepA, voffA);
            PG8_WAIT_L(8); PG8_BAR; PG8_WAIT_L(0); PG8_MMA(0, 0, At, B0); PG8_BAR; PG8_SCHED;
            PG8_LDB(B1, 0, 1); PG8_STAGE(PG8_SB(0, 0), b2, voffB);
            PG8_BAR; PG8_WAIT_L(0); PG8_MMA(0, 1, At, B1); PG8_BAR;
            PG8_LDA(At, 0, 1); PG8_STAGE(PG8_SA(0, 0), a2, voffA);
            PG8_BAR; PG8_WAIT_L(0); PG8_MMA(1, 0, At, B0); PG8_BAR; PG8_SCHED;
            PG8_STAGE(PG8_SB(0, 1), b2 + hstepB, voffB);
            PG8_WAIT_V(6); PG8_BAR; PG8_MMA(1, 1, At, B1); PG8_BAR;
            PG8_LDB(B0, 1, 0); PG8_SCHED; PG8_LDA(At, 1, 0); PG8_STAGE(PG8_SA(0, 1), a2 + hstepA, voffA);
            PG8_WAIT_L(8); PG8_BAR; PG8_WAIT_L(0); PG8_MMA(0, 0, At, B0); PG8_BAR; PG8_SCHED;
            PG8_LDB(B1, 1, 1); PG8_STAGE(PG8_SB(1, 0), b3, voffB);
            PG8_BAR; PG8_WAIT_L(0); PG8_MMA(0, 1, At, B1); PG8_BAR;
            PG8_LDA(At, 1, 1); PG8_STAGE(PG8_SA(1, 0), a3, voffA);
            PG8_BAR; PG8_WAIT_L(0); PG8_MMA(1, 0, At, B0); PG8_BAR; PG8_SCHED;
            PG8_STAGE(PG8_SB(1, 1), b3 + hstepB, voffB);
            PG8_WAIT_V(6); PG8_BAR; PG8_MMA(1, 1, At, B1); PG8_BAR;
        }
        E(acc, cur, wr, wc, fr, fq);
        if (!E.keep(cur)) {
#pragma unroll
            for (int a = 0; a < 2; ++a)
#pragma unroll
                for (int b = 0; b < 2; ++b)
#pragma unroll
                    for (int m = 0; m < 4; ++m)
#pragma unroll
                        for (int n = 0; n < 2; ++n) acc[a][b][m][n] = (f32x4){0.f, 0.f, 0.f, 0.f};
        }
        if (!has_next) break;
        cur = nxt; cA = nA; cB = nB; ++ui;
    }
    PG8_WAIT_V(0);
    if (wr == 0) PG8_BAR;
    PG8_BAR;
#undef PG8_SA
#undef PG8_SB
#undef PG8_STAGE
#undef PG8_LDA
#undef PG8_LDB
#undef PG8_MMA
#undef PG8_WAIT_V
#undef PG8_WAIT_L
#undef PG8_BAR
#undef PG8_SCHED
}
}

#define XB_TMO      128
#define XB_XCNT(j)  (256  + 64 * (j))
#define XB_XSUB(j)  (1280 + 64 * (j))
#define XB_XGEN(j)  (2304 + 64 * (j))
#define XB_TOP      3328
#define XB_TOPGEN   3392
#define XCD_BAR_WORDS 3456
#define XB_SPIN_CAP (1u << 22)
DEVI unsigned xb_ld(unsigned* p)              { return __hip_atomic_load(p, __ATOMIC_RELAXED, __HIP_MEMORY_SCOPE_AGENT); }
DEVI unsigned xb_add(unsigned* p, unsigned v) { return __hip_atomic_fetch_add(p, v, __ATOMIC_RELAXED, __HIP_MEMORY_SCOPE_AGENT); }
DEVI unsigned xb_xcc_id() { return (unsigned)__builtin_amdgcn_s_getreg((3 << 11) | 20) & 0xFu; }
#define XB_SPIN(cond, bar) do { unsigned _sp = 0; while (cond) { __builtin_amdgcn_s_sleep(1); \
    if ((++_sp & 255u) == 0u) { if (xb_ld(&(bar)[XB_TMO])) break; if (_sp > XB_SPIN_CAP) { atomicAdd(&(bar)[XB_TMO], 1u); break; } } } } while (0)
struct XcdBarrier { unsigned* bar; unsigned x; volatile LAS unsigned* st; };
DEVI void xcd_barrier_complete(unsigned* bar, unsigned x, unsigned& nloc, unsigned& nx) {
    const unsigned G = gridDim.x;
    unsigned sum, cnt, mine, sp = 0u;
    for (;;) {
        sum = 0u; cnt = 0u; mine = 0u;
#pragma unroll
        for (unsigned j = 0; j < 16; ++j) { const unsigned c = xb_ld(&bar[XB_XCNT(j)]); sum += c; cnt += (c > 0u) ? 1u : 0u; mine = (j == x) ? c : mine; }
        if (sum == G) break;
        __builtin_amdgcn_s_sleep(1);
        if ((++sp & 255u) == 0u) { if (xb_ld(&bar[XB_TMO])) break; if (sp > XB_SPIN_CAP) { atomicAdd(&bar[XB_TMO], 1u); break; } }
    }
    nloc = mine > 0u ? mine : 1u; nx = cnt > 0u ? cnt : 1u;
}
DEVI void xcd_barrier(const XcdBarrier& b, const int wv) {
    asm volatile("s_waitcnt vmcnt(0)" ::: "memory");
    __syncthreads();
    if (opaque_tid(wv) == 0) {
        unsigned* bar = b.bar;
        __builtin_amdgcn_s_waitcnt(0);
        unsigned nloc = b.st[0], nx = b.st[1];
        if (nloc == 0u) { xcd_barrier_complete(bar, b.x, nloc, nx); b.st[0] = nloc; b.st[1] = nx; }
        const unsigned old = xb_add(&bar[XB_XSUB(b.x)], 1u);
        const unsigned gen = old / nloc;
        if (old + 1u == (gen + 1u) * nloc) {
            __builtin_amdgcn_fence(__ATOMIC_RELEASE, "agent");
            asm volatile("s_waitcnt vmcnt(0)" ::: "memory");
            const unsigned og = xb_add(&bar[XB_TOP], 1u);
            const unsigned tg = og / nx;
            if (og + 1u == (tg + 1u) * nx) xb_add(&bar[XB_TOPGEN], 1u);
            else XB_SPIN(xb_ld(&bar[XB_TOPGEN]) == tg, bar);
            __builtin_amdgcn_fence(__ATOMIC_ACQUIRE, "agent");
            xb_add(&bar[XB_XGEN(b.x)], 1u);
            asm volatile("s_waitcnt vmcnt(0)" ::: "memory");
        } else {
            XB_SPIN(xb_ld(&bar[XB_XGEN(b.x)]) == gen, bar);
            __builtin_amdgcn_fence(__ATOMIC_ACQUIRE, "agent");
            asm volatile("s_waitcnt vmcnt(0)" ::: "memory");
        }
    }
    __syncthreads();
}

DEVI void ph_setup(const int wv, const Params& p, unsigned char* lds) {
    const int tid = opaque_tid(wv);
    for (int e = blockIdx.x * NTHREADS + tid; e < 2 * RT_; e += gridDim.x * NTHREADS) ((float*)(p.ws + OFF_SSQ2))[e] = 0.f;
    float* scv = (float*)lds;
    float* red = scv + 17 * 1024;
    for (int it = blockIdx.x; it < 192 + 130; it += gridDim.x) {
        if (it < 192) {
            const int l = it / 96, n0 = (it % 96) * 64;
            for (int e = tid; e < 17 * 1024; e += NTHREADS) { const int r = e >> 10, k = e & 1023; const float v = r < 16 ? p.in[1][r * 1024 + k] : p.in[3][k]; scv[e] = v / (1.0f + expf(-v)); }
            __syncthreads();
            const int n = tid & 63, kg = tid >> 6;
            float acc[17];
#pragma unroll
            for (int r = 0; r < 17; ++r) acc[r] = 0.f;
            const float* w = p.in[6] + (size_t)l * 1024 * 6144 + n0 + n;
            for (int k = kg * 128; k < kg * 128 + 128; ++k) { const float wv = w[(size_t)k * 6144];
#pragma unroll
                for (int r = 0; r < 17; ++r) acc[r] += scv[r * 1024 + k] * wv; }
#pragma unroll
            for (int r = 0; r < 17; ++r) red[(kg * 17 + r) * 64 + n] = acc[r];
            __syncthreads();
            float* mod = (float*)(p.ws + OFF_MOD);
            for (int e = tid; e < 17 * 64; e += NTHREADS) { const int r = e >> 6, nn = e & 63; float s = 0.f;
#pragma unroll
                for (int q = 0; q < 8; ++q) s += red[(q * 17 + r) * 64 + nn];
                mod[(size_t)(l * 17 + r) * 6144 + n0 + nn] = s + p.in[7][l * 6144 + n0 + nn]; }
            __syncthreads();
        } else {
            const int e = (it - 192) * NTHREADS + tid;
            if (e < 65536) { const int pos = e >> 5, i = e & 31; const float fr = powf(10000.0f, -(float)i / 32.0f); const float ang = (float)pos * fr;
                const double tr = (double)ang * 0.15915494309189535; const float tf = (float)(tr - floor(tr));
                ((float2*)(p.ws + OFF_RT))[e] = make_float2(__builtin_amdgcn_cosf(tf), __builtin_amdgcn_sinf(tf)); }
            else { const int e2 = e - 65536; const int pos = e2 >> 4, i = e2 & 15; const float fr = powf(10000.0f, -(float)i / 16.0f); const float ang = (float)pos * fr;
                const double tr = (double)ang * 0.15915494309189535; const float tf = (float)(tr - floor(tr));
                ((float2*)(p.ws + OFF_AT))[e2] = make_float2(__builtin_amdgcn_cosf(tf), __builtin_amdgcn_sinf(tf)); }
        }
    }
}

DEVI void ph_shw(const int wv, const Params& p, int l, unsigned char* lds, int blk_lo) {
    const int tid = opaque_tid(wv);
    if ((int)blockIdx.x < blk_lo) return;
    const int bx = blockIdx.x - blk_lo, nbx = gridDim.x - blk_lo;
    float* shv = (float*)lds;
    float* red = shv + 17 * 1024;
    const float* mod = (const float*)(p.ws + OFF_MOD) + (size_t)l * 17 * 6144;
    for (int e = bx * NTHREADS + tid; e < 17 * 1024; e += nbx * NTHREADS) { const int r = e >> 10, k = e & 1023;
        ((float*)(p.ws + OFF_A2))[(size_t)l * 17 * 1024 + e] = p.in[5][l * 1024 + k] * (1.0f + mod[(size_t)r * 6144 + 4096 + k]); }
    for (int it = bx; it < 256; it += nbx) {
        const int n0 = it * 16;
        __syncthreads();
        for (int e = tid; e < 17 * 1024; e += NTHREADS) { const int r = e >> 10, k = e & 1023; shv[e] = mod[(size_t)r * 6144 + 3072 + k]; }
        __syncthreads();
        const int n = tid & 15, kg = tid >> 4;
        float acc[17];
#pragma unroll
        for (int r = 0; r < 17; ++r) acc[r] = 0.f;
        const float* w = p.in[19] + (size_t)l * 1024 * 4096 + n0 + n;
#pragma unroll 8
        for (int k = kg * 32; k < kg * 32 + 32; ++k) { const float wvv = w[(size_t)k * 4096];
#pragma unroll
            for (int r = 0; r < 17; ++r) acc[r] += shv[r * 1024 + k] * wvv; }
#pragma unroll
        for (int r = 0; r < 17; ++r) red[(kg * 17 + r) * 16 + n] = acc[r];
        __syncthreads();
        for (int e = tid; e < 17 * 16; e += NTHREADS) { const int r = e >> 4, nn = e & 15; float sacc = 0.f;
#pragma unroll
            for (int q = 0; q < 32; ++q) sacc += red[(q * 17 + r) * 16 + nn];
            ((float*)(p.ws + OFF_SHW2))[(size_t)(l * 17 + r) * 4096 + n0 + nn] = sacc; }
    }
    __syncthreads();
}

DEVI void ph_convert(const int wv, const Params& p, int l, unsigned char* lds, int mode  , int blk_lo) {
    const int tid = opaque_tid(wv);
    float* tile = (float*)lds;
    bf16_t* WB = (bf16_t*)(p.ws + OFF_WB);
    if ((int)blockIdx.x < blk_lo) return;
    const int nitems = mode == 0 ? 4032 + 64 : (mode == 1 ? 3008 + 64 : 1024);
    for (int j = blockIdx.x - blk_lo; j < nitems; j += gridDim.x - blk_lo) {
        const int it = mode == 0 ? j : (mode == 1 ? (j < 3008 ? j : j + 1024) : j + 3008);
        if (it < 4032) {
            const float* src; bf16_t* dst; int K, N, t;
            if (it < 1472) { t = it; src = p.in[8] + (size_t)l * 1024 * INC; dst = WB + W_IN; K = 1024; N = INC; }
            else if (it < 1600) { t = it - 1472; src = p.in[15] + (size_t)l * 512 * 1024; dst = WB + W_BR; K = 512; N = 1024; }
            else if (it < 1728) { t = it - 1600; src = p.in[17] + (size_t)l * 512 * 1024; dst = WB + W_BR + 2 * 512 * 1024; K = 512; N = 1024; }
            else if (it < 1984) { t = it - 1728; src = p.in[18] + (size_t)l * 1024 * 1024; dst = WB + W_O; K = 1024; N = 1024; }
            else if (it < 3008) { t = it - 1984; src = p.in[19] + (size_t)l * 1024 * 4096; dst = WB + W_1; K = 1024; N = 4096; }
            else { t = it - 3008; src = p.in[20] + (size_t)l * 4096 * 1024; dst = WB + W_2; K = 4096; N = 1024; }
            const int nkt = K / 64, k0 = (t % nkt) * 64, n0 = (t / nkt) * 64;
            for (int e = tid; e < 4096; e += NTHREADS) { const int kk = e >> 6, nn = e & 63; tile[kk * 65 + nn] = src[(size_t)(k0 + kk) * N + n0 + nn]; }
            __syncthreads();
            for (int e = tid; e < 4096; e += NTHREADS) { const int nn = e >> 6, kk = e & 63; dst[(size_t)(n0 + nn) * K + k0 + kk] = f2bf(tile[kk * 65 + nn]); }
            __syncthreads();
        } else {
            const int pi = it - 4032, g = pi >> 4, n0 = (pi & 15) * 64;
            const int n = tid & 63, ig = tid >> 6;
            const float* pw = p.in[10] + (size_t)l * 4 * 128 * 128 + (size_t)g * 128 * 128 + (size_t)(ig * 16) * 128;
            const float* ps = p.in[11] + l * 512 + g * 128;
            const float* wpo = p.in[16] + (size_t)l * 512 * 1024 + (size_t)(g * 128) * 1024 + n0 + n;
            float acc[16];
#pragma unroll
            for (int ii = 0; ii < 16; ++ii) acc[ii] = 0.f;
            for (int j = 0; j < 128; ++j) { const float wv = ps[j] * wpo[(size_t)j * 1024];
#pragma unroll
                for (int ii = 0; ii < 16; ++ii) acc[ii] += pw[ii * 128 + j] * wv; }
            bf16_t* dst = WB + W_BR + 512 * 1024 + (size_t)(n0 + n) * 512 + g * 128 + ig * 16;
            u32x4 w0, w1;
            w0.x = cvt_pk_bf16(acc[0], acc[1]); w0.y = cvt_pk_bf16(acc[2], acc[3]); w0.z = cvt_pk_bf16(acc[4], acc[5]); w0.w = cvt_pk_bf16(acc[6], acc[7]);
            w1.x = cvt_pk_bf16(acc[8], acc[9]); w1.y = cvt_pk_bf16(acc[10], acc[11]); w1.z = cvt_pk_bf16(acc[12], acc[13]); w1.w = cvt_pk_bf16(acc[14], acc[15]);
            *(u32x4*)dst = w0; *(u32x4*)(dst + 8) = w1;
        }
    }
}

DEVI void ph_norm(const int wv, const Params& p, int l, int which  , int nrows) {
    const int tid = opaque_tid(wv); const int lane = tid & 63, wave = wv;
    const float* nw = p.in[which ? 5 : 4] + l * 1024;
    const int shoff = which ? 3072 : 0, scoff = which ? 4096 : 1024;
    bf16_t* U = (bf16_t*)(p.ws + OFF_UB);
    const int stride = gridDim.x * 8;
    for (int row0 = blockIdx.x * 8 + wave; row0 < nrows; row0 += 2 * stride) {
        f32x4 v[2][4]; float ss[2];
#pragma unroll
        for (int q = 0; q < 2; ++q) { const int row = row0 + q * stride; ss[q] = 0.f;
            if (row < nrows) { const float* x = which ? (const float*)xrow_out(p, row) : xrow_in(p, l, row);
#pragma unroll
                for (int i = 0; i < 4; ++i) v[q][i] = *(const f32x4*)(x + i * 256 + lane * 4); }
            else {
#pragma unroll
                for (int i = 0; i < 4; ++i) v[q][i] = (f32x4){0.f, 0.f, 0.f, 0.f}; } }
#pragma unroll
        for (int q = 0; q < 2; ++q) {
#pragma unroll
            for (int i = 0; i < 4; ++i) ss[q] += v[q][i][0] * v[q][i][0] + v[q][i][1] * v[q][i][1] + v[q][i][2] * v[q][i][2] + v[q][i][3] * v[q][i][3];
            ss[q] = wsum(ss[q]); }
#pragma unroll
        for (int q = 0; q < 2; ++q) { const int row = row0 + q * stride;
            if (row < nrows) { const float* md = modrow(p, l, row); const float rstd = rsqrtf(ss[q] * (1.0f / 1024.0f) + EPS);
#pragma unroll
                for (int i = 0; i < 4; ++i) { const int c = i * 256 + lane * 4;
                    const f32x4 w = *(const f32x4*)(nw + c), sc = *(const f32x4*)(md + scoff + c), sh = *(const f32x4*)(md + shoff + c);
                    const f32x4 o = v[q][i] * rstd * w * (1.0f + sc) + sh;
                    u32x2 pk; pk.x = cvt_pk_bf16(o[0], o[1]); pk.y = cvt_pk_bf16(o[2], o[3]);
                    *(u32x2*)(U + (size_t)row * 1024 + c) = pk; } } }
    }
}

DEVI void unpack8(const u32x4 w, float (&v)[8]) { v[0] = bflo(w.x); v[1] = bfhi(w.x); v[2] = bflo(w.y); v[3] = bfhi(w.y); v[4] = bflo(w.z); v[5] = bfhi(w.z); v[6] = bflo(w.w); v[7] = bfhi(w.w); }
DEVI void ph_prep(const int wv, const Params& p, int l, int nrows_pool, unsigned char* lds_raw) {
    const int tid = opaque_tid(wv); const int lane = tid & 63;
    bf16_t* Z = (bf16_t*)(p.ws + OFF_ZG); bf16_t* YB = (bf16_t*)(p.ws + OFF_YB);
    const float* RTf = (const float*)(p.ws + OFF_RT); const float* ATf = (const float*)(p.ws + OFF_AT);
    const int sub = lane & 7, hslot = lane >> 3, d0 = sub * 8;
    constexpr int NINST = RT_ * 6;
    for (int base = (blockIdx.x * 8 + wv) * 32; base < NINST; base += gridDim.x * 8 * 32) {
        u32x4 w[4]; int rowv[4], hhv[4], colv[4];
#pragma unroll
        for (int u = 0; u < 4; ++u) { const int hi = base + u * 8 + hslot; const int row = hi / 6, h6 = hi - row * 6, hh = h6 < 4 ? h6 : h6 + 4; rowv[u] = row; hhv[u] = hh;
            colv[u] = (hh < 4 ? C_RK + hh * 64 : hh < 8 ? C_RQ + (hh - 4) * 64 : hh < 10 ? C_AK + (hh - 8) * 64 : C_AQ + (hh - 10) * 64) + d0;
            w[u] = *(const u32x4*)(Z + (size_t)row * ZM + colv[u]); }
#pragma unroll
        for (int u = 0; u < 4; ++u) {
            const int row = rowv[u], hh = hhv[u]; const bool lat = row < NLAT; const int pos = row & 2047;
            float v[8]; unpack8(w[u], v);
            if (hh >= 8) {
                float ss = 0.f;
#pragma unroll
                for (int e = 0; e < 8; ++e) ss += v[e] * v[e];
                ss += __shfl_xor(ss, 1); ss += __shfl_xor(ss, 2); ss += __shfl_xor(ss, 4);
                const float rstd = rsqrtf(ss * (1.0f / 64.0f) + EPS) * (hh >= 10 ? 0.125f * 1.4426950408889634f : 1.0f);
                const float* wp = p.in[hh < 10 ? 13 : 12] + l * 64 + d0;
                const f32x4 w0 = *(const f32x4*)wp, w1 = *(const f32x4*)(wp + 4);
#pragma unroll
                for (int e = 0; e < 4; ++e) { v[e] *= rstd * w0[e]; v[4 + e] *= rstd * w1[e]; }
                if (lat) { const int pp = (sub & 4) ? (pos & 63) : (pos >> 6); const float* cp = ATf + (size_t)(pp * 16 + (d0 & 15)) * 2; const bool up = (sub & 2) != 0;
#pragma unroll
                    for (int e = 0; e < 8; ++e) { const float o = __shfl_xor(v[e], 2); const float cc = cp[2 * e], sn = cp[2 * e + 1]; v[e] = up ? o * sn + v[e] * cc : v[e] * cc - o * sn; } }
            } else {
                if (lat) { const float* cp = RTf + (size_t)(pos * 32 + (d0 & 31)) * 2; const bool up = (sub & 4) != 0;
#pragma unroll
                    for (int e = 0; e < 8; ++e) { const float o = __shfl_xor(v[e], 4); const float cc = cp[2 * e], sn = cp[2 * e + 1]; v[e] = up ? o * sn + v[e] * cc : v[e] * cc - o * sn; } }
                if (hh < 4) {
#pragma unroll
                    for (int e = 0; e < 8; ++e) v[e] *= 0.125f; }
            }
            u32x4 o; o.x = cvt_pk_bf16(v[0], v[1]); o.y = cvt_pk_bf16(v[2], v[3]); o.z = cvt_pk_bf16(v[4], v[5]); o.w = cvt_pk_bf16(v[6], v[7]);
            *(u32x4*)(Z + (size_t)row * ZM + colv[u]) = o;
        }
    }
    LAS unsigned char* slab = (LAS unsigned char*)lds_raw;
    for (int it = blockIdx.x; it < nrows_pool / 64; it += gridDim.x) {
        const int r0 = it * 64; int sbase, L;
        if (r0 < NLAT) { sbase = r0 & ~2047; L = 2048; } else { sbase = NLAT + ((r0 - NLAT) & ~255); L = 256; }
        const int t0 = r0 - sbase, lo_row = max(t0 - 8, 0), hi_row = min(t0 + 72, L), nchunks = (hi_row - lo_row) * 64;
        __syncthreads();
        for (int e = tid; e < nchunks; e += NTHREADS) { const int rr = e >> 6, cch = e & 63; *(LAS u32x4*)(slab + rr * 1024 + cch * 16) = *(const u32x4*)(Z + (size_t)(sbase + lo_row + rr) * ZM + C_PU + cch * 8); }
        __syncthreads();
#pragma unroll 2
        for (int o = tid; o < 4096; o += NTHREADS) {
            const int rr = o >> 6, cch = o & 63, hw = 1 << (cch >> 4), t = t0 + rr, lo = max(t - hw, 0), hi = min(t + hw, L);
            float sacc[8];
#pragma unroll
            for (int j = 0; j < 8; ++j) sacc[j] = 0.f;
            for (int tt = lo; tt < hi; ++tt) { float v[8]; unpack8(*(const LAS u32x4*)(slab + (tt - lo_row) * 1024 + cch * 16), v);
#pragma unroll
                for (int j = 0; j < 8; ++j) sacc[j] += v[j]; }
            float own[8]; unpack8(*(const LAS u32x4*)(slab + (t - lo_row) * 1024 + cch * 16), own);
            const float inv = 1.0f / (float)(hi - lo);
            u32x4 ow; ow.x = cvt_pk_bf16(sacc[0] * inv - own[0], sacc[1] * inv - own[1]); ow.y = cvt_pk_bf16(sacc[2] * inv - own[2], sacc[3] * inv - own[3]);
            ow.z = cvt_pk_bf16(sacc[4] * inv - own[4], sacc[5] * inv - own[5]); ow.w = cvt_pk_bf16(sacc[6] * inv - own[6], sacc[7] * inv - own[7]);
            *(u32x4*)(YB + (size_t)(sbase + t) * 1536 + 512 + cch * 8) = ow;
        }
    }
    __syncthreads();
}

#define MFMA16(X, Y, ACC) __builtin_amdgcn_mfma_f32_16x16x32_bf16((X), (Y), (ACC), 0, 0, 0)
DEVI bf16x8 mk_frag(unsigned a, unsigned b, unsigned c, unsigned d) { u32x4 w; w.x = a; w.y = b; w.z = c; w.w = d; return __builtin_bit_cast(bf16x8, w); }
typedef short s16x4 __attribute__((ext_vector_type(4)));
DEVI bf16x8 tr_frag(LAS unsigned char* tile, int rs, int rowA, int rowB, int n0, int fr) {
    const s16x4 a = __builtin_amdgcn_ds_read_tr16_b64_v4i16((LAS s16x4*)(tile + (rowA + (fr >> 2)) * rs + n0 * 2 + 8 * (fr & 3)));
    const s16x4 b = __builtin_amdgcn_ds_read_tr16_b64_v4i16((LAS s16x4*)(tile + (rowB + (fr >> 2)) * rs + n0 * 2 + 8 * (fr & 3)));
    return __builtin_shufflevector(a, b, 0, 1, 2, 3, 4, 5, 6, 7);
}
DEVI void lds_put8_t(LAS unsigned char* base, int rowstride, int r0, int j, const u32x4 w) {
    *(LAS unsigned short*)(base + (r0 + 0) * rowstride + 2 * j) = (unsigned short)(w.x & 0xffffu); *(LAS unsigned short*)(base + (r0 + 1) * rowstride + 2 * j) = (unsigned short)(w.x >> 16);
    *(LAS unsigned short*)(base + (r0 + 2) * rowstride + 2 * j) = (unsigned short)(w.y & 0xffffu); *(LAS unsigned short*)(base + (r0 + 3) * rowstride + 2 * j) = (unsigned short)(w.y >> 16);
    *(LAS unsigned short*)(base + (r0 + 4) * rowstride + 2 * j) = (unsigned short)(w.z & 0xffffu); *(LAS unsigned short*)(base + (r0 + 5) * rowstride + 2 * j) = (unsigned short)(w.z >> 16);
    *(LAS unsigned short*)(base + (r0 + 6) * rowstride + 2 * j) = (unsigned short)(w.w & 0xffffu); *(LAS unsigned short*)(base + (r0 + 7) * rowstride + 2 * j) = (unsigned short)(w.w >> 16);
}

DEVI void ph_attn(const int wv, const Params& p, int l, unsigned char* lds_raw, int it_lo = 0) {
    const int tid = opaque_tid(wv), lane = tid & 63, wave = wv, fr = lane & 15, fq = lane >> 4;
    LAS unsigned char* Kl = (LAS unsigned char*)lds_raw;
    LAS unsigned char* Vl = Kl + 18432;
    const bf16_t* Z = (const bf16_t*)(p.ws + OFF_ZG); bf16_t* YB = (bf16_t*)(p.ws + OFF_YB);
    const int nitems = 1024 + (l == 0 ? 128 : 0);
    for (int it = blockIdx.x + it_lo; it < nitems; it += gridDim.x) {
        int b, n, kvh, hp, qrow0; const bool isl = it < 1024;
        if (isl) { b = it >> 6; n = (it >> 2) & 15; kvh = (it >> 1) & 1; hp = it & 1; qrow0 = b * 2048 + n * 128; }
        else { const int i2 = it - 1024; b = i2 >> 3; n = (i2 >> 2) & 1; kvh = (i2 >> 1) & 1; hp = i2 & 1; qrow0 = NLAT + b * 256 + n * 128; }
        const int hq0 = kvh * 4 + hp * 2;
        const int ii = wave * 16 + fr;
        bf16x8 Qf[2][2];
#pragma unroll
        for (int g = 0; g < 2; ++g)
#pragma unroll
            for (int ks = 0; ks < 2; ++ks) Qf[g][ks] = *(const bf16x8*)(Z + (size_t)(qrow0 + ii) * ZM + C_AQ + (hq0 + g) * 64 + ks * 32 + fq * 8);
        {
            const int qpos = (qrow0 + ii) & 2047; const bool up = (fq & 2) != 0;
            float ssq[2]; float qv[2][2][8];
#pragma unroll
            for (int g = 0; g < 2; ++g) { ssq[g] = 0.f;
#pragma unroll
                for (int ks = 0; ks < 2; ++ks) { unpack8(__builtin_bit_cast(u32x4, Qf[g][ks]), qv[g][ks]);
#pragma unroll
                    for (int e = 0; e < 8; ++e) ssq[g] += qv[g][ks][e] * qv[g][ks][e]; }
                ssq[g] += __shfl_xor(ssq[g], 16); ssq[g] += __shfl_xor(ssq[g], 32);
                ssq[g] = rsqrtf(ssq[g] * (1.0f / 64.0f) + EPS) * (0.125f * 1.4426950408889634f); }
#pragma unroll
            for (int ks = 0; ks < 2; ++ks) {
                const float* wp = p.in[12] + l * 64 + ks * 32 + fq * 8;
                const f32x4 w0 = *(const f32x4*)wp, w1 = *(const f32x4*)(wp + 4);
                const float* cp = (const float*)(p.ws + OFF_AT) + (size_t)((ks ? (qpos & 63) : (qpos >> 6)) * 16 + (fq & 1) * 8) * 2;
                f32x4 cs[4];
                if (isl) {
#pragma unroll
                    for (int q4 = 0; q4 < 4; ++q4) cs[q4] = *(const f32x4*)(cp + 4 * q4); }
#pragma unroll
                for (int g = 0; g < 2; ++g) {
#pragma unroll
                    for (int e = 0; e < 8; ++e) { float v = qv[g][ks][e] * ssq[g] * (e < 4 ? w0[e & 3] : w1[e & 3]);
                        if (isl) { const float o = __shfl_xor(v, 32); const float cc = cs[e >> 1][(e & 1) * 2], sn = cs[e >> 1][(e & 1) * 2 + 1]; v = up ? o * sn + v * cc : v * cc - o * sn; }
                        qv[g][ks][e] = v; }
                    Qf[g][ks] = mk_frag(cvt_pk_bf16(qv[g][ks][0], qv[g][ks][1]), cvt_pk_bf16(qv[g][ks][2], qv[g][ks][3]), cvt_pk_bf16(qv[g][ks][4], qv[g][ks][5]), cvt_pk_bf16(qv[g][ks][6], qv[g][ks][7])); }
            }
        }
        float mrun[2], lrun[2]; f32x4 O[2][4];
#pragma unroll
        for (int g = 0; g < 2; ++g) { mrun[g] = p.in[14][l * 8 + hq0 + g] * 1.4426950408889634f; lrun[g] = fq == 0 ? 1.0f : 0.0f;
#pragma unroll
            for (int dt = 0; dt < 4; ++dt) O[g][dt] = (f32x4){0.f, 0.f, 0.f, 0.f}; }
        int t = isl ? (n > 0 ? 0 : 1) : 3;
        u32x4 pk[2], pv[2];
        { const int krow0 = t < 3 ? b * 2048 + (n - 1 + t) * 128 : NLAT + b * 256 + (t - 3) * 128;
#pragma unroll
          for (int rep = 0; rep < 2; ++rep) { const int pi = tid + 512 * rep;
              pk[rep] = *(const u32x4*)(Z + (size_t)(krow0 + (pi >> 3)) * ZM + C_AK + kvh * 64 + (pi & 7) * 8);
              pv[rep] = *(const u32x4*)(Z + (size_t)(krow0 + (pi >> 3)) * ZM + C_AV + kvh * 64 + (pi & 7) * 8); } }
        while (t < 5) {
            const int tn = (isl && t == 1 && n == 15) ? 3 : t + 1;
            const int msgn = t == 0 ? 1 : (t == 2 ? -1 : 0);
            const int dbase = 4 * fq - ii;
            __syncthreads();
#pragma unroll
            for (int rep = 0; rep < 2; ++rep) { const int pi = tid + 512 * rep;
                *(LAS u32x4*)(Kl + (pi >> 3) * 144 + (pi & 7) * 16) = pk[rep];
                *(LAS u32x4*)(Vl + (pi >> 3) * 144 + (pi & 7) * 16) = pv[rep]; }
            __syncthreads();
            if (tn < 5) { const int krow0 = tn < 3 ? b * 2048 + (n - 1 + tn) * 128 : NLAT + b * 256 + (tn - 3) * 128;
#pragma unroll
                for (int rep = 0; rep < 2; ++rep) { const int pi = tid + 512 * rep;
                    pk[rep] = *(const u32x4*)(Z + (size_t)(krow0 + (pi >> 3)) * ZM + C_AK + kvh * 64 + (pi & 7) * 8);
                    pv[rep] = *(const u32x4*)(Z + (size_t)(krow0 + (pi >> 3)) * ZM + C_AV + kvh * 64 + (pi & 7) * 8); } }
            const int jlo = msgn > 0 ? wave : 0, jhi = msgn < 0 ? wave : 7;
            f32x4 sc[2][8];
#pragma unroll
            for (int jt = 0; jt < 8; ++jt) {
                if (jt < jlo || jt > jhi) { sc[0][jt] = (f32x4){-INFINITY, -INFINITY, -INFINITY, -INFINITY}; sc[1][jt] = sc[0][jt]; continue; }
                sc[0][jt] = (f32x4){0.f, 0.f, 0.f, 0.f}; sc[1][jt] = (f32x4){0.f, 0.f, 0.f, 0.f};
#pragma unroll
                for (int ks = 0; ks < 2; ++ks) { const bf16x8 kf = *(const LAS bf16x8*)(Kl + (jt * 16 + fr) * 144 + ks * 64 + fq * 16);
                    sc[0][jt] = MFMA16(kf, Qf[0][ks], sc[0][jt]); sc[1][jt] = MFMA16(kf, Qf[1][ks], sc[1][jt]); } }
#pragma unroll
            for (int g = 0; g < 2; ++g) {
                float mx = mrun[g];
                if (msgn != 0) {
#pragma unroll
                    for (int jt = 0; jt < 8; ++jt)
#pragma unroll
                        for (int i = 0; i < 4; ++i) { const int d = msgn * (dbase + jt * 16 + i); sc[g][jt][i] = d >= 0 ? sc[g][jt][i] : -INFINITY; }
                }
#pragma unroll
                for (int jt = 0; jt < 8; ++jt) { mx = fmaxf(fmaxf(mx, sc[g][jt][0]), sc[g][jt][1]); mx = fmaxf(fmaxf(mx, sc[g][jt][2]), sc[g][jt][3]); }
                mx = fmaxf(mx, __shfl_xor(mx, 16)); mx = fmaxf(mx, __shfl_xor(mx, 32));
                const float alpha = __builtin_amdgcn_exp2f(mrun[g] - mx); mrun[g] = mx;
                float ps = 0.f;
#pragma unroll
                for (int jt = 0; jt < 8; ++jt)
#pragma unroll
                    for (int i = 0; i < 4; ++i) { const float e = __builtin_amdgcn_exp2f(sc[g][jt][i] - mx); sc[g][jt][i] = e; ps += e; }
                lrun[g] = lrun[g] * alpha + ps;
#pragma unroll
                for (int dt = 0; dt < 4; ++dt) O[g][dt] *= alpha;
            }
#pragma unroll
            for (int sI = 0; sI < 4; ++sI) {
                if (2 * sI + 1 < jlo || 2 * sI > jhi) continue;
                const bf16x8 pf0 = mk_frag(cvt_pk_bf16(sc[0][2 * sI][0], sc[0][2 * sI][1]), cvt_pk_bf16(sc[0][2 * sI][2], sc[0][2 * sI][3]), cvt_pk_bf16(sc[0][2 * sI + 1][0], sc[0][2 * sI + 1][1]), cvt_pk_bf16(sc[0][2 * sI + 1][2], sc[0][2 * sI + 1][3]));
                const bf16x8 pf1 = mk_frag(cvt_pk_bf16(sc[1][2 * sI][0], sc[1][2 * sI][1]), cvt_pk_bf16(sc[1][2 * sI][2], sc[1][2 * sI][3]), cvt_pk_bf16(sc[1][2 * sI + 1][0], sc[1][2 * sI + 1][1]), cvt_pk_bf16(sc[1][2 * sI + 1][2], sc[1][2 * sI + 1][3]));
#pragma unroll
                for (int dt = 0; dt < 4; ++dt) {
                    const bf16x8 vf = tr_frag(Vl, 144, (2 * sI) * 16 + 4 * fq, (2 * sI + 1) * 16 + 4 * fq, dt * 16, fr);
                    O[0][dt] = MFMA16(vf, pf0, O[0][dt]); O[1][dt] = MFMA16(vf, pf1, O[1][dt]); }
            }
            t = tn;
        }
#pragma unroll
        for (int g = 0; g < 2; ++g) { float lt = lrun[g]; lt += __shfl_xor(lt, 16); lt += __shfl_xor(lt, 32); const float inv = 1.0f / lt;
#pragma unroll
            for (int dt = 0; dt < 4; ++dt) { u32x2 w; w.x = cvt_pk_bf16(O[g][dt][0] * inv, O[g][dt][1] * inv); w.y = cvt_pk_bf16(O[g][dt][2] * inv, O[g][dt][3] * inv);
                *(u32x2*)(YB + (size_t)(qrow0 + ii) * 1536 + 1024 + (hq0 + g) * 64 + dt * 16 + 4 * fq) = w; } }
    }
    __syncthreads();
}

DEVI void ph_ret_state(const int wv, const Params& p, int l, unsigned char* lds_raw) {
    const int tid = opaque_tid(wv), lane = tid & 63, wave = wv, fr = lane & 15, fq = lane >> 4;
    LAS unsigned char* Kt = (LAS unsigned char*)lds_raw;
    LAS unsigned char* Vt = Kt + 18432;
    const bf16_t* Z = (const bf16_t*)(p.ws + OFF_ZG); bf16_t* RS = (bf16_t*)(p.ws + OFF_RS);
    for (int it = blockIdx.x; it < 256; it += gridDim.x) {
        const int b = it >> 4, h = (it >> 2) & 3, dir = (it >> 1) & 1, half = it & 1;
        const float e_ = p.in[9][(l * 2 + dir) * 4 + h];
        const float lg2 = log1pf(-exp2f(-e_)) * 1.4426950408889634f;
        const float gC = exp2f(128.0f * lg2);
        f32x4 R[2]; R[0] = (f32x4){0.f, 0.f, 0.f, 0.f}; R[1] = R[0];
        const int j0 = tid >> 3, g80 = tid & 7;
        const float wj0 = exp2f((float)(dir == 0 ? 127 - j0 : j0) * lg2), wj1 = exp2f((float)(dir == 0 ? 63 - j0 : j0 + 64) * lg2);
        u32x4 kwr[2], vwr[2];
        { const int cid0 = dir == 0 ? 0 : 1; const int row00 = NLAT + b * 256 + cid0 * 128;
#pragma unroll
          for (int rep = 0; rep < 2; ++rep) { const int jr = j0 + 64 * rep;
              kwr[rep] = *(const u32x4*)(Z + (size_t)(row00 + jr) * ZM + C_RK + h * 64 + g80 * 8);
              vwr[rep] = *(const u32x4*)(Z + (size_t)(row00 + jr) * ZM + C_RV + h * 128 + half * 64 + g80 * 8); } }
        for (int n = 0; n < 18; ++n) {
            const int cid = dir == 0 ? n : (n < 2 ? 1 - n : 19 - n);
#pragma unroll
            for (int tt = 0; tt < 2; ++tt) { const int t = wave * 2 + tt, dkt = t >> 2, dvt = t & 3;
                u32x2 w; w.x = cvt_pk_bf16(R[tt][0], R[tt][1]); w.y = cvt_pk_bf16(R[tt][2], R[tt][3]);
                *(u32x2*)(RS + ((size_t)((b * 4 + h) * 18 + cid) * 128 + half * 64 + dvt * 16 + fr) * 128 + dir * 64 + dkt * 16 + 4 * fq) = w; }
            if (n == 17) break;
            __syncthreads();
#pragma unroll
            for (int rep = 0; rep < 2; ++rep) { const int jr = j0 + 64 * rep; const float wj = rep ? wj1 : wj0;
                const u32x4 kw = kwr[rep];
                u32x4 ks; ks.x = cvt_pk_bf16(bflo(kw.x) * wj, bfhi(kw.x) * wj); ks.y = cvt_pk_bf16(bflo(kw.y) * wj, bfhi(kw.y) * wj); ks.z = cvt_pk_bf16(bflo(kw.z) * wj, bfhi(kw.z) * wj); ks.w = cvt_pk_bf16(bflo(kw.w) * wj, bfhi(kw.w) * wj);
                *(LAS u32x4*)(Kt + jr * 144 + g80 * 16) = ks; *(LAS u32x4*)(Vt + jr * 144 + g80 * 16) = vwr[rep]; }
            __syncthreads();
            if (n + 1 < 17) { const int n1 = n + 1; const int cid1 = dir == 0 ? n1 : (n1 < 2 ? 1 - n1 : 19 - n1);
                const int row01 = cid1 < 2 ? NLAT + b * 256 + cid1 * 128 : b * 2048 + (cid1 - 2) * 128;
#pragma unroll
                for (int rep = 0; rep < 2; ++rep) { const int jr = j0 + 64 * rep;
                    kwr[rep] = *(const u32x4*)(Z + (size_t)(row01 + jr) * ZM + C_RK + h * 64 + g80 * 8);
                    vwr[rep] = *(const u32x4*)(Z + (size_t)(row01 + jr) * ZM + C_RV + h * 128 + half * 64 + g80 * 8); } }
#pragma unroll
            for (int tt = 0; tt < 2; ++tt) { const int t = wave * 2 + tt, dkt = t >> 2, dvt = t & 3;
                f32x4 u = (f32x4){0.f, 0.f, 0.f, 0.f};
#pragma unroll
                for (int ks = 0; ks < 4; ++ks) { const bf16x8 xf = tr_frag(Kt, 144, ks * 32 + 8 * fq, ks * 32 + 8 * fq + 4, dkt * 16, fr), yf = tr_frag(Vt, 144, ks * 32 + 8 * fq, ks * 32 + 8 * fq + 4, dvt * 16, fr); u = MFMA16(xf, yf, u); }
                R[tt] = R[tt] * gC + u; }
        }
        __syncthreads();
    }
}

DEVI void ph_ret_out(const int wv, const Params& p, int l, unsigned char* lds_raw) {
    const int tid = opaque_tid(wv), lane = tid & 63, wave = wv, fr = lane & 15, fq = lane >> 4;
    LAS unsigned char* Kl = (LAS unsigned char*)lds_raw;
    LAS unsigned char* Ql = Kl + 18432;
    LAS unsigned char* Vt = Ql + 18432;
    LAS unsigned char* Rl = Vt + 36864;
    const bf16_t* Z = (const bf16_t*)(p.ws + OFF_ZG); const bf16_t* RS = (const bf16_t*)(p.ws + OFF_RS); bf16_t* YB = (bf16_t*)(p.ws + OFF_YB);
    const int nch = l == 0 ? 18 : 16, nitems = 64 * nch;
    u32x4 pk[2], pq[2], pr[4], pvv[4];
#define RO_LOAD(IT) do { const int bh_ = (IT) / nch, ci_ = (IT) - bh_ * nch, b_ = bh_ >> 2, h_ = bh_ & 3, cid_ = l == 0 ? ci_ : ci_ + 2; \
        const int row0_ = cid_ < 2 ? NLAT + b_ * 256 + cid_ * 128 : b_ * 2048 + (cid_ - 2) * 128; \
        _Pragma("unroll") for (int rep = 0; rep < 2; ++rep) { const int pi = tid + 512 * rep, r = pi >> 3, g8 = pi & 7; \
            pk[rep] = *(const u32x4*)(Z + (size_t)(row0_ + r) * ZM + C_RK + h_ * 64 + g8 * 8); pq[rep] = *(const u32x4*)(Z + (size_t)(row0_ + r) * ZM + C_RQ + h_ * 64 + g8 * 8); } \
        _Pragma("unroll") for (int rep = 0; rep < 4; ++rep) { const int pi = tid + 512 * rep; \
            pr[rep] = *(const u32x4*)(RS + ((size_t)(bh_ * 18 + cid_) * 128 + (pi >> 4)) * 128 + (pi & 15) * 8); \
            pvv[rep] = *(const u32x4*)(Z + (size_t)(row0_ + (pi >> 4)) * ZM + C_RV + h_ * 128 + (pi & 15) * 8); } } while (0)
    if ((int)blockIdx.x < nitems) RO_LOAD((int)blockIdx.x);
    for (int it = blockIdx.x; it < nitems; it += gridDim.x) {
        const int bh = it / nch, ci = it - bh * nch, b = bh >> 2, h = bh & 3, cid = l == 0 ? ci : ci + 2;
        const int row0 = cid < 2 ? NLAT + b * 256 + cid * 128 : b * 2048 + (cid - 2) * 128;
        const float lgf = log1pf(-exp2f(-p.in[9][(l * 2 + 0) * 4 + h])) * 1.4426950408889634f, lgb = log1pf(-exp2f(-p.in[9][(l * 2 + 1) * 4 + h])) * 1.4426950408889634f;
        __syncthreads();
#pragma unroll
        for (int rep = 0; rep < 2; ++rep) { const int pi = tid + 512 * rep, r = pi >> 3, g8 = pi & 7;
            *(LAS u32x4*)(Kl + r * 144 + g8 * 16) = pk[rep]; *(LAS u32x4*)(Ql + r * 144 + g8 * 16) = pq[rep]; }
#pragma unroll
        for (int rep = 0; rep < 4; ++rep) { const int pi = tid + 512 * rep;
            *(LAS u32x4*)(Rl + (pi >> 4) * 272 + (pi & 15) * 16) = pr[rep];
            *(LAS u32x4*)(Vt + (pi >> 4) * 288 + (pi & 15) * 16) = pvv[rep]; }
        __syncthreads();
        if (it + (int)gridDim.x < nitems) RO_LOAD(it + (int)gridDim.x);
        const int ii = wave * 16 + fr;
        bf16x8 Qf[2];
#pragma unroll
        for (int ks = 0; ks < 2; ++ks) Qf[ks] = *(const LAS bf16x8*)(Ql + ii * 144 + ks * 64 + fq * 16);
        if (cid >= 2) {
            const float* cp = (const float*)(p.ws + OFF_RT) + (size_t)(((row0 + ii) & 2047) * 32 + fq * 8) * 2;
            float x1[8], x2[8]; unpack8(__builtin_bit_cast(u32x4, Qf[0]), x1); unpack8(__builtin_bit_cast(u32x4, Qf[1]), x2);
            float y1[8], y2[8];
#pragma unroll
            for (int q4 = 0; q4 < 4; ++q4) { const f32x4 cs = *(const f32x4*)(cp + 4 * q4);
                y1[2 * q4] = x1[2 * q4] * cs[0] - x2[2 * q4] * cs[1]; y2[2 * q4] = x1[2 * q4] * cs[1] + x2[2 * q4] * cs[0];
                y1[2 * q4 + 1] = x1[2 * q4 + 1] * cs[2] - x2[2 * q4 + 1] * cs[3]; y2[2 * q4 + 1] = x1[2 * q4 + 1] * cs[3] + x2[2 * q4 + 1] * cs[2]; }
            Qf[0] = mk_frag(cvt_pk_bf16(y1[0], y1[1]), cvt_pk_bf16(y1[2], y1[3]), cvt_pk_bf16(y1[4], y1[5]), cvt_pk_bf16(y1[6], y1[7]));
            Qf[1] = mk_frag(cvt_pk_bf16(y2[0], y2[1]), cvt_pk_bf16(y2[2], y2[3]), cvt_pk_bf16(y2[4], y2[5]), cvt_pk_bf16(y2[6], y2[7]));
        }
        f32x4 sc[8];
#pragma unroll
        for (int jt = 0; jt < 8; ++jt) { sc[jt] = (f32x4){0.f, 0.f, 0.f, 0.f};
#pragma unroll
            for (int ks = 0; ks < 2; ++ks) { const bf16x8 kf = *(const LAS bf16x8*)(Kl + (jt * 16 + fr) * 144 + ks * 64 + fq * 16); sc[jt] = MFMA16(kf, Qf[ks], sc[jt]); } }
#pragma unroll
        for (int jt = 0; jt < 8; ++jt)
#pragma unroll
            for (int i = 0; i < 4; ++i) { const int d = ii - (jt * 16 + 4 * fq + i); const float f = __builtin_amdgcn_exp2f(d > 0 ? (float)d * lgf : (float)(-d) * lgb); sc[jt][i] *= (d == 0 ? 2.0f : f); }
        f32x4 Y[8];
#pragma unroll
        for (int dt = 0; dt < 8; ++dt) Y[dt] = (f32x4){0.f, 0.f, 0.f, 0.f};
#pragma unroll
        for (int sI = 0; sI < 4; ++sI) {
            const bf16x8 pf = mk_frag(cvt_pk_bf16(sc[2 * sI][0], sc[2 * sI][1]), cvt_pk_bf16(sc[2 * sI][2], sc[2 * sI][3]), cvt_pk_bf16(sc[2 * sI + 1][0], sc[2 * sI + 1][1]), cvt_pk_bf16(sc[2 * sI + 1][2], sc[2 * sI + 1][3]));
#pragma unroll
            for (int dt = 0; dt < 8; ++dt) {
                Y[dt] = MFMA16(tr_frag(Vt, 288, (2 * sI) * 16 + 4 * fq, (2 * sI + 1) * 16 + 4 * fq, dt * 16, fr), pf, Y[dt]); }
        }
        u32x2 gwv[8];
#pragma unroll
        for (int dt = 0; dt < 8; ++dt) gwv[dt] = *(const u32x2*)(Z + (size_t)(row0 + ii) * ZM + C_RG + h * 128 + dt * 16 + 4 * fq);
        const float xf = __builtin_amdgcn_exp2f((float)(ii + 1) * lgf), xb = __builtin_amdgcn_exp2f((float)(128 - ii) * lgb);
#pragma unroll
        for (int ks = 0; ks < 4; ++ks) {
            const u32x4 qw = __builtin_bit_cast(u32x4, Qf[ks & 1]); const float xs = ks < 2 ? xf : xb;
            const bf16x8 qs = mk_frag(cvt_pk_bf16(bflo(qw.x) * xs, bfhi(qw.x) * xs), cvt_pk_bf16(bflo(qw.y) * xs, bfhi(qw.y) * xs), cvt_pk_bf16(bflo(qw.z) * xs, bfhi(qw.z) * xs), cvt_pk_bf16(bflo(qw.w) * xs, bfhi(qw.w) * xs));
#pragma unroll
            for (int dt = 0; dt < 8; ++dt) { const bf16x8 rf = *(const LAS bf16x8*)(Rl + (dt * 16 + fr) * 272 + ks * 64 + fq * 16); Y[dt] = MFMA16(rf, qs, Y[dt]); }
        }
        float ss = 0.f;
#pragma unroll
        for (int dt = 0; dt < 8; ++dt) ss += Y[dt][0] * Y[dt][0] + Y[dt][1] * Y[dt][1] + Y[dt][2] * Y[dt][2] + Y[dt][3] * Y[dt][3];
        ss += __shfl_xor(ss, 16); ss += __shfl_xor(ss, 32);
        const float rstd = rsqrtf(ss * (1.0f / 128.0f) + EPS);
#pragma unroll
        for (int dt = 0; dt < 8; ++dt) {
            const u32x2 gw = gwv[dt];
            const float g0 = bflo(gw.x), g1 = bfhi(gw.x), g2 = bflo(gw.y), g3 = bfhi(gw.y);
            u32x2 w; w.x = cvt_pk_bf16(g0 * sigmoidf_(g0) * Y[dt][0] * rstd, g1 * sigmoidf_(g1) * Y[dt][1] * rstd); w.y = cvt_pk_bf16(g2 * sigmoidf_(g2) * Y[dt][2] * rstd, g3 * sigmoidf_(g3) * Y[dt][3] * rstd);
            *(u32x2*)(YB + (size_t)(row0 + ii) * 1536 + h * 128 + dt * 16 + 4 * fq) = w; }
    }
#undef RO_LOAD
    __syncthreads();
}

#ifndef ATT_MFMA
#define ATT_MFMA 1
#endif
#ifndef RET_MFMA
#define RET_MFMA 1
#endif
constexpr int NPL = 10;
constexpr int NPH = 1 + 2 * NPL;

__global__ void __launch_bounds__(NTHREADS) mega(Params p) {
    extern __shared__ __attribute__((aligned(16))) unsigned char lds_raw[];
    cg::grid_group grid = cg::this_grid();
    const int wv = __builtin_amdgcn_readfirstlane(threadIdx.x >> 6);
    LAS unsigned char* lds = (LAS unsigned char*)lds_raw;
    const int G = gridDim.x, c = blockIdx.x;
    const int lo = p.ph_lo, hi = p.ph_hi;
    if (hi < 0) grid.sync();
    XcdBarrier xb; xb.bar = (unsigned*)(p.ws + OFF_BAR); xb.x = xb_xcc_id(); xb.st = (volatile LAS unsigned*)(lds + LDS_BYTES);
    { const int t0 = opaque_tid(wv); if (t0 == 0) { xb.st[0] = 0u; xb.st[1] = 0u; } __syncthreads(); if (t0 == 0) (void)xb_add(&xb.bar[XB_XCNT(xb.x)], 1u); }
    bf16_t* WB = (bf16_t*)(p.ws + OFF_WB);
    bf16_t* ZG = (bf16_t*)(p.ws + OFF_ZG); bf16_t* YB = (bf16_t*)(p.ws + OFF_YB); bf16_t* UB = (bf16_t*)(p.ws + OFF_UB);
#ifndef DUPMASK
#define DUPMASK 0
#endif
#define PHASE(ph, ...) if ((ph) >= lo && (ph) < hi) { __VA_ARGS__; if ((ph) + 1 < hi) xcd_barrier(xb, wv); }
#define PHASED(flag, ph, ...) if ((ph) >= lo && (ph) < hi) { __VA_ARGS__; if (DUPMASK & (flag)) { xcd_barrier(xb, wv); __VA_ARGS__; } if ((ph) + 1 < hi) xcd_barrier(xb, wv); }
    PHASED(64, 0, ph_setup(wv, p, lds_raw); __syncthreads(); ph_convert(wv, p, 0, lds_raw, 0, 0))
#pragma unroll 1
    for (int l = 0; l < 2; ++l) {
        const int b = 1 + l * NPL;
        const int Mrows = l == 0 ? RT_ : NLAT;
        PHASED(1, b + 0, if (l > 0) ph_convert(wv, p, l, lds_raw, 2, 0); ph_norm(wv, p, l, 0, RT_))
        PHASED(2, b + 1, { pg8::Gemm g{UB, WB + W_IN, 1024, 1024, 1024, 0, 0}; pg8::Order S; if (l == 0) S.init(RT_, ZM, G, c, 1); else { S.init(NLAT, ZM, G, c, 1); S.set_tail(NCTX, 4); }     pg8::EpiBf16<0> E{ZG, ZM, nullptr, nullptr, 0}; pg8::gemm_phase(wv, lds, g, S, E); })
        PHASE(b + 2, ph_prep(wv, p, l, Mrows, lds_raw))
        PHASED(4, b + 3, ph_ret_state(wv, p, l, lds_raw); ph_attn(wv, p, l, lds_raw))
        PHASED(8, b + 4, ph_ret_out(wv, p, l, lds_raw))
        PHASED(2, b + 5, { pg8::Gemm g{UB, WB + W_IN + (size_t)ZM * 1024, 1024, 1024, 1024, 0, 0}; pg8::Order S; S.init(Mrows, ZGW, G, c, 1); pg8::EpiBf16<2> E{ZG, ZGW, nullptr, nullptr, 0}; pg8::gemm_phase(wv, lds, g, S, E); })
        PHASED(32, b + 6, { pg8::Gemm g{YB, WB + W_BR, 1536, 512, 512, 512 * 2, (size_t)1024 * 512 * 2}; pg8::Order S; S.init(Mrows, 1024, G, c, 3); pg8::EpiMerge E{ZG, UB}; pg8::gemm_phase(wv, lds, g, S, E); if (l == 0) ph_shw(wv, p, 0, lds_raw, 64); })
        PHASE(b + 7, { pg8::Gemm g{UB, WB + W_O, 1024, 1024, 1024, 0, 0}; pg8::Order S; S.init(Mrows, 1024, G, c, 1); pg8::EpiRes E{p, l, 2048, 0, 1}; pg8::gemm_phase(wv, lds, g, S, E); })
        PHASED(16, b + 8, { pg8::Gemm g{(const bf16_t*)(p.ws + OFF_U2), WB + W_1, 1024, 1024, 1024, 0, 0}; pg8::Order S; S.init(Mrows, HID, G, c, 1); pg8::EpiBf16<1, true> E{(bf16_t*)(p.ws + OFF_H), HID, (const float*)(p.ws + OFF_SSQ2) + (size_t)l * RT_, (const float*)(p.ws + OFF_SHW2) + (size_t)l * 17 * 4096, 4096}; pg8::gemm_phase(wv, lds, g, S, E); })
        PHASE(b + 9, { pg8::Gemm g{(const bf16_t*)(p.ws + OFF_H), WB + W_2, HID, HID, HID, 0, 0}; pg8::Order S; S.init(Mrows, 1024, G, c, 1); pg8::EpiRes E{p, l, 5120, 1, 0}; pg8::gemm_phase(wv, lds, g, S, E); if (l == 0) { ph_convert(wv, p, 1, lds_raw, 1, 64); ph_shw(wv, p, 1, lds_raw, 64); } })
    }
    if (DUPMASK & 128) { for (int i = 0; i < 20; ++i) xcd_barrier(xb, wv); }
#undef PHASE
#undef PHASED
}

#ifndef MULTI_LAUNCH
#define MULTI_LAUNCH 0
#endif

extern "C" void kernel_launch(void* const* d_in, const int* in_sizes, int n_in, void* d_out, int out_size, void* d_ws, size_t ws_size, hipStream_t stream) {
    static int grid = 0;
    if (grid == 0) {
        if (ws_size < WS_END) { fprintf(stderr, "kernel_launch: workspace too small: %zu < %zu\n", ws_size, (size_t)WS_END); grid = -1; return; }
        int dev = 0, cus = 0, per_cu = 0;
        hipGetDevice(&dev);
        hipDeviceGetAttribute(&cus, hipDeviceAttributeMultiprocessorCount, dev);
        if (hipFuncSetAttribute((const void*)mega, hipFuncAttributeMaxDynamicSharedMemorySize, LDS_TOTAL) != hipSuccess) { fprintf(stderr, "kernel_launch: hipFuncSetAttribute failed\n"); grid = -1; return; }
        if (hipOccupancyMaxActiveBlocksPerMultiprocessor(&per_cu, (const void*)mega, NTHREADS, LDS_TOTAL) != hipSuccess || per_cu < 1) { fprintf(stderr, "kernel_launch: occupancy query gave %d\n", per_cu); per_cu = 1; }
        (void)hipGetLastError();
        grid = cus * per_cu;
        fprintf(stderr, "kernel_launch: grid %d (cus %d x %d)\n", grid, cus, per_cu);
    }
    if (grid < 0) return;
    if (hipMemsetAsync((char*)d_ws + OFF_BAR, 0, BAR_BYTES, stream) != hipSuccess) { fprintf(stderr, "kernel_launch: memset of barrier words failed\n"); return; }
    Params p{};
    for (int i = 0; i < 21; ++i) p.in[i] = (const float*)d_in[i];
    p.out = (float*)d_out; p.ws = (unsigned char*)d_ws;
#if MULTI_LAUNCH
    for (int ph = 0; ph < NPH; ++ph) {
        p.ph_lo = ph; p.ph_hi = ph + 1;
        hipLaunchKernelGGL(mega, dim3(grid), dim3(NTHREADS), LDS_TOTAL, stream, p);
    }
#else
    p.ph_lo = 0; p.ph_hi = NPH;
    void* args[] = {&p};
    hipError_t e = hipLaunchCooperativeKernel((const void*)mega, dim3(grid), dim3(NTHREADS), args, LDS_TOTAL, stream);
    if (e != hipSuccess) fprintf(stderr, "cooperative launch failed: %s (grid %d)\n", hipGetErrorString(e), grid);
#endif
}
```

```cpp
#include <hip/hip_runtime.h>
#include <hip/hip_cooperative_groups.h>
#include <cstdio>
namespace cg = cooperative_groups;

#define DEVI __device__ __forceinline__
#define LAS __attribute__((address_space(3)))
typedef unsigned short bf16_t;
typedef short bf16x8 __attribute__((ext_vector_type(8)));
typedef float f32x4 __attribute__((ext_vector_type(4)));
typedef unsigned u32x4 __attribute__((ext_vector_type(4)));
typedef unsigned u32x2 __attribute__((ext_vector_type(2)));

constexpr int DM = 1024, NB = 16, SEQ = 2048, LCTX = 256, NLAT = NB * SEQ, NCTX = NB * LCTX, RT_ = NLAT + NCTX;
constexpr int ZM = 2816, ZGW = 3072, INC = 5888, HID = 4096;
constexpr int C_RK = 0, C_RV = 256, C_AK = 768, C_AV = 896, C_RQ = 1024, C_RG = 1280, C_AQ = 1792, C_PU = 2304;
constexpr float EPS = 1e-6f;
constexpr int NTHREADS = 512;
constexpr int LDS_BYTES = 131072;
constexpr int LDS_TOTAL = LDS_BYTES + 16;

constexpr size_t OFF_ZG = 0;
constexpr size_t OFF_YB = OFF_ZG + (size_t)RT_ * ZGW * 2;
constexpr size_t OFF_UB = OFF_YB + (size_t)RT_ * 1536 * 2;
constexpr size_t OFF_XC = OFF_UB + (size_t)RT_ * 1024 * 2;
constexpr size_t OFF_WB = OFF_XC + (size_t)NCTX * 1024 * 4;
constexpr size_t W_IN = 0, W_BR = W_IN + (size_t)INC * 1024, W_O = W_BR + 3 * 512 * 1024, W_1 = W_O + 1024 * 1024, W_2 = W_1 + 4096 * 1024, W_END = W_2 + 4096 * 1024;
constexpr size_t OFF_RS = OFF_WB + W_END * 2;
constexpr size_t OFF_MOD = OFF_RS + (size_t)NB * 4 * 2 * 18 * 8192 * 2;
constexpr size_t OFF_RT = OFF_MOD + 2 * 17 * 6144 * 4;
constexpr size_t OFF_AT = OFF_RT + 2048 * 32 * 8;
constexpr size_t OFF_BAR = OFF_AT + 64 * 16 * 8;
constexpr size_t BAR_BYTES = 16384;
constexpr size_t OFF_SSQ2 = OFF_BAR + BAR_BYTES;
constexpr size_t OFF_SHW2 = OFF_SSQ2 + (size_t)2 * RT_ * 4;
constexpr size_t OFF_A2 = OFF_SHW2 + (size_t)2 * 17 * 4096 * 4;
constexpr size_t WS_END = OFF_A2 + (size_t)2 * 17 * 1024 * 4;
constexpr size_t OFF_U2 = OFF_ZG;
constexpr size_t OFF_H = OFF_ZG + (size_t)RT_ * 1024 * 2;
static_assert(OFF_H + (size_t)RT_ * 4096 * 2 <= OFF_XC, "H overlaps the ctx stream");

struct Params { const float* in[21]; float* out; unsigned char* ws; int ph_lo, ph_hi; };

DEVI int opaque_tid(int wv) { int ln; asm volatile("v_mbcnt_lo_u32_b32 %0, -1, 0\n\tv_mbcnt_hi_u32_b32 %0, -1, %0" : "=v"(ln)); return wv * 64 + ln; }
DEVI float bf2f(bf16_t h) { return __uint_as_float(((unsigned)h) << 16); }
DEVI float bflo(unsigned w) { return __uint_as_float(w << 16); }
DEVI float bfhi(unsigned w) { return __uint_as_float(w & 0xffff0000u); }
DEVI unsigned cvt_pk_bf16(float lo, float hi) { unsigned r; asm volatile("v_cvt_pk_bf16_f32 %0, %1, %2" : "=v"(r) : "v"(lo), "v"(hi)); return r; }
DEVI bf16_t f2bf(float f) { return (bf16_t)(cvt_pk_bf16(f, 0.f) & 0xffffu); }
DEVI float wsum(float v) {
#pragma unroll
    for (int o = 32; o > 0; o >>= 1) v += __shfl_xor(v, o);
    return v; }
DEVI float wmax(float v) {
#pragma unroll
    for (int o = 32; o > 0; o >>= 1) v = fmaxf(v, __shfl_xor(v, o));
    return v; }
DEVI float sigmoidf_(float g) { return __builtin_amdgcn_rcpf(1.0f + __expf(-g)); }
DEVI const float* xrow_in(const Params& p, int l, int row) {
    if (l == 0) return row < NLAT ? p.in[0] + (size_t)row * DM : p.in[2] + (size_t)(row - NLAT) * DM;
    return row < NLAT ? p.out + (size_t)row * DM : (const float*)(p.ws + OFF_XC) + (size_t)(row - NLAT) * DM;
}
DEVI float* xrow_out(const Params& p, int row) { return row < NLAT ? p.out + (size_t)row * DM : (float*)(p.ws + OFF_XC) + (size_t)(row - NLAT) * DM; }
DEVI const float* modrow(const Params& p, int l, int row) { const int bi = row < NLAT ? (row >> 11) : 16; return (const float*)(p.ws + OFF_MOD) + (size_t)(l * 17 + bi) * 6144; }

namespace pg8 {
constexpr int BM = 256, BK = 64, HALF = 128, HTB = HALF * BK * 2, NXCD = 8, WGM = 8;
DEVI int lds_byte(int r, int c) { const int st = (r >> 4) * 2 + (c >> 5), rr = r & 15, cc = c & 31, ob = rr * 64 + cc * 2; return st * 1024 + (ob ^ (((ob >> 9) & 1) << 5)); }
DEVI void stage_rc(int b, int& R, int& C) { const int st = b / 1024, sb = b % 1024, swz = sb ^ (((sb >> 9) & 1) << 5); R = (st >> 1) * 16 + swz / 64; C = (st & 1) * 32 + (swz % 64) / 2; }
DEVI int perm32(int rho) { const int n = rho >> 4, i = rho & 15; return 8 * (i >> 2) + 4 * n + (i & 3); }

struct Unit { int pm, pn, pb; };
struct Gemm { const bf16_t* A; const bf16_t* Bt; int lda, ldb, K; size_t a_bs, b_bs; };
struct Order {
    int nM, nN, nwg, G, c, nb, tail_units, tail_nN;
    DEVI void init(int M, int N, int G_, int c_, int nb_) { nM = M / BM; nN = N / BM; nwg = nM * nN; G = G_; c = c_; nb = nb_; tail_units = 0; tail_nN = 1; }
    DEVI void set_tail(int tail_rows, int tail_nN_) { tail_nN = tail_nN_; tail_units = (tail_rows / BM) * tail_nN_; }
    DEVI bool next(int i, Unit& u) const {
        const int ti = i / nb; u.pb = i - ti * nb;
        const long L = (long)ti * G + c;
        if (L >= nwg) { const int t = (int)(L - nwg); if (t >= tail_units) return false; u.pm = nM + t / tail_nN; u.pn = t % tail_nN; return true; }
        int wgid = (int)L; { const int q = nwg / NXCD, r = nwg % NXCD, xcd = wgid % NXCD, off = wgid / NXCD; wgid = (xcd < r ? xcd * (q + 1) : r * (q + 1) + (xcd - r) * q) + off; }
        const int nig = WGM * nN, gid = wgid / nig, fm = gid * WGM, gsz = (nM - fm) < WGM ? (nM - fm) : WGM;
        u.pm = fm + ((wgid % nig) % gsz); u.pn = (wgid % nig) / gsz; return true;
    }
};

template <int ACT  , bool RS = false  > struct EpiBf16 {
    static constexpr bool PERM = true;
    bf16_t* O; int ldc; const float* ssq; const float* shw; int ldshw;
    DEVI bool keep(const Unit&) const { return false; }
    DEVI void operator()(f32x4 (&acc)[2][2][4][2], const Unit& u, int wr, int wc, int fr, int fq) const {
        const int row0 = u.pm * BM + wr * 64 + fr, col0 = u.pn * BM + wc * 32 + 8 * fq;
        f32x4 sh[2][2];
        if (RS) { const int bi = u.pm * BM < NLAT ? (u.pm * BM) >> 11 : 16;
#pragma unroll
            for (int bj = 0; bj < 2; ++bj) { sh[bj][0] = *(const f32x4*)(shw + (size_t)bi * ldshw + col0 + bj * HALF); sh[bj][1] = *(const f32x4*)(shw + (size_t)bi * ldshw + col0 + bj * HALF + 4); } }
#pragma unroll
        for (int ai = 0; ai < 2; ++ai)
#pragma unroll
            for (int m = 0; m < 4; ++m) { bf16_t* rowp = O + (size_t)(row0 + ai * HALF + m * 16) * ldc + col0;
                float rstd = 1.0f; if (RS) rstd = rsqrtf(ssq[row0 + ai * HALF + m * 16] * (1.0f / 1024.0f) + EPS);
#pragma unroll
                for (int bj = 0; bj < 2; ++bj) { f32x4 v0 = acc[ai][bj][m][0], v1 = acc[ai][bj][m][1];
                    if (RS) { v0 = v0 * rstd + sh[bj][0]; v1 = v1 * rstd + sh[bj][1]; }
                    if (ACT == 1) {
#pragma unroll
                        for (int j = 0; j < 4; ++j) { const float a = fmaxf(v0[j], 0.f), b = fmaxf(v1[j], 0.f); v0[j] = a * a; v1[j] = b * b; } }
                    if (ACT == 2) {
#pragma unroll
                        for (int j = 0; j < 4; ++j) { v0[j] = 1.0f + __expf(-fminf(fmaxf(v0[j], -30.f), 30.f)); v1[j] = 1.0f + __expf(-fminf(fmaxf(v1[j], -30.f), 30.f)); } }
                    u32x4 w; w.x = cvt_pk_bf16(v0[0], v0[1]); w.y = cvt_pk_bf16(v0[2], v0[3]); w.z = cvt_pk_bf16(v1[0], v1[1]); w.w = cvt_pk_bf16(v1[2], v1[3]);
                    *(u32x4*)(rowp + bj * HALF) = w; } }
    }
};
struct EpiMerge {
    static constexpr bool PERM = true;
    const bf16_t* Gt; bf16_t* O;
    DEVI bool keep(const Unit& u) const { return u.pb < 2; }
    DEVI void operator()(f32x4 (&acc)[2][2][4][2], const Unit& u, int wr, int wc, int fr, int fq) const {
        const int row0 = u.pm * BM + wr * 64 + fr, col0 = u.pn * BM + wc * 32 + 8 * fq;
        const bool mid = u.pb < 2;
#pragma unroll
        for (int ai = 0; ai < 2; ++ai) {
            u32x4 ga[4][2], gb[4][2];
#pragma unroll
            for (int m = 0; m < 4; ++m)
#pragma unroll
                for (int bj = 0; bj < 2; ++bj) { const bf16_t* gp = Gt + (size_t)(row0 + ai * HALF + m * 16) * ZGW + u.pb * 1024 + col0 + bj * HALF;
                    ga[m][bj] = *(const u32x4*)gp; gb[m][bj] = mid ? *(const u32x4*)(gp + 1024) : (u32x4){0x3f803f80u, 0x3f803f80u, 0x3f803f80u, 0x3f803f80u}; }
#pragma unroll
            for (int m = 0; m < 4; ++m)
#pragma unroll
                for (int bj = 0; bj < 2; ++bj) {
                    const u32x4 a = ga[m][bj], b = gb[m][bj];
                    float sc[8];
                    sc[0] = bflo(b.x) * __builtin_amdgcn_rcpf(bflo(a.x)); sc[1] = bfhi(b.x) * __builtin_amdgcn_rcpf(bfhi(a.x)); sc[2] = bflo(b.y) * __builtin_amdgcn_rcpf(bflo(a.y)); sc[3] = bfhi(b.y) * __builtin_amdgcn_rcpf(bfhi(a.y));
                    sc[4] = bflo(b.z) * __builtin_amdgcn_rcpf(bflo(a.z)); sc[5] = bfhi(b.z) * __builtin_amdgcn_rcpf(bfhi(a.z)); sc[6] = bflo(b.w) * __builtin_amdgcn_rcpf(bflo(a.w)); sc[7] = bfhi(b.w) * __builtin_amdgcn_rcpf(bfhi(a.w));
                    f32x4 v0 = acc[ai][bj][m][0], v1 = acc[ai][bj][m][1];
#pragma unroll
                    for (int j = 0; j < 4; ++j) { v0[j] *= sc[j]; v1[j] *= sc[4 + j]; }
                    if (mid) { acc[ai][bj][m][0] = v0; acc[ai][bj][m][1] = v1; }
                    else { u32x4 w; w.x = cvt_pk_bf16(v0[0], v0[1]); w.y = cvt_pk_bf16(v0[2], v0[3]); w.z = cvt_pk_bf16(v1[0], v1[1]); w.w = cvt_pk_bf16(v1[2], v1[3]);
                        *(u32x4*)(O + (size_t)(row0 + ai * HALF + m * 16) * DM + col0 + bj * HALF) = w; }
                }
        }
    }
};
struct EpiRes {
    static constexpr bool PERM = false;
    Params p; int l, goff;
    int in_is_stream;
    int emit;
    DEVI bool keep(const Unit&) const { return false; }
    DEVI void operator()(f32x4 (&acc)[2][2][4][2], const Unit& u, int wr, int wc, int fr, int fq) const {
        const int row0 = u.pm * BM + wr * 64 + fr, col0 = u.pn * BM + wc * 32 + 4 * fq;
        const float* gr = modrow(p, l, u.pm * BM) + goff + col0;
        f32x4 gv[2][2];
#pragma unroll
        for (int bj = 0; bj < 2; ++bj)
#pragma unroll
            for (int n = 0; n < 2; ++n) gv[bj][n] = *(const f32x4*)(gr + bj * HALF + n * 16);
        f32x4 av[2][2];
        if (emit) { const int bi = u.pm * BM < NLAT ? (u.pm * BM) >> 11 : 16; const float* ar = (const float*)(p.ws + OFF_A2) + (size_t)(l * 17 + bi) * 1024 + col0;
#pragma unroll
            for (int bj = 0; bj < 2; ++bj)
#pragma unroll
                for (int n = 0; n < 2; ++n) av[bj][n] = *(const f32x4*)(ar + bj * HALF + n * 16); }
#pragma unroll
        for (int am = 0; am < 4; ++am) {
            const int ai = am >> 1, mb = (am & 1) * 2;
            f32x4 xv[2][2][2];
#pragma unroll
            for (int mm = 0; mm < 2; ++mm) { const int r = row0 + ai * HALF + (mb + mm) * 16;
                const float* xi = (in_is_stream ? (const float*)xrow_out(p, r) : xrow_in(p, l, r)) + col0;
#pragma unroll
                for (int bj = 0; bj < 2; ++bj)
#pragma unroll
                    for (int n = 0; n < 2; ++n) xv[mm][bj][n] = *(const f32x4*)(xi + bj * HALF + n * 16); }
#pragma unroll
            for (int mm = 0; mm < 2; ++mm) { const int m = mb + mm; const int r = row0 + ai * HALF + m * 16; float* xo = xrow_out(p, r) + col0;
                float ssp = 0.f;
#pragma unroll
                for (int bj = 0; bj < 2; ++bj)
#pragma unroll
                    for (int n = 0; n < 2; ++n) { const f32x4 xn = xv[mm][bj][n] + gv[bj][n] * acc[ai][bj][m][n]; *(f32x4*)(xo + bj * HALF + n * 16) = xn;
                        if (emit) { ssp += xn[0] * xn[0] + xn[1] * xn[1] + xn[2] * xn[2] + xn[3] * xn[3];
                            const f32x4 ua = xn * av[bj][n]; u32x2 w; w.x = cvt_pk_bf16(ua[0], ua[1]); w.y = cvt_pk_bf16(ua[2], ua[3]);
                            *(u32x2*)((bf16_t*)(p.ws + OFF_U2) + (size_t)r * DM + col0 + bj * HALF + n * 16) = w; } }
                if (emit) { ssp += __shfl_xor(ssp, 16); ssp += __shfl_xor(ssp, 32); if (fq == 0) atomicAdd((float*)(p.ws + OFF_SSQ2) + (size_t)l * RT_ + r, ssp); } }
        }
    }
};

template <class Epi>
DEVI void gemm_phase(const int wv, LAS unsigned char* lds, const Gemm g, const Order& S, const Epi& E) {
    const int tid = opaque_tid(wv), wid = wv, lane = tid & 63, wr = wid >> 2, wc = wid & 3, fr = lane & 15, fq = lane >> 4;
    const int K = g.K, nt = K / BK;
    unsigned voffA[2], voffB[2];
#pragma unroll
    for (int i = 0; i < 2; ++i) { int R, C; stage_rc(tid * 16 + i * 8192, R, C); const int Rb = Epi::PERM ? ((R & ~31) + perm32(R & 31)) : R;
        voffA[i] = (unsigned)(R * g.lda + C) * 2u; voffB[i] = (unsigned)(Rb * g.ldb + C) * 2u; }
    const size_t kstep = (size_t)(BK * 2);
    const size_t hstepA = (size_t)HALF * g.lda * 2, hstepB = (size_t)HALF * g.ldb * 2;
    const size_t tstepA = 2 * hstepA, tstepB = 2 * hstepB;
    const unsigned ldsw = (unsigned)wid * 1024u;
    const int aoff = lds_byte(wr * 64 + fr, fq * 8), boff = lds_byte(wc * 32 + fr, fq * 8);
#define PG8_SA(b, h) (((b) * 2 + (h)) * HTB)
#define PG8_SB(b, h) ((4 + (b) * 2 + (h)) * HTB)
#define PG8_STAGE(bufoff, gbase, voff) do { _Pragma("unroll") for (int _i = 0; _i < 2; ++_i) \
        __builtin_amdgcn_global_load_lds((const unsigned*)((const char*)(gbase) + (voff)[_i]), (LAS unsigned*)(lds + (bufoff) + ldsw + _i * 8192), 16, 0, 0); } while (0)
#define PG8_LDA(dst, b, h) do { _Pragma("unroll") for (int m = 0; m < 4; ++m) _Pragma("unroll") for (int k = 0; k < 2; ++k) dst[m][k] = *(const LAS bf16x8*)(lds + PG8_SA(b, h) + aoff + m * 2048 + k * 1024); } while (0)
#define PG8_LDB(dst, b, h) do { _Pragma("unroll") for (int n = 0; n < 2; ++n) _Pragma("unroll") for (int k = 0; k < 2; ++k) dst[n][k] = *(const LAS bf16x8*)(lds + PG8_SB(b, h) + boff + n * 2048 + k * 1024); } while (0)
#define PG8_MMA(ai, bj, At, Bt) do { __builtin_amdgcn_s_setprio(1); _Pragma("unroll") for (int m = 0; m < 4; ++m) _Pragma("unroll") for (int n = 0; n < 2; ++n) _Pragma("unroll") for (int k = 0; k < 2; ++k) \
        acc[ai][bj][m][n] = __builtin_amdgcn_mfma_f32_16x16x32_bf16(Bt[n][k], At[m][k], acc[ai][bj][m][n], 0, 0, 0); __builtin_amdgcn_s_setprio(0); } while (0)
#define PG8_WAIT_V(n) asm volatile("s_waitcnt vmcnt(" #n ")" ::: "memory")
#define PG8_WAIT_L(n) asm volatile("s_waitcnt lgkmcnt(" #n ")" ::: "memory")
#define PG8_BAR __builtin_amdgcn_s_barrier()
#define PG8_SCHED __builtin_amdgcn_sched_barrier(0)
    Unit cur, nxt; int ui = 0;
    if (!S.next(0, cur)) return;
    f32x4 acc[2][2][4][2];
#pragma unroll
    for (int a = 0; a < 2; ++a)
#pragma unroll
        for (int b = 0; b < 2; ++b)
#pragma unroll
            for (int m = 0; m < 4; ++m)
#pragma unroll
                for (int n = 0; n < 2; ++n) acc[a][b][m][n] = (f32x4){0.f, 0.f, 0.f, 0.f};
    bf16x8 At[4][2], B0[2][2], B1[2][2];
    const char* cA = (const char*)g.A + (size_t)cur.pb * g.a_bs + (size_t)cur.pm * tstepA; const char* cB = (const char*)g.Bt + (size_t)cur.pb * g.b_bs + (size_t)cur.pn * tstepB;
    PG8_STAGE(PG8_SB(0, 0), cB, voffB); PG8_STAGE(PG8_SA(0, 0), cA, voffA); PG8_STAGE(PG8_SB(0, 1), cB + hstepB, voffB); PG8_STAGE(PG8_SA(0, 1), cA + hstepA, voffA);
    if (wr == 1) PG8_BAR;
    PG8_WAIT_V(4); PG8_BAR;
    PG8_STAGE(PG8_SB(1, 0), cB + kstep, voffB); PG8_STAGE(PG8_SA(1, 0), cA + kstep, voffA); PG8_STAGE(PG8_SB(1, 1), cB + hstepB + kstep, voffB);
    PG8_WAIT_V(6); PG8_BAR;
    for (;;) {
        const bool has_next = S.next(ui + 1, nxt);
        const char* nA = has_next ? (const char*)g.A + (size_t)nxt.pb * g.a_bs + (size_t)nxt.pm * tstepA : cA;
        const char* nB = has_next ? (const char*)g.Bt + (size_t)nxt.pb * g.b_bs + (size_t)nxt.pn * tstepB : cB;
        for (int t = 0; t < nt; t += 2) {
            const bool last = (t == nt - 2);
            const char* a1 = cA + (size_t)(t + 1) * kstep;
            const char* a2 = last ? nA : cA + (size_t)(t + 2) * kstep; const char* b2 = last ? nB : cB + (size_t)(t + 2) * kstep;
            const char* a3 = a2 + kstep; const char* b3 = b2 + kstep;
            PG8_LDB(B0, 0, 0); PG8_SCHED; PG8_LDA(At, 0, 0); PG8_STAGE(PG8_SA(1, 1), a1 + hstepA, voffA);
            PG8_WAIT_L(8); PG8_BAR; PG8_WAIT_L(0); PG8_MMA(0, 0, At, B0); PG8_BAR; PG8_SCHED;
            PG8_LDB(B1, 0, 1); PG8_STAGE(PG8_SB(0, 0), b2, voffB);
            PG8_BAR; PG8_WAIT_L(0); PG8_MMA(0, 1, At, B1); PG8_BAR;
            PG8_LDA(At, 0, 1); PG8_STAGE(PG8_SA(0, 0), a2, voffA);
            PG8_BAR; PG8_WAIT_L(0); PG8_MMA(1, 0, At, B0); PG8_BAR; PG8_SCHED;
            PG8_STAGE(PG8_SB(0, 1), b2 + hstepB, voffB);
            PG8_WAIT_V(6); PG8_BAR; PG8_MMA(1, 1, At, B1); PG8_BAR;
            PG8_LDB(B0, 1, 0); PG8_SCHED; PG8_LDA(At, 1, 0); PG8_STAGE(PG8_SA(0, 1), a2 + hstepA, voffA);
            PG8_WAIT_L(8); PG8_BAR; PG8_WAIT_L(0); PG8_MMA(0, 0, At, B0); PG8_BAR; PG8_SCHED;
            PG8_LDB(B1, 1, 1); PG8_STAGE(PG8_SB(1, 0), b3, voffB);
            PG8_BAR; PG8_WAIT_L(0); PG8_MMA(0, 1, At, B1); PG8_BAR;
            PG8_LDA(At, 1, 1); PG8_STAGE(PG8_SA(1, 0), a3, voffA);
            PG8_BAR; PG8_WAIT_L(0); PG8_MMA(1, 0, At, B0); PG8_BAR; PG8_SCHED;
            PG8_STAGE(PG8_SB(1, 1), b3 + hstepB, voffB);
            PG8_WAIT_V(6); PG8_BAR; PG8_MMA(1, 1, At, B1); PG8_BAR;
        }
        E(acc, cur, wr, wc, fr, fq);
        if (!E.keep(cur)) {
#pragma unroll
            for (int a = 0; a < 2; ++a)
#pragma unroll
                for (int b = 0; b < 2; ++b)
#pragma unroll
                    for (int m = 0; m < 4; ++m)
#pragma unroll
                        for (int n = 0; n < 2; ++n) acc[a][b][m][n] = (f32x4){0.f, 0.f, 0.f, 0.f};
        }
        if (!has_next) break;
        cur = nxt; cA = nA; cB = nB; ++ui;
    }
    PG8_WAIT_V(0);
    if (wr == 0) PG8_BAR;
    PG8_BAR;
#undef PG8_SA
#undef PG8_SB
#undef PG8_STAGE
#undef PG8_LDA
#undef PG8_LDB
#undef PG8_MMA
#undef PG8_WAIT_V
#undef PG8_WAIT_L
#undef PG8_BAR
#undef PG8_SCHED
}
}

#define XB_TMO      128
#define XB_XCNT(j)  (256  + 64 * (j))
#define XB_XSUB(j)  (1280 + 64 * (j))
#define XB_XGEN(j)  (2304 + 64 * (j))
#define XB_TOP      3328
#define XB_TOPGEN   3392
#define XCD_BAR_WORDS 3456
#define XB_SPIN_CAP (1u << 22)
DEVI unsigned xb_ld(unsigned* p)              { return __hip_atomic_load(p, __ATOMIC_RELAXED, __HIP_MEMORY_SCOPE_AGENT); }
DEVI unsigned xb_add(unsigned* p, unsigned v) { return __hip_atomic_fetch_add(p, v, __ATOMIC_RELAXED, __HIP_MEMORY_SCOPE_AGENT); }
DEVI unsigned xb_xcc_id() { return (unsigned)__builtin_amdgcn_s_getreg((3 << 11) | 20) & 0xFu; }
#define XB_SPIN(cond, bar) do { unsigned _sp = 0; while (cond) { __builtin_amdgcn_s_sleep(1); \
    if ((++_sp & 255u) == 0u) { if (xb_ld(&(bar)[XB_TMO])) break; if (_sp > XB_SPIN_CAP) { atomicAdd(&(bar)[XB_TMO], 1u); break; } } } } while (0)
struct XcdBarrier { unsigned* bar; unsigned x; volatile LAS unsigned* st; };
DEVI void xcd_barrier_complete(unsigned* bar, unsigned x, unsigned& nloc, unsigned& nx) {
    const unsigned G = gridDim.x;
    unsigned sum, cnt, mine, sp = 0u;
    for (;;) {
        sum = 0u; cnt = 0u; mine = 0u;
#pragma unroll
        for (unsigned j = 0; j < 16; ++j) { const unsigned c = xb_ld(&bar[XB_XCNT(j)]); sum += c; cnt += (c > 0u) ? 1u : 0u; mine = (j == x) ? c : mine; }
        if (sum == G) break;
        __builtin_amdgcn_s_sleep(1);
        if ((++sp & 255u) == 0u) { if (xb_ld(&bar[XB_TMO])) break; if (sp > XB_SPIN_CAP) { atomicAdd(&bar[XB_TMO], 1u); break; } }
    }
    nloc = mine > 0u ? mine : 1u; nx = cnt > 0u ? cnt : 1u;
}
DEVI void xcd_barrier(const XcdBarrier& b, const int wv) {
    asm volatile("s_waitcnt vmcnt(0)" ::: "memory");
    __syncthreads();
    if (opaque_tid(wv) == 0) {
        unsigned* bar = b.bar;
        __builtin_amdgcn_s_waitcnt(0);
        unsigned nloc = b.st[0], nx = b.st[1];
        if (nloc == 0u) { xcd_barrier_complete(bar, b.x, nloc, nx); b.st[0] = nloc; b.st[1] = nx; }
        const unsigned old = xb_add(&bar[XB_XSUB(b.x)], 1u);
        const unsigned gen = old / nloc;
        if (old + 1u == (gen + 1u) * nloc) {
            __builtin_amdgcn_fence(__ATOMIC_RELEASE, "agent");
            asm volatile("s_waitcnt vmcnt(0)" ::: "memory");
            const unsigned og = xb_add(&bar[XB_TOP], 1u);
            const unsigned tg = og / nx;
            if (og + 1u == (tg + 1u) * nx) xb_add(&bar[XB_TOPGEN], 1u);
            else XB_SPIN(xb_ld(&bar[XB_TOPGEN]) == tg, bar);
            __builtin_amdgcn_fence(__ATOMIC_ACQUIRE, "agent");
            xb_add(&bar[XB_XGEN(b.x)], 1u);
            asm volatile("s_waitcnt vmcnt(0)" ::: "memory");
        } else {
            XB_SPIN(xb_ld(&bar[XB_XGEN(b.x)]) == gen, bar);
            __builtin_amdgcn_fence(__ATOMIC_ACQUIRE, "agent");
            asm volatile("s_waitcnt vmcnt(0)" ::: "memory");
        }
    }
    __syncthreads();
}

DEVI void ph_setup(const int wv, const Params& p, unsigned char* lds) {
    const int tid = opaque_tid(wv);
    for (int e = blockIdx.x * NTHREADS + tid; e < 2 * RT_; e += gridDim.x * NTHREADS) ((float*)(p.ws + OFF_SSQ2))[e] = 0.f;
    float* scv = (float*)lds;
    float* red = scv + 17 * 1024;
    for (int it = blockIdx.x; it < 192 + 130; it += gridDim.x) {
        if (it < 192) {
            const int l = it / 96, n0 = (it % 96) * 64;
            for (int e = tid; e < 17 * 1024; e += NTHREADS) { const int r = e >> 10, k = e & 1023; const float v = r < 16 ? p.in[1][r * 1024 + k] : p.in[3][k]; scv[e] = v / (1.0f + expf(-v)); }
            __syncthreads();
            const int n = tid & 63, kg = tid >> 6;
            float acc[17];
#pragma unroll
            for (int r = 0; r < 17; ++r) acc[r] = 0.f;
            const float* w = p.in[6] + (size_t)l * 1024 * 6144 + n0 + n;
            for (int k = kg * 128; k < kg * 128 + 128; ++k) { const float wv = w[(size_t)k * 6144];
#pragma unroll
                for (int r = 0; r < 17; ++r) acc[r] += scv[r * 1024 + k] * wv; }
#pragma unroll
            for (int r = 0; r < 17; ++r) red[(kg * 17 + r) * 64 + n] = acc[r];
            __syncthreads();
            float* mod = (float*)(p.ws + OFF_MOD);
            for (int e = tid; e < 17 * 64; e += NTHREADS) { const int r = e >> 6, nn = e & 63; float s = 0.f;
#pragma unroll
                for (int q = 0; q < 8; ++q) s += red[(q * 17 + r) * 64 + nn];
                mod[(size_t)(l * 17 + r) * 6144 + n0 + nn] = s + p.in[7][l * 6144 + n0 + nn]; }
            __syncthreads();
        } else {
            const int e = (it - 192) * NTHREADS + tid;
            if (e < 65536) { const int pos = e >> 5, i = e & 31; const float fr = powf(10000.0f, -(float)i / 32.0f); const float ang = (float)pos * fr;
                const double tr = (double)ang * 0.15915494309189535; const float tf = (float)(tr - floor(tr));
                ((float2*)(p.ws + OFF_RT))[e] = make_float2(__builtin_amdgcn_cosf(tf), __builtin_amdgcn_sinf(tf)); }
            else { const int e2 = e - 65536; const int pos = e2 >> 4, i = e2 & 15; const float fr = powf(10000.0f, -(float)i / 16.0f); const float ang = (float)pos * fr;
                const double tr = (double)ang * 0.15915494309189535; const float tf = (float)(tr - floor(tr));
                ((float2*)(p.ws + OFF_AT))[e2] = make_float2(__builtin_amdgcn_cosf(tf), __builtin_amdgcn_sinf(tf)); }
        }
    }
}

DEVI void ph_shw(const int wv, const Params& p, int l, unsigned char* lds, int blk_lo) {
    const int tid = opaque_tid(wv);
    if ((int)blockIdx.x < blk_lo) return;
    const int bx = blockIdx.x - blk_lo, nbx = gridDim.x - blk_lo;
    float* shv = (float*)lds;
    float* red = shv + 17 * 1024;
    const float* mod = (const float*)(p.ws + OFF_MOD) + (size_t)l * 17 * 6144;
    for (int e = bx * NTHREADS + tid; e < 17 * 1024; e += nbx * NTHREADS) { const int r = e >> 10, k = e & 1023;
        ((float*)(p.ws + OFF_A2))[(size_t)l * 17 * 1024 + e] = p.in[5][l * 1024 + k] * (1.0f + mod[(size_t)r * 6144 + 4096 + k]); }
    for (int it = bx; it < 256; it += nbx) {
        const int n0 = it * 16;
        __syncthreads();
        for (int e = tid; e < 17 * 1024; e += NTHREADS) { const int r = e >> 10, k = e & 1023; shv[e] = mod[(size_t)r * 6144 + 3072 + k]; }
        __syncthreads();
        const int n = tid & 15, kg = tid >> 4;
        float acc[17];
#pragma unroll
        for (int r = 0; r < 17; ++r) acc[r] = 0.f;
        const float* w = p.in[19] + (size_t)l * 1024 * 4096 + n0 + n;
#pragma unroll 8
        for (int k = kg * 32; k < kg * 32 + 32; ++k) { const float wvv = w[(size_t)k * 4096];
#pragma unroll
            for (int r = 0; r < 17; ++r) acc[r] += shv[r * 1024 + k] * wvv; }
#pragma unroll
        for (int r = 0; r < 17; ++r) red[(kg * 17 + r) * 16 + n] = acc[r];
        __syncthreads();
        for (int e = tid; e < 17 * 16; e += NTHREADS) { const int r = e >> 4, nn = e & 15; float sacc = 0.f;
#pragma unroll
            for (int q = 0; q < 32; ++q) sacc += red[(q * 17 + r) * 16 + nn];
            ((float*)(p.ws + OFF_SHW2))[(size_t)(l * 17 + r) * 4096 + n0 + nn] = sacc; }
    }
    __syncthreads();
}

DEVI void ph_convert(const int wv, const Params& p, int l, unsigned char* lds, int mode  , int blk_lo) {
    const int tid = opaque_tid(wv);
    float* tile = (float*)lds;
    bf16_t* WB = (bf16_t*)(p.ws + OFF_WB);
    if ((int)blockIdx.x < blk_lo) return;
    const int nitems = mode == 0 ? 4032 + 64 : (mode == 1 ? 3008 + 64 : (mode == 2 ? 1024 : (mode == 3 ? 1984 + 64 : 2048)));
    for (int j = blockIdx.x - blk_lo; j < nitems; j += gridDim.x - blk_lo) {
        const int it = mode == 0 ? j : (mode == 1 ? (j < 3008 ? j : j + 1024) : (mode == 2 ? j + 3008 : (mode == 3 ? (j < 1984 ? j : j + 2048) : j + 1984)));
        if (it < 4032) {
            const float* src; bf16_t* dst; int K, N, t;
            if (it < 1472) { t = it; src = p.in[8] + (size_t)l * 1024 * INC; dst = WB + W_IN; K = 1024; N = INC; }
            else if (it < 1600) { t = it - 1472; src = p.in[15] + (size_t)l * 512 * 1024; dst = WB + W_BR; K = 512; N = 1024; }
            else if (it < 1728) { t = it - 1600; src = p.in[17] + (size_t)l * 512 * 1024; dst = WB + W_BR + 2 * 512 * 1024; K = 512; N = 1024; }
            else if (it < 1984) { t = it - 1728; src = p.in[18] + (size_t)l * 1024 * 1024; dst = WB + W_O; K = 1024; N = 1024; }
            else if (it < 3008) { t = it - 1984; src = p.in[19] + (size_t)l * 1024 * 4096; dst = WB + W_1; K = 1024; N = 4096; }
            else { t = it - 3008; src = p.in[20] + (size_t)l * 4096 * 1024; dst = WB + W_2; K = 4096; N = 1024; }
            const int nkt = K / 64, k0 = (t % nkt) * 64, n0 = (t / nkt) * 64;
            for (int e = tid; e < 4096; e += NTHREADS) { const int kk = e >> 6, nn = e & 63; tile[kk * 65 + nn] = src[(size_t)(k0 + kk) * N + n0 + nn]; }
            __syncthreads();
            for (int e = tid; e < 4096; e += NTHREADS) { const int nn = e >> 6, kk = e & 63; dst[(size_t)(n0 + nn) * K + k0 + kk] = f2bf(tile[kk * 65 + nn]); }
            __syncthreads();
        } else {
            const int pi = it - 4032, g = pi >> 4, n0 = (pi & 15) * 64;
            const int n = tid & 63, ig = tid >> 6;
            const float* pw = p.in[10] + (size_t)l * 4 * 128 * 128 + (size_t)g * 128 * 128 + (size_t)(ig * 16) * 128;
            const float* ps = p.in[11] + l * 512 + g * 128;
            const float* wpo = p.in[16] + (size_t)l * 512 * 1024 + (size_t)(g * 128) * 1024 + n0 + n;
            float acc[16];
#pragma unroll
            for (int ii = 0; ii < 16; ++ii) acc[ii] = 0.f;
            for (int j = 0; j < 128; ++j) { const float wv = ps[j] * wpo[(size_t)j * 1024];
#pragma unroll
                for (int ii = 0; ii < 16; ++ii) acc[ii] += pw[ii * 128 + j] * wv; }
            bf16_t* dst = WB + W_BR + 512 * 1024 + (size_t)(n0 + n) * 512 + g * 128 + ig * 16;
            u32x4 w0, w1;
            w0.x = cvt_pk_bf16(acc[0], acc[1]); w0.y = cvt_pk_bf16(acc[2], acc[3]); w0.z = cvt_pk_bf16(acc[4], acc[5]); w0.w = cvt_pk_bf16(acc[6], acc[7]);
            w1.x = cvt_pk_bf16(acc[8], acc[9]); w1.y = cvt_pk_bf16(acc[10], acc[11]); w1.z = cvt_pk_bf16(acc[12], acc[13]); w1.w = cvt_pk_bf16(acc[14], acc[15]);
            *(u32x4*)dst = w0; *(u32x4*)(dst + 8) = w1;
        }
    }
}

DEVI void ph_norm(const int wv, const Params& p, int l, int which  , int nrows) {
    const int tid = opaque_tid(wv); const int lane = tid & 63, wave = wv;
    const float* nw = p.in[which ? 5 : 4] + l * 1024;
    const int shoff = which ? 3072 : 0, scoff = which ? 4096 : 1024;
    bf16_t* U = (bf16_t*)(p.ws + OFF_UB);
    const int stride = gridDim.x * 8;
    for (int row0 = blockIdx.x * 8 + wave; row0 < nrows; row0 += 2 * stride) {
        f32x4 v[2][4]; float ss[2];
#pragma unroll
        for (int q = 0; q < 2; ++q) { const int row = row0 + q * stride; ss[q] = 0.f;
            if (row < nrows) { const float* x = which ? (const float*)xrow_out(p, row) : xrow_in(p, l, row);
#pragma unroll
                for (int i = 0; i < 4; ++i) v[q][i] = *(const f32x4*)(x + i * 256 + lane * 4); }
            else {
#pragma unroll
                for (int i = 0; i < 4; ++i) v[q][i] = (f32x4){0.f, 0.f, 0.f, 0.f}; } }
#pragma unroll
        for (int q = 0; q < 2; ++q) {
#pragma unroll
            for (int i = 0; i < 4; ++i) ss[q] += v[q][i][0] * v[q][i][0] + v[q][i][1] * v[q][i][1] + v[q][i][2] * v[q][i][2] + v[q][i][3] * v[q][i][3];
            ss[q] = wsum(ss[q]); }
#pragma unroll
        for (int q = 0; q < 2; ++q) { const int row = row0 + q * stride;
            if (row < nrows) { const float* md = modrow(p, l, row); const float rstd = rsqrtf(ss[q] * (1.0f / 1024.0f) + EPS);
#pragma unroll
                for (int i = 0; i < 4; ++i) { const int c = i * 256 + lane * 4;
                    const f32x4 w = *(const f32x4*)(nw + c), sc = *(const f32x4*)(md + scoff + c), sh = *(const f32x4*)(md + shoff + c);
                    const f32x4 o = v[q][i] * rstd * w * (1.0f + sc) + sh;
                    u32x2 pk; pk.x = cvt_pk_bf16(o[0], o[1]); pk.y = cvt_pk_bf16(o[2], o[3]);
                    *(u32x2*)(U + (size_t)row * 1024 + c) = pk; } } }
    }
}

DEVI void unpack8(const u32x4 w, float (&v)[8]) { v[0] = bflo(w.x); v[1] = bfhi(w.x); v[2] = bflo(w.y); v[3] = bfhi(w.y); v[4] = bflo(w.z); v[5] = bfhi(w.z); v[6] = bflo(w.w); v[7] = bfhi(w.w); }
DEVI void ph_prep(const int wv, const Params& p, int l, int nrows_pool, unsigned char* lds_raw) {
    const int tid = opaque_tid(wv); const int lane = tid & 63;
    bf16_t* Z = (bf16_t*)(p.ws + OFF_ZG); bf16_t* YB = (bf16_t*)(p.ws + OFF_YB);
    const float* RTf = (const float*)(p.ws + OFF_RT); const float* ATf = (const float*)(p.ws + OFF_AT);
    const int sub = lane & 7, hslot = lane >> 3, d0 = sub * 8;
    constexpr int NINST = RT_ * 6;
    for (int base = (blockIdx.x * 8 + wv) * 32; base < NINST; base += gridDim.x * 8 * 32) {
        u32x4 w[4]; int rowv[4], hhv[4], colv[4];
#pragma unroll
        for (int u = 0; u < 4; ++u) { const int hi = base + u * 8 + hslot; const int row = hi / 6, h6 = hi - row * 6, hh = h6 < 4 ? h6 : h6 + 4; rowv[u] = row; hhv[u] = hh;
            colv[u] = (hh < 4 ? C_RK + hh * 64 : hh < 8 ? C_RQ + (hh - 4) * 64 : hh < 10 ? C_AK + (hh - 8) * 64 : C_AQ + (hh - 10) * 64) + d0;
            w[u] = *(const u32x4*)(Z + (size_t)row * ZM + colv[u]); }
#pragma unroll
        for (int u = 0; u < 4; ++u) {
            const int row = rowv[u], hh = hhv[u]; const bool lat = row < NLAT; const int pos = row & 2047;
            float v[8]; unpack8(w[u], v);
            if (hh >= 8) {
                float ss = 0.f;
#pragma unroll
                for (int e = 0; e < 8; ++e) ss += v[e] * v[e];
                ss += __shfl_xor(ss, 1); ss += __shfl_xor(ss, 2); ss += __shfl_xor(ss, 4);
                const float rstd = rsqrtf(ss * (1.0f / 64.0f) + EPS) * (hh >= 10 ? 0.125f * 1.4426950408889634f : 1.0f);
                const float* wp = p.in[hh < 10 ? 13 : 12] + l * 64 + d0;
                const f32x4 w0 = *(const f32x4*)wp, w1 = *(const f32x4*)(wp + 4);
#pragma unroll
                for (int e = 0; e < 4; ++e) { v[e] *= rstd * w0[e]; v[4 + e] *= rstd * w1[e]; }
                if (lat) { const int pp = (sub & 4) ? (pos & 63) : (pos >> 6); const float* cp = ATf + (size_t)(pp * 16 + (d0 & 15)) * 2; const bool up = (sub & 2) != 0;
#pragma unroll
                    for (int e = 0; e < 8; ++e) { const float o = __shfl_xor(v[e], 2); const float cc = cp[2 * e], sn = cp[2 * e + 1]; v[e] = up ? o * sn + v[e] * cc : v[e] * cc - o * sn; } }
            } else {
                if (lat) { const float* cp = RTf + (size_t)(pos * 32 + (d0 & 31)) * 2; const bool up = (sub & 4) != 0;
#pragma unroll
                    for (int e = 0; e < 8; ++e) { const float o = __shfl_xor(v[e], 4); const float cc = cp[2 * e], sn = cp[2 * e + 1]; v[e] = up ? o * sn + v[e] * cc : v[e] * cc - o * sn; } }
                if (hh < 4) {
#pragma unroll
                    for (int e = 0; e < 8; ++e) v[e] *= 0.125f; }
            }
            u32x4 o; o.x = cvt_pk_bf16(v[0], v[1]); o.y = cvt_pk_bf16(v[2], v[3]); o.z = cvt_pk_bf16(v[4], v[5]); o.w = cvt_pk_bf16(v[6], v[7]);
            *(u32x4*)(Z + (size_t)row * ZM + colv[u]) = o;
        }
    }
    LAS unsigned char* slab = (LAS unsigned char*)lds_raw;
    for (int it = blockIdx.x; it < nrows_pool / 64; it += gridDim.x) {
        const int r0 = it * 64; int sbase, L;
        if (r0 < NLAT) { sbase = r0 & ~2047; L = 2048; } else { sbase = NLAT + ((r0 - NLAT) & ~255); L = 256; }
        const int t0 = r0 - sbase, lo_row = max(t0 - 8, 0), hi_row = min(t0 + 72, L), nchunks = (hi_row - lo_row) * 64;
        __syncthreads();
        for (int e = tid; e < nchunks; e += NTHREADS) { const int rr = e >> 6, cch = e & 63; *(LAS u32x4*)(slab + rr * 1024 + cch * 16) = *(const u32x4*)(Z + (size_t)(sbase + lo_row + rr) * ZM + C_PU + cch * 8); }
        __syncthreads();
#pragma unroll 2
        for (int o = tid; o < 4096; o += NTHREADS) {
            const int rr = o >> 6, cch = o & 63, hw = 1 << (cch >> 4), t = t0 + rr, lo = max(t - hw, 0), hi = min(t + hw, L);
            float sacc[8];
#pragma unroll
            for (int j = 0; j < 8; ++j) sacc[j] = 0.f;
            for (int tt = lo; tt < hi; ++tt) { float v[8]; unpack8(*(const LAS u32x4*)(slab + (tt - lo_row) * 1024 + cch * 16), v);
#pragma unroll
                for (int j = 0; j < 8; ++j) sacc[j] += v[j]; }
            float own[8]; unpack8(*(const LAS u32x4*)(slab + (t - lo_row) * 1024 + cch * 16), own);
            const float inv = 1.0f / (float)(hi - lo);
            u32x4 ow; ow.x = cvt_pk_bf16(sacc[0] * inv - own[0], sacc[1] * inv - own[1]); ow.y = cvt_pk_bf16(sacc[2] * inv - own[2], sacc[3] * inv - own[3]);
            ow.z = cvt_pk_bf16(sacc[4] * inv - own[4], sacc[5] * inv - own[5]); ow.w = cvt_pk_bf16(sacc[6] * inv - own[6], sacc[7] * inv - own[7]);
            *(u32x4*)(YB + (size_t)(sbase + t) * 1536 + 512 + cch * 8) = ow;
        }
    }
    __syncthreads();
}

#define MFMA16(X, Y, ACC) __builtin_amdgcn_mfma_f32_16x16x32_bf16((X), (Y), (ACC), 0, 0, 0)
DEVI bf16x8 mk_frag(unsigned a, unsigned b, unsigned c, unsigned d) { u32x4 w; w.x = a; w.y = b; w.z = c; w.w = d; return __builtin_bit_cast(bf16x8, w); }
typedef short s16x4 __attribute__((ext_vector_type(4)));
DEVI bf16x8 tr_frag(LAS unsigned char* tile, int rs, int rowA, int rowB, int n0, int fr) {
    const s16x4 a = __builtin_amdgcn_ds_read_tr16_b64_v4i16((LAS s16x4*)(tile + (rowA + (fr >> 2)) * rs + n0 * 2 + 8 * (fr & 3)));
    const s16x4 b = __builtin_amdgcn_ds_read_tr16_b64_v4i16((LAS s16x4*)(tile + (rowB + (fr >> 2)) * rs + n0 * 2 + 8 * (fr & 3)));
    return __builtin_shufflevector(a, b, 0, 1, 2, 3, 4, 5, 6, 7);
}
DEVI void lds_put8_t(LAS unsigned char* base, int rowstride, int r0, int j, const u32x4 w) {
    *(LAS unsigned short*)(base + (r0 + 0) * rowstride + 2 * j) = (unsigned short)(w.x & 0xffffu); *(LAS unsigned short*)(base + (r0 + 1) * rowstride + 2 * j) = (unsigned short)(w.x >> 16);
    *(LAS unsigned short*)(base + (r0 + 2) * rowstride + 2 * j) = (unsigned short)(w.y & 0xffffu); *(LAS unsigned short*)(base + (r0 + 3) * rowstride + 2 * j) = (unsigned short)(w.y >> 16);
    *(LAS unsigned short*)(base + (r0 + 4) * rowstride + 2 * j) = (unsigned short)(w.z & 0xffffu); *(LAS unsigned short*)(base + (r0 + 5) * rowstride + 2 * j) = (unsigned short)(w.z >> 16);
    *(LAS unsigned short*)(base + (r0 + 6) * rowstride + 2 * j) = (unsigned short)(w.w & 0xffffu); *(LAS unsigned short*)(base + (r0 + 7) * rowstride + 2 * j) = (unsigned short)(w.w >> 16);
}

DEVI void ph_attn(const int wv, const Params& p, int l, unsigned char* lds_raw, int it_lo = 0) {
    const int tid = opaque_tid(wv), lane = tid & 63, wave = wv, fr = lane & 15, fq = lane >> 4;
    LAS unsigned char* Kl = (LAS unsigned char*)lds_raw;
    LAS unsigned char* Vl = Kl + 18432;
    const bf16_t* Z = (const bf16_t*)(p.ws + OFF_ZG); bf16_t* YB = (bf16_t*)(p.ws + OFF_YB);
    const int nitems = 1024 + (l == 0 ? 128 : 0);
    for (int it = blockIdx.x + it_lo; it < nitems; it += gridDim.x) {
        int b, n, kvh, hp, qrow0; const bool isl = it < 1024;
        if (isl) { b = it >> 6; n = (it >> 2) & 15; kvh = (it >> 1) & 1; hp = it & 1; qrow0 = b * 2048 + n * 128; }
        else { const int i2 = it - 1024; b = i2 >> 3; n = (i2 >> 2) & 1; kvh = (i2 >> 1) & 1; hp = i2 & 1; qrow0 = NLAT + b * 256 + n * 128; }
        const int hq0 = kvh * 4 + hp * 2;
        const int ii = wave * 16 + fr;
        bf16x8 Qf[2][2];
#pragma unroll
        for (int g = 0; g < 2; ++g)
#pragma unroll
            for (int ks = 0; ks < 2; ++ks) Qf[g][ks] = *(const bf16x8*)(Z + (size_t)(qrow0 + ii) * ZM + C_AQ + (hq0 + g) * 64 + ks * 32 + fq * 8);
        {
            const int qpos = (qrow0 + ii) & 2047; const bool up = (fq & 2) != 0;
            float ssq[2]; float qv[2][2][8];
#pragma unroll
            for (int g = 0; g < 2; ++g) { ssq[g] = 0.f;
#pragma unroll
                for (int ks = 0; ks < 2; ++ks) { unpack8(__builtin_bit_cast(u32x4, Qf[g][ks]), qv[g][ks]);
#pragma unroll
                    for (int e = 0; e < 8; ++e) ssq[g] += qv[g][ks][e] * qv[g][ks][e]; }
                ssq[g] += __shfl_xor(ssq[g], 16); ssq[g] += __shfl_xor(ssq[g], 32);
                ssq[g] = rsqrtf(ssq[g] * (1.0f / 64.0f) + EPS) * (0.125f * 1.4426950408889634f); }
#pragma unroll
            for (int ks = 0; ks < 2; ++ks) {
                const float* wp = p.in[12] + l * 64 + ks * 32 + fq * 8;
                const f32x4 w0 = *(const f32x4*)wp, w1 = *(const f32x4*)(wp + 4);
                const float* cp = (const float*)(p.ws + OFF_AT) + (size_t)((ks ? (qpos & 63) : (qpos >> 6)) * 16 + (fq & 1) * 8) * 2;
                f32x4 cs[4];
                if (isl) {
#pragma unroll
                    for (int q4 = 0; q4 < 4; ++q4) cs[q4] = *(const f32x4*)(cp + 4 * q4); }
#pragma unroll
                for (int g = 0; g < 2; ++g) {
#pragma unroll
                    for (int e = 0; e < 8; ++e) { float v = qv[g][ks][e] * ssq[g] * (e < 4 ? w0[e & 3] : w1[e & 3]);
                        if (isl) { const float o = __shfl_xor(v, 32); const float cc = cs[e >> 1][(e & 1) * 2], sn = cs[e >> 1][(e & 1) * 2 + 1]; v = up ? o * sn + v * cc : v * cc - o * sn; }
                        qv[g][ks][e] = v; }
                    Qf[g][ks] = mk_frag(cvt_pk_bf16(qv[g][ks][0], qv[g][ks][1]), cvt_pk_bf16(qv[g][ks][2], qv[g][ks][3]), cvt_pk_bf16(qv[g][ks][4], qv[g][ks][5]), cvt_pk_bf16(qv[g][ks][6], qv[g][ks][7])); }
            }
        }
        float mrun[2], lrun[2]; f32x4 O[2][4];
#pragma unroll
        for (int g = 0; g < 2; ++g) { mrun[g] = p.in[14][l * 8 + hq0 + g] * 1.4426950408889634f; lrun[g] = fq == 0 ? 1.0f : 0.0f;
#pragma unroll
            for (int dt = 0; dt < 4; ++dt) O[g][dt] = (f32x4){0.f, 0.f, 0.f, 0.f}; }
        int t = isl ? (n > 0 ? 0 : 1) : 3;
        u32x4 pk[2], pv[2];
        { const int krow0 = t < 3 ? b * 2048 + (n - 1 + t) * 128 : NLAT + b * 256 + (t - 3) * 128;
#pragma unroll
          for (int rep = 0; rep < 2; ++rep) { const int pi = tid + 512 * rep;
              pk[rep] = *(const u32x4*)(Z + (size_t)(krow0 + (pi >> 3)) * ZM + C_AK + kvh * 64 + (pi & 7) * 8);
              pv[rep] = *(const u32x4*)(Z + (size_t)(krow0 + (pi >> 3)) * ZM + C_AV + kvh * 64 + (pi & 7) * 8); } }
        while (t < 5) {
            const int tn = (isl && t == 1 && n == 15) ? 3 : t + 1;
            const int msgn = t == 0 ? 1 : (t == 2 ? -1 : 0);
            const int dbase = 4 * fq - ii;
            __syncthreads();
#pragma unroll
            for (int rep = 0; rep < 2; ++rep) { const int pi = tid + 512 * rep;
                *(LAS u32x4*)(Kl + (pi >> 3) * 144 + (pi & 7) * 16) = pk[rep];
                *(LAS u32x4*)(Vl + (pi >> 3) * 144 + (pi & 7) * 16) = pv[rep]; }
            __syncthreads();
            if (tn < 5) { const int krow0 = tn < 3 ? b * 2048 + (n - 1 + tn) * 128 : NLAT + b * 256 + (tn - 3) * 128;
#pragma unroll
                for (int rep = 0; rep < 2; ++rep) { const int pi = tid + 512 * rep;
                    pk[rep] = *(const u32x4*)(Z + (size_t)(krow0 + (pi >> 3)) * ZM + C_AK + kvh * 64 + (pi & 7) * 8);
                    pv[rep] = *(const u32x4*)(Z + (size_t)(krow0 + (pi >> 3)) * ZM + C_AV + kvh * 64 + (pi & 7) * 8); } }
            const int jlo = msgn > 0 ? wave : 0, jhi = msgn < 0 ? wave : 7;
            f32x4 sc[2][8];
#pragma unroll
            for (int jt = 0; jt < 8; ++jt) {
                if (jt < jlo || jt > jhi) { sc[0][jt] = (f32x4){-INFINITY, -INFINITY, -INFINITY, -INFINITY}; sc[1][jt] = sc[0][jt]; continue; }
                sc[0][jt] = (f32x4){0.f, 0.f, 0.f, 0.f}; sc[1][jt] = (f32x4){0.f, 0.f, 0.f, 0.f};
#pragma unroll
                for (int ks = 0; ks < 2; ++ks) { const bf16x8 kf = *(const LAS bf16x8*)(Kl + (jt * 16 + fr) * 144 + ks * 64 + fq * 16);
                    sc[0][jt] = MFMA16(kf, Qf[0][ks], sc[0][jt]); sc[1][jt] = MFMA16(kf, Qf[1][ks], sc[1][jt]); } }
#pragma unroll
            for (int g = 0; g < 2; ++g) {
                float mx = mrun[g];
                if (msgn != 0) {
#pragma unroll
                    for (int jt = 0; jt < 8; ++jt)
#pragma unroll
                        for (int i = 0; i < 4; ++i) { const int d = msgn * (dbase + jt * 16 + i); sc[g][jt][i] = d >= 0 ? sc[g][jt][i] : -INFINITY; }
                }
#pragma unroll
                for (int jt = 0; jt < 8; ++jt) { mx = fmaxf(fmaxf(mx, sc[g][jt][0]), sc[g][jt][1]); mx = fmaxf(fmaxf(mx, sc[g][jt][2]), sc[g][jt][3]); }
                mx = fmaxf(mx, __shfl_xor(mx, 16)); mx = fmaxf(mx, __shfl_xor(mx, 32));
                const float alpha = __builtin_amdgcn_exp2f(mrun[g] - mx); mrun[g] = mx;
                float ps = 0.f;
#pragma unroll
                for (int jt = 0; jt < 8; ++jt)
#pragma unroll
                    for (int i = 0; i < 4; ++i) { const float e = __builtin_amdgcn_exp2f(sc[g][jt][i] - mx); sc[g][jt][i] = e; ps += e; }
                lrun[g] = lrun[g] * alpha + ps;
#pragma unroll
                for (int dt = 0; dt < 4; ++dt) O[g][dt] *= alpha;
            }
#pragma unroll
            for (int sI = 0; sI < 4; ++sI) {
                if (2 * sI + 1 < jlo || 2 * sI > jhi) continue;
                const bf16x8 pf0 = mk_frag(cvt_pk_bf16(sc[0][2 * sI][0], sc[0][2 * sI][1]), cvt_pk_bf16(sc[0][2 * sI][2], sc[0][2 * sI][3]), cvt_pk_bf16(sc[0][2 * sI + 1][0], sc[0][2 * sI + 1][1]), cvt_pk_bf16(sc[0][2 * sI + 1][2], sc[0][2 * sI + 1][3]));
                const bf16x8 pf1 = mk_frag(cvt_pk_bf16(sc[1][2 * sI][0], sc[1][2 * sI][1]), cvt_pk_bf16(sc[1][2 * sI][2], sc[1][2 * sI][3]), cvt_pk_bf16(sc[1][2 * sI + 1][0], sc[1][2 * sI + 1][1]), cvt_pk_bf16(sc[1][2 * sI + 1][2], sc[1][2 * sI + 1][3]));
#pragma unroll
                for (int dt = 0; dt < 4; ++dt) {
                    const bf16x8 vf = tr_frag(Vl, 144, (2 * sI) * 16 + 4 * fq, (2 * sI + 1) * 16 + 4 * fq, dt * 16, fr);
                    O[0][dt] = MFMA16(vf, pf0, O[0][dt]); O[1][dt] = MFMA16(vf, pf1, O[1][dt]); }
            }
            t = tn;
        }
#pragma unroll
        for (int g = 0; g < 2; ++g) { float lt = lrun[g]; lt += __shfl_xor(lt, 16); lt += __shfl_xor(lt, 32); const float inv = 1.0f / lt;
#pragma unroll
            for (int dt = 0; dt < 4; ++dt) { u32x2 w; w.x = cvt_pk_bf16(O[g][dt][0] * inv, O[g][dt][1] * inv); w.y = cvt_pk_bf16(O[g][dt][2] * inv, O[g][dt][3] * inv);
                *(u32x2*)(YB + (size_t)(qrow0 + ii) * 1536 + 1024 + (hq0 + g) * 64 + dt * 16 + 4 * fq) = w; } }
    }
    __syncthreads();
}

DEVI void ph_ret_state(const int wv, const Params& p, int l, unsigned char* lds_raw) {
    const int tid = opaque_tid(wv), lane = tid & 63, wave = wv, fr = lane & 15, fq = lane >> 4;
    LAS unsigned char* Kt = (LAS unsigned char*)lds_raw;
    LAS unsigned char* Vt = Kt + 18432;
    const bf16_t* Z = (const bf16_t*)(p.ws + OFF_ZG); bf16_t* RS = (bf16_t*)(p.ws + OFF_RS);
    for (int it = blockIdx.x; it < 256; it += gridDim.x) {
        const int b = it >> 4, h = (it >> 2) & 3, dir = (it >> 1) & 1, half = it & 1;
        const float e_ = p.in[9][(l * 2 + dir) * 4 + h];
        const float lg2 = log1pf(-exp2f(-e_)) * 1.4426950408889634f;
        const float gC = exp2f(128.0f * lg2);
        f32x4 R[2]; R[0] = (f32x4){0.f, 0.f, 0.f, 0.f}; R[1] = R[0];
        const int j0 = tid >> 3, g80 = tid & 7;
        const float wj0 = exp2f((float)(dir == 0 ? 127 - j0 : j0) * lg2), wj1 = exp2f((float)(dir == 0 ? 63 - j0 : j0 + 64) * lg2);
        u32x4 kwr[2], vwr[2];
        { const int cid0 = dir == 0 ? 0 : 1; const int row00 = NLAT + b * 256 + cid0 * 128;
#pragma unroll
          for (int rep = 0; rep < 2; ++rep) { const int jr = j0 + 64 * rep;
              kwr[rep] = *(const u32x4*)(Z + (size_t)(row00 + jr) * ZM + C_RK + h * 64 + g80 * 8);
              vwr[rep] = *(const u32x4*)(Z + (size_t)(row00 + jr) * ZM + C_RV + h * 128 + half * 64 + g80 * 8); } }
        for (int n = 0; n < 18; ++n) {
            const int cid = dir == 0 ? n : (n < 2 ? 1 - n : 19 - n);
#pragma unroll
            for (int tt = 0; tt < 2; ++tt) { const int t = wave * 2 + tt, dkt = t >> 2, dvt = t & 3;
                u32x2 w; w.x = cvt_pk_bf16(R[tt][0], R[tt][1]); w.y = cvt_pk_bf16(R[tt][2], R[tt][3]);
                *(u32x2*)(RS + ((size_t)((b * 4 + h) * 18 + cid) * 128 + half * 64 + dvt * 16 + fr) * 128 + dir * 64 + dkt * 16 + 4 * fq) = w; }
            if (n == 17) break;
            __syncthreads();
#pragma unroll
            for (int rep = 0; rep < 2; ++rep) { const int jr = j0 + 64 * rep; const float wj = rep ? wj1 : wj0;
                const u32x4 kw = kwr[rep];
                u32x4 ks; ks.x = cvt_pk_bf16(bflo(kw.x) * wj, bfhi(kw.x) * wj); ks.y = cvt_pk_bf16(bflo(kw.y) * wj, bfhi(kw.y) * wj); ks.z = cvt_pk_bf16(bflo(kw.z) * wj, bfhi(kw.z) * wj); ks.w = cvt_pk_bf16(bflo(kw.w) * wj, bfhi(kw.w) * wj);
                *(LAS u32x4*)(Kt + jr * 144 + g80 * 16) = ks; *(LAS u32x4*)(Vt + jr * 144 + g80 * 16) = vwr[rep]; }
            __syncthreads();
            if (n + 1 < 17) { const int n1 = n + 1; const int cid1 = dir == 0 ? n1 : (n1 < 2 ? 1 - n1 : 19 - n1);
                const int row01 = cid1 < 2 ? NLAT + b * 256 + cid1 * 128 : b * 2048 + (cid1 - 2) * 128;
#pragma unroll
                for (int rep = 0; rep < 2; ++rep) { const int jr = j0 + 64 * rep;
                    kwr[rep] = *(const u32x4*)(Z + (size_t)(row01 + jr) * ZM + C_RK + h * 64 + g80 * 8);
                    vwr[rep] = *(const u32x4*)(Z + (size_t)(row01 + jr) * ZM + C_RV + h * 128 + half * 64 + g80 * 8); } }
#pragma unroll
            for (int tt = 0; tt < 2; ++tt) { const int t = wave * 2 + tt, dkt = t >> 2, dvt = t & 3;
                f32x4 u = (f32x4){0.f, 0.f, 0.f, 0.f};
#pragma unroll
                for (int ks = 0; ks < 4; ++ks) { const bf16x8 xf = tr_frag(Kt, 144, ks * 32 + 8 * fq, ks * 32 + 8 * fq + 4, dkt * 16, fr), yf = tr_frag(Vt, 144, ks * 32 + 8 * fq, ks * 32 + 8 * fq + 4, dvt * 16, fr); u = MFMA16(xf, yf, u); }
                R[tt] = R[tt] * gC + u; }
        }
        __syncthreads();
    }
}

DEVI void ph_ret_out(const int wv, const Params& p, int l, unsigned char* lds_raw) {
    const int tid = opaque_tid(wv), lane = tid & 63, wave = wv, fr = lane & 15, fq = lane >> 4;
    LAS unsigned char* Kl = (LAS unsigned char*)lds_raw;
    LAS unsigned char* Ql = Kl + 18432;
    LAS unsigned char* Vt = Ql + 18432;
    LAS unsigned char* Rl = Vt + 36864;
    const bf16_t* Z = (const bf16_t*)(p.ws + OFF_ZG); const bf16_t* RS = (const bf16_t*)(p.ws + OFF_RS); bf16_t* YB = (bf16_t*)(p.ws + OFF_YB);
    const int nch = l == 0 ? 18 : 16, nitems = 64 * nch;
    u32x4 pk[2], pq[2], pr[4], pvv[4];
#define RO_LOAD(IT) do { const int bh_ = (IT) / nch, ci_ = (IT) - bh_ * nch, b_ = bh_ >> 2, h_ = bh_ & 3, cid_ = l == 0 ? ci_ : ci_ + 2; \
        const int row0_ = cid_ < 2 ? NLAT + b_ * 256 + cid_ * 128 : b_ * 2048 + (cid_ - 2) * 128; \
        _Pragma("unroll") for (int rep = 0; rep < 2; ++rep) { const int pi = tid + 512 * rep, r = pi >> 3, g8 = pi & 7; \
            pk[rep] = *(const u32x4*)(Z + (size_t)(row0_ + r) * ZM + C_RK + h_ * 64 + g8 * 8); pq[rep] = *(const u32x4*)(Z + (size_t)(row0_ + r) * ZM + C_RQ + h_ * 64 + g8 * 8); } \
        _Pragma("unroll") for (int rep = 0; rep < 4; ++rep) { const int pi = tid + 512 * rep; \
            pr[rep] = *(const u32x4*)(RS + ((size_t)(bh_ * 18 + cid_) * 128 + (pi >> 4)) * 128 + (pi & 15) * 8); \
            pvv[rep] = *(const u32x4*)(Z + (size_t)(row0_ + (pi >> 4)) * ZM + C_RV + h_ * 128 + (pi & 15) * 8); } } while (0)
    if ((int)blockIdx.x < nitems) RO_LOAD((int)blockIdx.x);
    for (int it = blockIdx.x; it < nitems; it += gridDim.x) {
        const int bh = it / nch, ci = it - bh * nch, b = bh >> 2, h = bh & 3, cid = l == 0 ? ci : ci + 2;
        const int row0 = cid < 2 ? NLAT + b * 256 + cid * 128 : b * 2048 + (cid - 2) * 128;
        const float lgf = log1pf(-exp2f(-p.in[9][(l * 2 + 0) * 4 + h])) * 1.4426950408889634f, lgb = log1pf(-exp2f(-p.in[9][(l * 2 + 1) * 4 + h])) * 1.4426950408889634f;
        __syncthreads();
#pragma unroll
        for (int rep = 0; rep < 2; ++rep) { const int pi = tid + 512 * rep, r = pi >> 3, g8 = pi & 7;
            *(LAS u32x4*)(Kl + r * 144 + g8 * 16) = pk[rep]; *(LAS u32x4*)(Ql + r * 144 + g8 * 16) = pq[rep]; }
#pragma unroll
        for (int rep = 0; rep < 4; ++rep) { const int pi = tid + 512 * rep;
            *(LAS u32x4*)(Rl + (pi >> 4) * 272 + (pi & 15) * 16) = pr[rep];
            *(LAS u32x4*)(Vt + (pi >> 4) * 288 + (pi & 15) * 16) = pvv[rep]; }
        __syncthreads();
        if (it + (int)gridDim.x < nitems) RO_LOAD(it + (int)gridDim.x);
        const int ii = wave * 16 + fr;
        bf16x8 Qf[2];
#pragma unroll
        for (int ks = 0; ks < 2; ++ks) Qf[ks] = *(const LAS bf16x8*)(Ql + ii * 144 + ks * 64 + fq * 16);
        if (cid >= 2) {
            const float* cp = (const float*)(p.ws + OFF_RT) + (size_t)(((row0 + ii) & 2047) * 32 + fq * 8) * 2;
            float x1[8], x2[8]; unpack8(__builtin_bit_cast(u32x4, Qf[0]), x1); unpack8(__builtin_bit_cast(u32x4, Qf[1]), x2);
            float y1[8], y2[8];
#pragma unroll
            for (int q4 = 0; q4 < 4; ++q4) { const f32x4 cs = *(const f32x4*)(cp + 4 * q4);
                y1[2 * q4] = x1[2 * q4] * cs[0] - x2[2 * q4] * cs[1]; y2[2 * q4] = x1[2 * q4] * cs[1] + x2[2 * q4] * cs[0];
                y1[2 * q4 + 1] = x1[2 * q4 + 1] * cs[2] - x2[2 * q4 + 1] * cs[3]; y2[2 * q4 + 1] = x1[2 * q4 + 1] * cs[3] + x2[2 * q4 + 1] * cs[2]; }
            Qf[0] = mk_frag(cvt_pk_bf16(y1[0], y1[1]), cvt_pk_bf16(y1[2], y1[3]), cvt_pk_bf16(y1[4], y1[5]), cvt_pk_bf16(y1[6], y1[7]));
            Qf[1] = mk_frag(cvt_pk_bf16(y2[0], y2[1]), cvt_pk_bf16(y2[2], y2[3]), cvt_pk_bf16(y2[4], y2[5]), cvt_pk_bf16(y2[6], y2[7]));
        }
        f32x4 sc[8];
#pragma unroll
        for (int jt = 0; jt < 8; ++jt) { sc[jt] = (f32x4){0.f, 0.f, 0.f, 0.f};
#pragma unroll
            for (int ks = 0; ks < 2; ++ks) { const bf16x8 kf = *(const LAS bf16x8*)(Kl + (jt * 16 + fr) * 144 + ks * 64 + fq * 16); sc[jt] = MFMA16(kf, Qf[ks], sc[jt]); } }
#pragma unroll
        for (int jt = 0; jt < 8; ++jt)
#pragma unroll
            for (int i = 0; i < 4; ++i) { const int d = ii - (jt * 16 + 4 * fq + i); const float f = __builtin_amdgcn_exp2f(d > 0 ? (float)d * lgf : (float)(-d) * lgb); sc[jt][i] *= (d == 0 ? 2.0f : f); }
        f32x4 Y[8];
#pragma unroll
        for (int dt = 0; dt < 8; ++dt) Y[dt] = (f32x4){0.f, 0.f, 0.f, 0.f};
#pragma unroll
        for (int sI = 0; sI < 4; ++sI) {
            const bf16x8 pf = mk_frag(cvt_pk_bf16(sc[2 * sI][0], sc[2 * sI][1]), cvt_pk_bf16(sc[2 * sI][2], sc[2 * sI][3]), cvt_pk_bf16(sc[2 * sI + 1][0], sc[2 * sI + 1][1]), cvt_pk_bf16(sc[2 * sI + 1][2], sc[2 * sI + 1][3]));
#pragma unroll
            for (int dt = 0; dt < 8; ++dt) {
                Y[dt] = MFMA16(tr_frag(Vt, 288, (2 * sI) * 16 + 4 * fq, (2 * sI + 1) * 16 + 4 * fq, dt * 16, fr), pf, Y[dt]); }
        }
        u32x2 gwv[8];
#pragma unroll
        for (int dt = 0; dt < 8; ++dt) gwv[dt] = *(const u32x2*)(Z + (size_t)(row0 + ii) * ZM + C_RG + h * 128 + dt * 16 + 4 * fq);
        const float xf = __builtin_amdgcn_exp2f((float)(ii + 1) * lgf), xb = __builtin_amdgcn_exp2f((float)(128 - ii) * lgb);
#pragma unroll
        for (int ks = 0; ks < 4; ++ks) {
            const u32x4 qw = __builtin_bit_cast(u32x4, Qf[ks & 1]); const float xs = ks < 2 ? xf : xb;
            const bf16x8 qs = mk_frag(cvt_pk_bf16(bflo(qw.x) * xs, bfhi(qw.x) * xs), cvt_pk_bf16(bflo(qw.y) * xs, bfhi(qw.y) * xs), cvt_pk_bf16(bflo(qw.z) * xs, bfhi(qw.z) * xs), cvt_pk_bf16(bflo(qw.w) * xs, bfhi(qw.w) * xs));
#pragma unroll
            for (int dt = 0; dt < 8; ++dt) { const bf16x8 rf = *(const LAS bf16x8*)(Rl + (dt * 16 + fr) * 272 + ks * 64 + fq * 16); Y[dt] = MFMA16(rf, qs, Y[dt]); }
        }
        float ss = 0.f;
#pragma unroll
        for (int dt = 0; dt < 8; ++dt) ss += Y[dt][0] * Y[dt][0] + Y[dt][1] * Y[dt][1] + Y[dt][2] * Y[dt][2] + Y[dt][3] * Y[dt][3];
        ss += __shfl_xor(ss, 16); ss += __shfl_xor(ss, 32);
        const float rstd = rsqrtf(ss * (1.0f / 128.0f) + EPS);
#pragma unroll
        for (int dt = 0; dt < 8; ++dt) {
            const u32x2 gw = gwv[dt];
            const float g0 = bflo(gw.x), g1 = bfhi(gw.x), g2 = bflo(gw.y), g3 = bfhi(gw.y);
            u32x2 w; w.x = cvt_pk_bf16(g0 * sigmoidf_(g0) * Y[dt][0] * rstd, g1 * sigmoidf_(g1) * Y[dt][1] * rstd); w.y = cvt_pk_bf16(g2 * sigmoidf_(g2) * Y[dt][2] * rstd, g3 * sigmoidf_(g3) * Y[dt][3] * rstd);
            *(u32x2*)(YB + (size_t)(row0 + ii) * 1536 + h * 128 + dt * 16 + 4 * fq) = w; }
    }
#undef RO_LOAD
    __syncthreads();
}

#ifndef ATT_MFMA
#define ATT_MFMA 1
#endif
#ifndef RET_MFMA
#define RET_MFMA 1
#endif
constexpr int NPL = 10;
constexpr int NPH = 1 + 2 * NPL;

__global__ void __launch_bounds__(NTHREADS) mega(Params p) {
    extern __shared__ __attribute__((aligned(16))) unsigned char lds_raw[];
    cg::grid_group grid = cg::this_grid();
    const int wv = __builtin_amdgcn_readfirstlane(threadIdx.x >> 6);
    LAS unsigned char* lds = (LAS unsigned char*)lds_raw;
    const int G = gridDim.x, c = blockIdx.x;
    const int lo = p.ph_lo, hi = p.ph_hi;
    if (hi < 0) grid.sync();
    XcdBarrier xb; xb.bar = (unsigned*)(p.ws + OFF_BAR); xb.x = xb_xcc_id(); xb.st = (volatile LAS unsigned*)(lds + LDS_BYTES);
    { const int t0 = opaque_tid(wv); if (t0 == 0) { xb.st[0] = 0u; xb.st[1] = 0u; } __syncthreads(); if (t0 == 0) (void)xb_add(&xb.bar[XB_XCNT(xb.x)], 1u); }
    bf16_t* WB = (bf16_t*)(p.ws + OFF_WB);
    bf16_t* ZG = (bf16_t*)(p.ws + OFF_ZG); bf16_t* YB = (bf16_t*)(p.ws + OFF_YB); bf16_t* UB = (bf16_t*)(p.ws + OFF_UB);
#ifndef DUPMASK
#define DUPMASK 0
#endif
#define PHASE(ph, ...) if ((ph) >= lo && (ph) < hi) { __VA_ARGS__; if ((ph) + 1 < hi) xcd_barrier(xb, wv); }
#define PHASED(flag, ph, ...) if ((ph) >= lo && (ph) < hi) { __VA_ARGS__; if (DUPMASK & (flag)) { xcd_barrier(xb, wv); __VA_ARGS__; } if ((ph) + 1 < hi) xcd_barrier(xb, wv); }
    PHASED(64, 0, ph_setup(wv, p, lds_raw); __syncthreads(); ph_convert(wv, p, 0, lds_raw, 3, 0))
#pragma unroll 1
    for (int l = 0; l < 2; ++l) {
        const int b = 1 + l * NPL;
        const int Mrows = l == 0 ? RT_ : NLAT;
        PHASED(1, b + 0, if (l > 0) ph_convert(wv, p, l, lds_raw, 2, 0); ph_norm(wv, p, l, 0, RT_))
        PHASED(2, b + 1, { pg8::Gemm g{UB, WB + W_IN, 1024, 1024, 1024, 0, 0}; pg8::Order S; if (l == 0) S.init(RT_, ZM, G, c, 1); else { S.init(NLAT, ZM, G, c, 1); S.set_tail(NCTX, 4); }     pg8::EpiBf16<0> E{ZG, ZM, nullptr, nullptr, 0}; pg8::gemm_phase(wv, lds, g, S, E); if (l == 0) ph_convert(wv, p, 0, lds_raw, 4, 48); })
        PHASE(b + 2, ph_prep(wv, p, l, Mrows, lds_raw))
        PHASED(4, b + 3, ph_ret_state(wv, p, l, lds_raw); ph_attn(wv, p, l, lds_raw))
        PHASED(8, b + 4, ph_ret_out(wv, p, l, lds_raw))
        PHASED(2, b + 5, { pg8::Gemm g{UB, WB + W_IN + (size_t)ZM * 1024, 1024, 1024, 1024, 0, 0}; pg8::Order S; S.init(Mrows, ZGW, G, c, 1); pg8::EpiBf16<2> E{ZG, ZGW, nullptr, nullptr, 0}; pg8::gemm_phase(wv, lds, g, S, E); })
        PHASED(32, b + 6, { pg8::Gemm g{YB, WB + W_BR, 1536, 512, 512, 512 * 2, (size_t)1024 * 512 * 2}; pg8::Order S; S.init(Mrows, 1024, G, c, 3); pg8::EpiMerge E{ZG, UB}; pg8::gemm_phase(wv, lds, g, S, E); if (l == 0) ph_shw(wv, p, 0, lds_raw, 64); })
        PHASE(b + 7, { pg8::Gemm g{UB, WB + W_O, 1024, 1024, 1024, 0, 0}; pg8::Order S; S.init(Mrows, 1024, G, c, 1); pg8::EpiRes E{p, l, 2048, 0, 1}; pg8::gemm_phase(wv, lds, g, S, E); })
        PHASED(16, b + 8, { pg8::Gemm g{(const bf16_t*)(p.ws + OFF_U2), WB + W_1, 1024, 1024, 1024, 0, 0}; pg8::Order S; S.init(Mrows, HID, G, c, 1); pg8::EpiBf16<1, true> E{(bf16_t*)(p.ws + OFF_H), HID, (const float*)(p.ws + OFF_SSQ2) + (size_t)l * RT_, (const float*)(p.ws + OFF_SHW2) + (size_t)l * 17 * 4096, 4096}; pg8::gemm_phase(wv, lds, g, S, E); })
        PHASE(b + 9, { pg8::Gemm g{(const bf16_t*)(p.ws + OFF_H), WB + W_2, HID, HID, HID, 0, 0}; pg8::Order S; S.init(Mrows, 1024, G, c, 1); pg8::EpiRes E{p, l, 5120, 1, 0}; pg8::gemm_phase(wv, lds, g, S, E); if (l == 0) { ph_convert(wv, p, 1, lds_raw, 1, 64); ph_shw(wv, p, 1, lds_raw, 64); } })
    }
    if (DUPMASK & 128) { for (int i = 0; i < 20; ++i) xcd_barrier(xb, wv); }
#undef PHASE
#undef PHASED
}

#ifndef MULTI_LAUNCH
#define MULTI_LAUNCH 0
#endif

extern "C" void kernel_launch(void* const* d_in, const int* in_sizes, int n_in, void* d_out, int out_size, void* d_ws, size_t ws_size, hipStream_t stream) {
    static int grid = 0;
    if (grid == 0) {
        if (ws_size < WS_END) { fprintf(stderr, "kernel_launch: workspace too small: %zu < %zu\n", ws_size, (size_t)WS_END); grid = -1; return; }
        int dev = 0, cus = 0, per_cu = 0;
        hipGetDevice(&dev);
        hipDeviceGetAttribute(&cus, hipDeviceAttributeMultiprocessorCount, dev);
        if (hipFuncSetAttribute((const void*)mega, hipFuncAttributeMaxDynamicSharedMemorySize, LDS_TOTAL) != hipSuccess) { fprintf(stderr, "kernel_launch: hipFuncSetAttribute failed\n"); grid = -1; return; }
        if (hipOccupancyMaxActiveBlocksPerMultiprocessor(&per_cu, (const void*)mega, NTHREADS, LDS_TOTAL) != hipSuccess || per_cu < 1) { fprintf(stderr, "kernel_launch: occupancy query gave %d\n", per_cu); per_cu = 1; }
        (void)hipGetLastError();
        grid = cus * per_cu;
        fprintf(stderr, "kernel_launch: grid %d (cus %d x %d)\n", grid, cus, per_cu);
    }
    if (grid < 0) return;
    if (hipMemsetAsync((char*)d_ws + OFF_BAR, 0, BAR_BYTES, stream) != hipSuccess) { fprintf(stderr, "kernel_launch: memset of barrier words failed\n"); return; }
    Params p{};
    for (int i = 0; i < 21; ++i) p.in[i] = (const float*)d_in[i];
    p.out = (float*)d_out; p.ws = (unsigned char*)d_ws;
#if MULTI_LAUNCH
    for (int ph = 0; ph < NPH; ++ph) {
        p.ph_lo = ph; p.ph_hi = ph + 1;
        hipLaunchKernelGGL(mega, dim3(grid), dim3(NTHREADS), LDS_TOTAL, stream, p);
    }
#else
    p.ph_lo = 0; p.ph_hi = NPH;
    void* args[] = {&p};
    hipError_t e = hipLaunchCooperativeKernel((const void*)mega, dim3(grid), dim3(NTHREADS), args, LDS_TOTAL, stream);
    if (e != hipSuccess) fprintf(stderr, "cooperative launch failed: %s (grid %d)\n", hipGetErrorString(e), grid);
#endif
}
```

```cpp
#include <hip/hip_runtime.h>
#include <hip/hip_cooperative_groups.h>
#include <cstdio>
namespace cg = cooperative_groups;

#define DEVI __device__ __forceinline__
#define LAS __attribute__((address_space(3)))
typedef unsigned short bf16_t;
typedef short bf16x8 __attribute__((ext_vector_type(8)));
typedef float f32x4 __attribute__((ext_vector_type(4)));
typedef unsigned u32x4 __attribute__((ext_vector_type(4)));
typedef unsigned u32x2 __attribute__((ext_vector_type(2)));

constexpr int DM = 1024, NB = 16, SEQ = 2048, LCTX = 256, NLAT = NB * SEQ, NCTX = NB * LCTX, RT_ = NLAT + NCTX;
constexpr int ZM = 2816, ZGW = 3072, INC = 5888, HID = 4096;
constexpr int C_RK = 0, C_RV = 256, C_AK = 768, C_AV = 896, C_RQ = 1024, C_RG = 1280, C_AQ = 1792, C_PU = 2304;
constexpr float EPS = 1e-6f;
constexpr int NTHREADS = 512;
constexpr int LDS_BYTES = 131072;
constexpr int LDS_TOTAL = LDS_BYTES + 16;

constexpr size_t OFF_ZG = 0;
constexpr size_t OFF_YB = OFF_ZG + (size_t)RT_ * ZGW * 2;
constexpr size_t OFF_UB = OFF_YB + (size_t)RT_ * 1536 * 2;
constexpr size_t OFF_XC = OFF_UB + (size_t)RT_ * 1024 * 2;
constexpr size_t OFF_WB = OFF_XC + (size_t)NCTX * 1024 * 4;
constexpr size_t W_IN = 0, W_BR = W_IN + (size_t)INC * 1024, W_O = W_BR + 3 * 512 * 1024, W_1 = W_O + 1024 * 1024, W_2 = W_1 + 4096 * 1024, W_END = W_2 + 4096 * 1024;
constexpr size_t OFF_RS = OFF_WB + W_END * 2;
constexpr size_t OFF_MOD = OFF_RS + (size_t)NB * 4 * 2 * 18 * 8192 * 2;
constexpr size_t OFF_RT = OFF_MOD + 2 * 17 * 6144 * 4;
constexpr size_t OFF_AT = OFF_RT + 2048 * 32 * 8;
constexpr size_t OFF_BAR = OFF_AT + 64 * 16 * 8;
constexpr size_t BAR_BYTES = 16384;
constexpr size_t OFF_SSQ2 = OFF_BAR + BAR_BYTES;
constexpr size_t OFF_SHW2 = OFF_SSQ2 + (size_t)2 * RT_ * 4;
constexpr size_t OFF_A2 = OFF_SHW2 + (size_t)2 * 17 * 4096 * 4;
constexpr size_t WS_END = OFF_A2 + (size_t)2 * 17 * 1024 * 4;
constexpr size_t OFF_U2 = OFF_ZG;
constexpr size_t OFF_H = OFF_ZG + (size_t)RT_ * 1024 * 2;
static_assert(OFF_H + (size_t)RT_ * 4096 * 2 <= OFF_XC, "H overlaps the ctx stream");

struct Params { const float* in[21]; float* out; unsigned char* ws; int ph_lo, ph_hi; };

DEVI int opaque_tid(int wv) { int ln; asm volatile("v_mbcnt_lo_u32_b32 %0, -1, 0\n\tv_mbcnt_hi_u32_b32 %0, -1, %0" : "=v"(ln)); return wv * 64 + ln; }
DEVI float bf2f(bf16_t h) { return __uint_as_float(((unsigned)h) << 16); }
DEVI float bflo(unsigned w) { return __uint_as_float(w << 16); }
DEVI float bfhi(unsigned w) { return __uint_as_float(w & 0xffff0000u); }
DEVI unsigned cvt_pk_bf16(float lo, float hi) { unsigned r; asm volatile("v_cvt_pk_bf16_f32 %0, %1, %2" : "=v"(r) : "v"(lo), "v"(hi)); return r; }
DEVI bf16_t f2bf(float f) { return (bf16_t)(cvt_pk_bf16(f, 0.f) & 0xffffu); }
DEVI float wsum(float v) {
#pragma unroll
    for (int o = 32; o > 0; o >>= 1) v += __shfl_xor(v, o);
    return v; }
DEVI float wmax(float v) {
#pragma unroll
    for (int o = 32; o > 0; o >>= 1) v = fmaxf(v, __shfl_xor(v, o));
    return v; }
DEVI float sigmoidf_(float g) { return __builtin_amdgcn_rcpf(1.0f + __expf(-g)); }
DEVI const float* xrow_in(const Params& p, int l, int row) {
    if (l == 0) return row < NLAT ? p.in[0] + (size_t)row * DM : p.in[2] + (size_t)(row - NLAT) * DM;
    return row < NLAT ? p.out + (size_t)row * DM : (const float*)(p.ws + OFF_XC) + (size_t)(row - NLAT) * DM;
}
DEVI float* xrow_out(const Params& p, int row) { return row < NLAT ? p.out + (size_t)row * DM : (float*)(p.ws + OFF_XC) + (size_t)(row - NLAT) * DM; }
DEVI const float* modrow(const Params& p, int l, int row) { const int bi = row < NLAT ? (row >> 11) : 16; return (const float*)(p.ws + OFF_MOD) + (size_t)(l * 17 + bi) * 6144; }

namespace pg8 {
constexpr int BM = 256, BK = 64, HALF = 128, HTB = HALF * BK * 2, NXCD = 8, WGM = 8;
DEVI int lds_byte(int r, int c) { const int st = (r >> 4) * 2 + (c >> 5), rr = r & 15, cc = c & 31, ob = rr * 64 + cc * 2; return st * 1024 + (ob ^ (((ob >> 9) & 1) << 5)); }
DEVI void stage_rc(int b, int& R, int& C) { const int st = b / 1024, sb = b % 1024, swz = sb ^ (((sb >> 9) & 1) << 5); R = (st >> 1) * 16 + swz / 64; C = (st & 1) * 32 + (swz % 64) / 2; }
DEVI int perm32(int rho) { const int n = rho >> 4, i = rho & 15; return 8 * (i >> 2) + 4 * n + (i & 3); }

struct Unit { int pm, pn, pb; };
struct Gemm { const bf16_t* A; const bf16_t* Bt; int lda, ldb, K; size_t a_bs, b_bs; };
struct Order {
    int nM, nN, nwg, G, c, nb, tail_units, tail_nN;
    DEVI void init(int M, int N, int G_, int c_, int nb_) { nM = M / BM; nN = N / BM; nwg = nM * nN; G = G_; c = c_; nb = nb_; tail_units = 0; tail_nN = 1; }
    DEVI void set_tail(int tail_rows, int tail_nN_) { tail_nN = tail_nN_; tail_units = (tail_rows / BM) * tail_nN_; }
    DEVI bool next(int i, Unit& u) const {
        const int ti = i / nb; u.pb = i - ti * nb;
        const long L = (long)ti * G + c;
        if (L >= nwg) { const int t = (int)(L - nwg); if (t >= tail_units) return false; u.pm = nM + t / tail_nN; u.pn = t % tail_nN; return true; }
        int wgid = (int)L; { const int q = nwg / NXCD, r = nwg % NXCD, xcd = wgid % NXCD, off = wgid / NXCD; wgid = (xcd < r ? xcd * (q + 1) : r * (q + 1) + (xcd - r) * q) + off; }
        const int nig = WGM * nN, gid = wgid / nig, fm = gid * WGM, gsz = (nM - fm) < WGM ? (nM - fm) : WGM;
        u.pm = fm + ((wgid % nig) % gsz); u.pn = (wgid % nig) / gsz; return true;
    }
};

template <int ACT  , bool RS = false  > struct EpiBf16 {
    static constexpr bool PERM = true;
    bf16_t* O; int ldc; const float* ssq; const float* shw; int ldshw;
    DEVI bool keep(const Unit&) const { return false; }
    DEVI void operator()(f32x4 (&acc)[2][2][4][2], const Unit& u, int wr, int wc, int fr, int fq) const {
        const int row0 = u.pm * BM + wr * 64 + fr, col0 = u.pn * BM + wc * 32 + 8 * fq;
        f32x4 sh[2][2];
        if (RS) { const int bi = u.pm * BM < NLAT ? (u.pm * BM) >> 11 : 16;
#pragma unroll
            for (int bj = 0; bj < 2; ++bj) { sh[bj][0] = *(const f32x4*)(shw + (size_t)bi * ldshw + col0 + bj * HALF); sh[bj][1] = *(const f32x4*)(shw + (size_t)bi * ldshw + col0 + bj * HALF + 4); } }
#pragma unroll
        for (int ai = 0; ai < 2; ++ai)
#pragma unroll
            for (int m = 0; m < 4; ++m) { bf16_t* rowp = O + (size_t)(row0 + ai * HALF + m * 16) * ldc + col0;
                float rstd = 1.0f; if (RS) rstd = rsqrtf(ssq[row0 + ai * HALF + m * 16] * (1.0f / 1024.0f) + EPS);
#pragma unroll
                for (int bj = 0; bj < 2; ++bj) { f32x4 v0 = acc[ai][bj][m][0], v1 = acc[ai][bj][m][1];
                    if (RS) { v0 = v0 * rstd + sh[bj][0]; v1 = v1 * rstd + sh[bj][1]; }
                    if (ACT == 1) {
#pragma unroll
                        for (int j = 0; j < 4; ++j) { const float a = fmaxf(v0[j], 0.f), b = fmaxf(v1[j], 0.f); v0[j] = a * a; v1[j] = b * b; } }
                    if (ACT == 2) {
#pragma unroll
                        for (int j = 0; j < 4; ++j) { v0[j] = 1.0f + __expf(-fminf(fmaxf(v0[j], -30.f), 30.f)); v1[j] = 1.0f + __expf(-fminf(fmaxf(v1[j], -30.f), 30.f)); } }
                    u32x4 w; w.x = cvt_pk_bf16(v0[0], v0[1]); w.y = cvt_pk_bf16(v0[2], v0[3]); w.z = cvt_pk_bf16(v1[0], v1[1]); w.w = cvt_pk_bf16(v1[2], v1[3]);
                    *(u32x4*)(rowp + bj * HALF) = w; } }
    }
};
struct EpiMerge {
    static constexpr bool PERM = true;
    const bf16_t* Gt; bf16_t* O;
    DEVI bool keep(const Unit& u) const { return u.pb < 2; }
    DEVI void operator()(f32x4 (&acc)[2][2][4][2], const Unit& u, int wr, int wc, int fr, int fq) const {
        const int row0 = u.pm * BM + wr * 64 + fr, col0 = u.pn * BM + wc * 32 + 8 * fq;
        const bool mid = u.pb < 2;
#pragma unroll
        for (int ai = 0; ai < 2; ++ai) {
            u32x4 ga[4][2], gb[4][2];
#pragma unroll
            for (int m = 0; m < 4; ++m)
#pragma unroll
                for (int bj = 0; bj < 2; ++bj) { const bf16_t* gp = Gt + (size_t)(row0 + ai * HALF + m * 16) * ZGW + u.pb * 1024 + col0 + bj * HALF;
                    ga[m][bj] = *(const u32x4*)gp; gb[m][bj] = mid ? *(const u32x4*)(gp + 1024) : (u32x4){0x3f803f80u, 0x3f803f80u, 0x3f803f80u, 0x3f803f80u}; }
#pragma unroll
            for (int m = 0; m < 4; ++m)
#pragma unroll
                for (int bj = 0; bj < 2; ++bj) {
                    const u32x4 a = ga[m][bj], b = gb[m][bj];
                    float sc[8];
                    sc[0] = bflo(b.x) * __builtin_amdgcn_rcpf(bflo(a.x)); sc[1] = bfhi(b.x) * __builtin_amdgcn_rcpf(bfhi(a.x)); sc[2] = bflo(b.y) * __builtin_amdgcn_rcpf(bflo(a.y)); sc[3] = bfhi(b.y) * __builtin_amdgcn_rcpf(bfhi(a.y));
                    sc[4] = bflo(b.z) * __builtin_amdgcn_rcpf(bflo(a.z)); sc[5] = bfhi(b.z) * __builtin_amdgcn_rcpf(bfhi(a.z)); sc[6] = bflo(b.w) * __builtin_amdgcn_rcpf(bflo(a.w)); sc[7] = bfhi(b.w) * __builtin_amdgcn_rcpf(bfhi(a.w));
                    f32x4 v0 = acc[ai][bj][m][0], v1 = acc[ai][bj][m][1];
#pragma unroll
                    for (int j = 0; j < 4; ++j) { v0[j] *= sc[j]; v1[j] *= sc[4 + j]; }
                    if (mid) { acc[ai][bj][m][0] = v0; acc[ai][bj][m][1] = v1; }
                    else { u32x4 w; w.x = cvt_pk_bf16(v0[0], v0[1]); w.y = cvt_pk_bf16(v0[2], v0[3]); w.z = cvt_pk_bf16(v1[0], v1[1]); w.w = cvt_pk_bf16(v1[2], v1[3]);
                        *(u32x4*)(O + (size_t)(row0 + ai * HALF + m * 16) * DM + col0 + bj * HALF) = w; }
                }
        }
    }
};
struct EpiRes {
    static constexpr bool PERM = false;
    Params p; int l, goff;
    int in_is_stream;
    int emit;
    DEVI bool keep(const Unit&) const { return false; }
    DEVI void operator()(f32x4 (&acc)[2][2][4][2], const Unit& u, int wr, int wc, int fr, int fq) const {
        const int row0 = u.pm * BM + wr * 64 + fr, col0 = u.pn * BM + wc * 32 + 4 * fq;
        const float* gr = modrow(p, l, u.pm * BM) + goff + col0;
        f32x4 gv[2][2];
#pragma unroll
        for (int bj = 0; bj < 2; ++bj)
#pragma unroll
            for (int n = 0; n < 2; ++n) gv[bj][n] = *(const f32x4*)(gr + bj * HALF + n * 16);
        f32x4 av[2][2];
        if (emit) { const int bi = u.pm * BM < NLAT ? (u.pm * BM) >> 11 : 16; const float* ar = (const float*)(p.ws + OFF_A2) + (size_t)(l * 17 + bi) * 1024 + col0;
#pragma unroll
            for (int bj = 0; bj < 2; ++bj)
#pragma unroll
                for (int n = 0; n < 2; ++n) av[bj][n] = *(const f32x4*)(ar + bj * HALF + n * 16); }
#pragma unroll
        for (int am = 0; am < 4; ++am) {
            const int ai = am >> 1, mb = (am & 1) * 2;
            f32x4 xv[2][2][2];
#pragma unroll
            for (int mm = 0; mm < 2; ++mm) { const int r = row0 + ai * HALF + (mb + mm) * 16;
                const float* xi = (in_is_stream ? (const float*)xrow_out(p, r) : xrow_in(p, l, r)) + col0;
#pragma unroll
                for (int bj = 0; bj < 2; ++bj)
#pragma unroll
                    for (int n = 0; n < 2; ++n) xv[mm][bj][n] = *(const f32x4*)(xi + bj * HALF + n * 16); }
#pragma unroll
            for (int mm = 0; mm < 2; ++mm) { const int m = mb + mm; const int r = row0 + ai * HALF + m * 16; float* xo = xrow_out(p, r) + col0;
                float ssp = 0.f;
#pragma unroll
                for (int bj = 0; bj < 2; ++bj)
#pragma unroll
                    for (int n = 0; n < 2; ++n) { const f32x4 xn = xv[mm][bj][n] + gv[bj][n] * acc[ai][bj][m][n]; *(f32x4*)(xo + bj * HALF + n * 16) = xn;
                        if (emit) { ssp += xn[0] * xn[0] + xn[1] * xn[1] + xn[2] * xn[2] + xn[3] * xn[3];
                            const f32x4 ua = xn * av[bj][n]; u32x2 w; w.x = cvt_pk_bf16(ua[0], ua[1]); w.y = cvt_pk_bf16(ua[2], ua[3]);
                            *(u32x2*)((bf16_t*)(p.ws + OFF_U2) + (size_t)r * DM + col0 + bj * HALF + n * 16) = w; } }
                if (emit) { ssp += __shfl_xor(ssp, 16); ssp += __shfl_xor(ssp, 32); if (fq == 0) atomicAdd((float*)(p.ws + OFF_SSQ2) + (size_t)l * RT_ + r, ssp); } }
        }
    }
};

template <class Epi>
DEVI void gemm_phase(const int wv, LAS unsigned char* lds, const Gemm g, const Order& S, const Epi& E) {
    const int tid = opaque_tid(wv), wid = wv, lane = tid & 63, wr = wid >> 2, wc = wid & 3, fr = lane & 15, fq = lane >> 4;
    const int K = g.K, nt = K / BK;
    unsigned voffA[2], voffB[2];
#pragma unroll
    for (int i = 0; i < 2; ++i) { int R, C; stage_rc(tid * 16 + i * 8192, R, C); const int Rb = Epi::PERM ? ((R & ~31) + perm32(R & 31)) : R;
        voffA[i] = (unsigned)(R * g.lda + C) * 2u; voffB[i] = (unsigned)(Rb * g.ldb + C) * 2u; }
    const size_t kstep = (size_t)(BK * 2);
    const size_t hstepA = (size_t)HALF * g.lda * 2, hstepB = (size_t)HALF * g.ldb * 2;
    const size_t tstepA = 2 * hstepA, tstepB = 2 * hstepB;
    const unsigned ldsw = (unsigned)wid * 1024u;
    const int aoff = lds_byte(wr * 64 + fr, fq * 8), boff = lds_byte(wc * 32 + fr, fq * 8);
#define PG8_SA(b, h) (((b) * 2 + (h)) * HTB)
#define PG8_SB(b, h) ((4 + (b) * 2 + (h)) * HTB)
#define PG8_STAGE(bufoff, gbase, voff) do { _Pragma("unroll") for (int _i = 0; _i < 2; ++_i) \
        __builtin_amdgcn_global_load_lds((const unsigned*)((const char*)(gbase) + (voff)[_i]), (LAS unsigned*)(lds + (bufoff) + ldsw + _i * 8192), 16, 0, 0); } while (0)
#define PG8_LDA(dst, b, h) do { _Pragma("unroll") for (int m = 0; m < 4; ++m) _Pragma("unroll") for (int k = 0; k < 2; ++k) dst[m][k] = *(const LAS bf16x8*)(lds + PG8_SA(b, h) + aoff + m * 2048 + k * 1024); } while (0)
#define PG8_LDB(dst, b, h) do { _Pragma("unroll") for (int n = 0; n < 2; ++n) _Pragma("unroll") for (int k = 0; k < 2; ++k) dst[n][k] = *(const LAS bf16x8*)(lds + PG8_SB(b, h) + boff + n * 2048 + k * 1024); } while (0)
#define PG8_MMA(ai, bj, At, Bt) do { __builtin_amdgcn_s_setprio(1); _Pragma("unroll") for (int m = 0; m < 4; ++m) _Pragma("unroll") for (int n = 0; n < 2; ++n) _Pragma("unroll") for (int k = 0; k < 2; ++k) \
        acc[ai][bj][m][n] = __builtin_amdgcn_mfma_f32_16x16x32_bf16(Bt[n][k], At[m][k], acc[ai][bj][m][n], 0, 0, 0); __builtin_amdgcn_s_setprio(0); } while (0)
#define PG8_WAIT_V(n) asm volatile("s_waitcnt vmcnt(" #n ")" ::: "memory")
#define PG8_WAIT_L(n) asm volatile("s_waitcnt lgkmcnt(" #n ")" ::: "memory")
#define PG8_BAR __builtin_amdgcn_s_barrier()
#define PG8_SCHED __builtin_amdgcn_sched_barrier(0)
    Unit cur, nxt; int ui = 0;
    if (!S.next(0, cur)) return;
    f32x4 acc[2][2][4][2];
#pragma unroll
    for (int a = 0; a < 2; ++a)
#pragma unroll
        for (int b = 0; b < 2; ++b)
#pragma unroll
            for (int m = 0; m < 4; ++m)
#pragma unroll
                for (int n = 0; n < 2; ++n) acc[a][b][m][n] = (f32x4){0.f, 0.f, 0.f, 0.f};
    bf16x8 At[4][2], B0[2][2], B1[2][2];
    const char* cA = (const char*)g.A + (size_t)cur.pb * g.a_bs + (size_t)cur.pm * tstepA; const char* cB = (const char*)g.Bt + (size_t)cur.pb * g.b_bs + (size_t)cur.pn * tstepB;
    PG8_STAGE(PG8_SB(0, 0), cB, voffB); PG8_STAGE(PG8_SA(0, 0), cA, voffA); PG8_STAGE(PG8_SB(0, 1), cB + hstepB, voffB); PG8_STAGE(PG8_SA(0, 1), cA + hstepA, voffA);
    if (wr == 1) PG8_BAR;
    PG8_WAIT_V(4); PG8_BAR;
    PG8_STAGE(PG8_SB(1, 0), cB + kstep, voffB); PG8_STAGE(PG8_SA(1, 0), cA + kstep, voffA); PG8_STAGE(PG8_SB(1, 1), cB + hstepB + kstep, voffB);
    PG8_WAIT_V(6); PG8_BAR;
    for (;;) {
        const bool has_next = S.next(ui + 1, nxt);
        const char* nA = has_next ? (const char*)g.A + (size_t)nxt.pb * g.a_bs + (size_t)nxt.pm * tstepA : cA;
        const char* nB = has_next ? (const char*)g.Bt + (size_t)nxt.pb * g.b_bs + (size_t)nxt.pn * tstepB : cB;
        for (int t = 0; t < nt; t += 2) {
            const bool last = (t == nt - 2);
            const char* a1 = cA + (size_t)(t + 1) * kstep;
            const char* a2 = last ? nA : cA + (size_t)(t + 2) * kstep; const char* b2 = last ? nB : cB + (size_t)(t + 2) * kstep;
            const char* a3 = a2 + kstep; const char* b3 = b2 + kstep;
            PG8_LDB(B0, 0, 0); PG8_SCHED; PG8_LDA(At, 0, 0); PG8_STAGE(PG8_SA(1, 1), a1 + hstepA, voffA);
            PG8_WAIT_L(8); PG8_BAR; PG8_WAIT_L(0); PG8_MMA(0, 0, At, B0); PG8_BAR; PG8_SCHED;
            PG8_LDB(B1, 0, 1); PG8_STAGE(PG8_SB(0, 0), b2, voffB);
            PG8_BAR; PG8_WAIT_L(0); PG8_MMA(0, 1, At, B1); PG8_BAR;
            PG8_LDA(At, 0, 1); PG8_STAGE(PG8_SA(0, 0), a2, voffA);
            PG8_BAR; PG8_WAIT_L(0); PG8_MMA(1, 0, At, B0); PG8_BAR; PG8_SCHED;
            PG8_STAGE(PG8_SB(0, 1), b2 + hstepB, voffB);
            PG8_WAIT_V(6); PG8_BAR; PG8_MMA(1, 1, At, B1); PG8_BAR;
            PG8_LDB(B0, 1, 0); PG8_SCHED; PG8_LDA(At, 1, 0); PG8_STAGE(PG8_SA(0, 1), a2 + hstepA, voffA);
            PG8_WAIT_L(8); PG8_BAR; PG8_WAIT_L(0); PG8_MMA(0, 0, At, B0); PG8_BAR; PG8_SCHED;
            PG8_LDB(B1, 1, 1); PG8_STAGE(PG8_SB(1, 0), b3, voffB);
            PG8_BAR; PG8_WAIT_L(0); PG8_MMA(0, 1, At, B1); PG8_BAR;
            PG8_LDA(At, 1, 1); PG8_STAGE(PG8_SA(1, 0), a3, voffA);
            PG8_BAR; PG8_WAIT_L(0); PG8_MMA(1, 0, At, B0); PG8_BAR; PG8_SCHED;
            PG8_STAGE(PG8_SB(1, 1), b3 + hstepB, voffB);
            PG8_WAIT_V(6); PG8_BAR; PG8_MMA(1, 1, At, B1); PG8_BAR;
        }
        E(acc, cur, wr, wc, fr, fq);
        if (!E.keep(cur)) {
#pragma unroll
            for (int a = 0; a < 2; ++a)
#pragma unroll
                for (int b = 0; b < 2; ++b)
#pragma unroll
                    for (int m = 0; m < 4; ++m)
#pragma unroll
                        for (int n = 0; n < 2; ++n) acc[a][b][m][n] = (f32x4){0.f, 0.f, 0.f, 0.f};
        }
        if (!has_next) break;
        cur = nxt; cA = nA; cB = nB; ++ui;
    }
    PG8_WAIT_V(0);
    if (wr == 0) PG8_BAR;
    PG8_BAR;
#undef PG8_SA
#undef PG8_SB
#undef PG8_STAGE
#undef PG8_LDA
#undef PG8_LDB
#undef PG8_MMA
#undef PG8_WAIT_V
#undef PG8_WAIT_L
#undef PG8_BAR
#undef PG8_SCHED
}
}

#define XB_TMO      128
#define XB_XCNT(j)  (256  + 64 * (j))
#define XB_XSUB(j)  (1280 + 64 * (j))
#define XB_XGEN(j)  (2304 + 64 * (j))
#define XB_TOP      3328
#define XB_TOPGEN   3392
#define XCD_BAR_WORDS 3456
#define XB_SPIN_CAP (1u << 22)
DEVI unsigned xb_ld(unsigned* p)              { return __hip_atomic_load(p, __ATOMIC_RELAXED, __HIP_MEMORY_SCOPE_AGENT); }
DEVI unsigned xb_add(unsigned* p, unsigned v) { return __hip_atomic_fetch_add(p, v, __ATOMIC_RELAXED, __HIP_MEMORY_SCOPE_AGENT); }
DEVI unsigned xb_xcc_id() { return (unsigned)__builtin_amdgcn_s_getreg((3 << 11) | 20) & 0xFu; }
#define XB_SPIN(cond, bar) do { unsigned _sp = 0; while (cond) { __builtin_amdgcn_s_sleep(1); \
    if ((++_sp & 255u) == 0u) { if (xb_ld(&(bar)[XB_TMO])) break; if (_sp > XB_SPIN_CAP) { atomicAdd(&(bar)[XB_TMO], 1u); break; } } } } while (0)
struct XcdBarrier { unsigned* bar; unsigned x; volatile LAS unsigned* st; };
DEVI void xcd_barrier_complete(unsigned* bar, unsigned x, unsigned& nloc, unsigned& nx) {
    const unsigned G = gridDim.x;
    unsigned sum, cnt, mine, sp = 0u;
    for (;;) {
        sum = 0u; cnt = 0u; mine = 0u;
#pragma unroll
        for (unsigned j = 0; j < 16; ++j) { const unsigned c = xb_ld(&bar[XB_XCNT(j)]); sum += c; cnt += (c > 0u) ? 1u : 0u; mine = (j == x) ? c : mine; }
        if (sum == G) break;
        __builtin_amdgcn_s_sleep(1);
        if ((++sp & 255u) == 0u) { if (xb_ld(&bar[XB_TMO])) break; if (sp > XB_SPIN_CAP) { atomicAdd(&bar[XB_TMO], 1u); break; } }
    }
    nloc = mine > 0u ? mine : 1u; nx = cnt > 0u ? cnt : 1u;
}
DEVI void xcd_barrier(const XcdBarrier& b, const int wv) {
    asm volatile("s_waitcnt vmcnt(0)" ::: "memory");
    __syncthreads();
    if (opaque_tid(wv) == 0) {
        unsigned* bar = b.bar;
        __builtin_amdgcn_s_waitcnt(0);
        unsigned nloc = b.st[0], nx = b.st[1];
        if (nloc == 0u) { xcd_barrier_complete(bar, b.x, nloc, nx); b.st[0] = nloc; b.st[1] = nx; }
        const unsigned old = xb_add(&bar[XB_XSUB(b.x)], 1u);
        const unsigned gen = old / nloc;
        if (old + 1u == (gen + 1u) * nloc) {
            __builtin_amdgcn_fence(__ATOMIC_RELEASE, "agent");
            asm volatile("s_waitcnt vmcnt(0)" ::: "memory");
            const unsigned og = xb_add(&bar[XB_TOP], 1u);
            const unsigned tg = og / nx;
            if (og + 1u == (tg + 1u) * nx) xb_add(&bar[XB_TOPGEN], 1u);
            else XB_SPIN(xb_ld(&bar[XB_TOPGEN]) == tg, bar);
            __builtin_amdgcn_fence(__ATOMIC_ACQUIRE, "agent");
            xb_add(&bar[XB_XGEN(b.x)], 1u);
            asm volatile("s_waitcnt vmcnt(0)" ::: "memory");
        } else {
            XB_SPIN(xb_ld(&bar[XB_XGEN(b.x)]) == gen, bar);
            __builtin_amdgcn_fence(__ATOMIC_ACQUIRE, "agent");
            asm volatile("s_waitcnt vmcnt(0)" ::: "memory");
        }
    }
    __syncthreads();
}

DEVI void ph_setup(const int wv, const Params& p, unsigned char* lds) {
    const int tid = opaque_tid(wv);
    for (int e = blockIdx.x * NTHREADS + tid; e < 2 * RT_; e += gridDim.x * NTHREADS) ((float*)(p.ws + OFF_SSQ2))[e] = 0.f;
    float* scv = (float*)lds;
    float* red = scv + 17 * 1024;
    for (int it = blockIdx.x; it < 192 + 130; it += gridDim.x) {
        if (it < 192) {
            const int l = it / 96, n0 = (it % 96) * 64;
            for (int e = tid; e < 17 * 1024; e += NTHREADS) { const int r = e >> 10, k = e & 1023; const float v = r < 16 ? p.in[1][r * 1024 + k] : p.in[3][k]; scv[e] = v / (1.0f + expf(-v)); }
            __syncthreads();
            const int n = tid & 63, kg = tid >> 6;
            float acc[17];
#pragma unroll
            for (int r = 0; r < 17; ++r) acc[r] = 0.f;
            const float* w = p.in[6] + (size_t)l * 1024 * 6144 + n0 + n;
            for (int k = kg * 128; k < kg * 128 + 128; ++k) { const float wv = w[(size_t)k * 6144];
#pragma unroll
                for (int r = 0; r < 17; ++r) acc[r] += scv[r * 1024 + k] * wv; }
#pragma unroll
            for (int r = 0; r < 17; ++r) red[(kg * 17 + r) * 64 + n] = acc[r];
            __syncthreads();
            float* mod = (float*)(p.ws + OFF_MOD);
            for (int e = tid; e < 17 * 64; e += NTHREADS) { const int r = e >> 6, nn = e & 63; float s = 0.f;
#pragma unroll
                for (int q = 0; q < 8; ++q) s += red[(q * 17 + r) * 64 + nn];
                mod[(size_t)(l * 17 + r) * 6144 + n0 + nn] = s + p.in[7][l * 6144 + n0 + nn]; }
            __syncthreads();
        } else {
            const int e = (it - 192) * NTHREADS + tid;
            if (e < 65536) { const int pos = e >> 5, i = e & 31; const float fr = powf(10000.0f, -(float)i / 32.0f); const float ang = (float)pos * fr;
                const double tr = (double)ang * 0.15915494309189535; const float tf = (float)(tr - floor(tr));
                ((float2*)(p.ws + OFF_RT))[e] = make_float2(__builtin_amdgcn_cosf(tf), __builtin_amdgcn_sinf(tf)); }
            else { const int e2 = e - 65536; const int pos = e2 >> 4, i = e2 & 15; const float fr = powf(10000.0f, -(float)i / 16.0f); const float ang = (float)pos * fr;
                const double tr = (double)ang * 0.15915494309189535; const float tf = (float)(tr - floor(tr));
                ((float2*)(p.ws + OFF_AT))[e2] = make_float2(__builtin_amdgcn_cosf(tf), __builtin_amdgcn_sinf(tf)); }
        }
    }
}

DEVI void ph_shw(const int wv, const Params& p, int l, unsigned char* lds, int blk_lo) {
    const int tid = opaque_tid(wv);
    if ((int)blockIdx.x < blk_lo) return;
    const int bx = blockIdx.x - blk_lo, nbx = gridDim.x - blk_lo;
    float* shv = (float*)lds;
    float* red = shv + 17 * 1024;
    const float* mod = (const float*)(p.ws + OFF_MOD) + (size_t)l * 17 * 6144;
    for (int e = bx * NTHREADS + tid; e < 17 * 1024; e += nbx * NTHREADS) { const int r = e >> 10, k = e & 1023;
        ((float*)(p.ws + OFF_A2))[(size_t)l * 17 * 1024 + e] = p.in[5][l * 1024 + k] * (1.0f + mod[(size_t)r * 6144 + 4096 + k]); }
    for (int it = bx; it < 256; it += nbx) {
        const int n0 = it * 16;
        __syncthreads();
        for (int e = tid; e < 17 * 1024; e += NTHREADS) { const int r = e >> 10, k = e & 1023; shv[e] = mod[(size_t)r * 6144 + 3072 + k]; }
        __syncthreads();
        const int n = tid & 15, kg = tid >> 4;
        float acc[17];
#pragma unroll
        for (int r = 0; r < 17; ++r) acc[r] = 0.f;
        const float* w = p.in[19] + (size_t)l * 1024 * 4096 + n0 + n;
#pragma unroll 8
        for (int k = kg * 32; k < kg * 32 + 32; ++k) { const float wvv = w[(size_t)k * 4096];
#pragma unroll
            for (int r = 0; r < 17; ++r) acc[r] += shv[r * 1024 + k] * wvv; }
#pragma unroll
        for (int r = 0; r < 17; ++r) red[(kg * 17 + r) * 16 + n] = acc[r];
        __syncthreads();
        for (int e = tid; e < 17 * 16; e += NTHREADS) { const int r = e >> 4, nn = e & 15; float sacc = 0.f;
#pragma unroll
            for (int q = 0; q < 32; ++q) sacc += red[(q * 17 + r) * 16 + nn];
            ((float*)(p.ws + OFF_SHW2))[(size_t)(l * 17 + r) * 4096 + n0 + nn] = sacc; }
    }
    __syncthreads();
}

DEVI void ph_convert(const int wv, const Params& p, int l, unsigned char* lds, int mode  , int blk_lo) {
    const int tid = opaque_tid(wv);
    float* tile = (float*)lds;
    bf16_t* WB = (bf16_t*)(p.ws + OFF_WB);
    if ((int)blockIdx.x < blk_lo) return;
    const int nitems = mode == 0 ? 4032 + 64 : (mode == 1 ? 3008 + 64 : (mode == 2 ? 1024 : (mode == 3 ? 1984 + 64 : 2048)));
    for (int j = blockIdx.x - blk_lo; j < nitems; j += gridDim.x - blk_lo) {
        const int it = mode == 0 ? j : (mode == 1 ? (j < 3008 ? j : j + 1024) : (mode == 2 ? j + 3008 : (mode == 3 ? (j < 1984 ? j : j + 2048) : j + 1984)));
        if (it < 4032) {
            const float* src; bf16_t* dst; int K, N, t;
            if (it < 1472) { t = it; src = p.in[8] + (size_t)l * 1024 * INC; dst = WB + W_IN; K = 1024; N = INC; }
            else if (it < 1600) { t = it - 1472; src = p.in[15] + (size_t)l * 512 * 1024; dst = WB + W_BR; K = 512; N = 1024; }
            else if (it < 1728) { t = it - 1600; src = p.in[17] + (size_t)l * 512 * 1024; dst = WB + W_BR + 2 * 512 * 1024; K = 512; N = 1024; }
            else if (it < 1984) { t = it - 1728; src = p.in[18] + (size_t)l * 1024 * 1024; dst = WB + W_O; K = 1024; N = 1024; }
            else if (it < 3008) { t = it - 1984; src = p.in[19] + (size_t)l * 1024 * 4096; dst = WB + W_1; K = 1024; N = 4096; }
            else { t = it - 3008; src = p.in[20] + (size_t)l * 4096 * 1024; dst = WB + W_2; K = 4096; N = 1024; }
            const int nkt = K / 64, k0 = (t % nkt) * 64, n0 = (t / nkt) * 64;
            for (int e = tid; e < 4096; e += NTHREADS) { const int kk = e >> 6, nn = e & 63; tile[kk * 65 + nn] = src[(size_t)(k0 + kk) * N + n0 + nn]; }
            __syncthreads();
            for (int e = tid; e < 4096; e += NTHREADS) { const int nn = e >> 6, kk = e & 63; dst[(size_t)(n0 + nn) * K + k0 + kk] = f2bf(tile[kk * 65 + nn]); }
            __syncthreads();
        } else {
            const int pi = it - 4032, g = pi >> 4, n0 = (pi & 15) * 64;
            const int n = tid & 63, ig = tid >> 6;
            const float* pw = p.in[10] + (size_t)l * 4 * 128 * 128 + (size_t)g * 128 * 128 + (size_t)(ig * 16) * 128;
            const float* ps = p.in[11] + l * 512 + g * 128;
            const float* wpo = p.in[16] + (size_t)l * 512 * 1024 + (size_t)(g * 128) * 1024 + n0 + n;
            float acc[16];
#pragma unroll
            for (int ii = 0; ii < 16; ++ii) acc[ii] = 0.f;
            for (int j = 0; j < 128; ++j) { const float wv = ps[j] * wpo[(size_t)j * 1024];
#pragma unroll
                for (int ii = 0; ii < 16; ++ii) acc[ii] += pw[ii * 128 + j] * wv; }
            bf16_t* dst = WB + W_BR + 512 * 1024 + (size_t)(n0 + n) * 512 + g * 128 + ig * 16;
            u32x4 w0, w1;
            w0.x = cvt_pk_bf16(acc[0], acc[1]); w0.y = cvt_pk_bf16(acc[2], acc[3]); w0.z = cvt_pk_bf16(acc[4], acc[5]); w0.w = cvt_pk_bf16(acc[6], acc[7]);
            w1.x = cvt_pk_bf16(acc[8], acc[9]); w1.y = cvt_pk_bf16(acc[10], acc[11]); w1.z = cvt_pk_bf16(acc[12], acc[13]); w1.w = cvt_pk_bf16(acc[14], acc[15]);
            *(u32x4*)dst = w0; *(u32x4*)(dst + 8) = w1;
        }
    }
}

DEVI void ph_norm(const int wv, const Params& p, int l, int which  , int nrows) {
    const int tid = opaque_tid(wv); const int lane = tid & 63, wave = wv;
    const float* nw = p.in[which ? 5 : 4] + l * 1024;
    const int shoff = which ? 3072 : 0, scoff = which ? 4096 : 1024;
    bf16_t* U = (bf16_t*)(p.ws + OFF_UB);
    const int stride = gridDim.x * 8;
    for (int row0 = blockIdx.x * 8 + wave; row0 < nrows; row0 += 2 * stride) {
        f32x4 v[2][4]; float ss[2];
#pragma unroll
        for (int q = 0; q < 2; ++q) { const int row = row0 + q * stride; ss[q] = 0.f;
            if (row < nrows) { const float* x = which ? (const float*)xrow_out(p, row) : xrow_in(p, l, row);
#pragma unroll
                for (int i = 0; i < 4; ++i) v[q][i] = *(const f32x4*)(x + i * 256 + lane * 4); }
            else {
#pragma unroll
                for (int i = 0; i < 4; ++i) v[q][i] = (f32x4){0.f, 0.f, 0.f, 0.f}; } }
#pragma unroll
        for (int q = 0; q < 2; ++q) {
#pragma unroll
            for (int i = 0; i < 4; ++i) ss[q] += v[q][i][0] * v[q][i][0] + v[q][i][1] * v[q][i][1] + v[q][i][2] * v[q][i][2] + v[q][i][3] * v[q][i][3];
            ss[q] = wsum(ss[q]); }
#pragma unroll
        for (int q = 0; q < 2; ++q) { const int row = row0 + q * stride;
            if (row < nrows) { const float* md = modrow(p, l, row); const float rstd = rsqrtf(ss[q] * (1.0f / 1024.0f) + EPS);
#pragma unroll
                for (int i = 0; i < 4; ++i) { const int c = i * 256 + lane * 4;
                    const f32x4 w = *(const f32x4*)(nw + c), sc = *(const f32x4*)(md + scoff + c), sh = *(const f32x4*)(md + shoff + c);
                    const f32x4 o = v[q][i] * rstd * w * (1.0f + sc) + sh;
                    u32x2 pk; pk.x = cvt_pk_bf16(o[0], o[1]); pk.y = cvt_pk_bf16(o[2], o[3]);
                    *(u32x2*)(U + (size_t)row * 1024 + c) = pk; } } }
    }
}

DEVI void unpack8(const u32x4 w, float (&v)[8]) { v[0] = bflo(w.x); v[1] = bfhi(w.x); v[2] = bflo(w.y); v[3] = bfhi(w.y); v[4] = bflo(w.z); v[5] = bfhi(w.z); v[6] = bflo(w.w); v[7] = bfhi(w.w); }
DEVI void ph_prep(const int wv, const Params& p, int l, int nrows_pool, unsigned char* lds_raw) {
    const int tid = opaque_tid(wv); const int lane = tid & 63;
    bf16_t* Z = (bf16_t*)(p.ws + OFF_ZG); bf16_t* YB = (bf16_t*)(p.ws + OFF_YB);
    const float* RTf = (const float*)(p.ws + OFF_RT); const float* ATf = (const float*)(p.ws + OFF_AT);
    const int sub = lane & 7, hslot = lane >> 3, d0 = sub * 8;
    constexpr int NINST = RT_ * 6;
    for (int base = (blockIdx.x * 8 + wv) * 32; base < NINST; base += gridDim.x * 8 * 32) {
        u32x4 w[4]; int rowv[4], hhv[4], colv[4];
#pragma unroll
        for (int u = 0; u < 4; ++u) { const int hi = base + u * 8 + hslot; const int row = hi / 6, h6 = hi - row * 6, hh = h6 < 4 ? h6 : h6 + 4; rowv[u] = row; hhv[u] = hh;
            colv[u] = (hh < 4 ? C_RK + hh * 64 : hh < 8 ? C_RQ + (hh - 4) * 64 : hh < 10 ? C_AK + (hh - 8) * 64 : C_AQ + (hh - 10) * 64) + d0;
            w[u] = *(const u32x4*)(Z + (size_t)row * ZM + colv[u]); }
#pragma unroll
        for (int u = 0; u < 4; ++u) {
            const int row = rowv[u], hh = hhv[u]; const bool lat = row < NLAT; const int pos = row & 2047;
            float v[8]; unpack8(w[u], v);
            if (hh >= 8) {
                float ss = 0.f;
#pragma unroll
                for (int e = 0; e < 8; ++e) ss += v[e] * v[e];
                ss += __shfl_xor(ss, 1); ss += __shfl_xor(ss, 2); ss += __shfl_xor(ss, 4);
                const float rstd = rsqrtf(ss * (1.0f / 64.0f) + EPS) * (hh >= 10 ? 0.125f * 1.4426950408889634f : 1.0f);
                const float* wp = p.in[hh < 10 ? 13 : 12] + l * 64 + d0;
                const f32x4 w0 = *(const f32x4*)wp, w1 = *(const f32x4*)(wp + 4);
#pragma unroll
                for (int e = 0; e < 4; ++e) { v[e] *= rstd * w0[e]; v[4 + e] *= rstd * w1[e]; }
                if (lat) { const int pp = (sub & 4) ? (pos & 63) : (pos >> 6); const float* cp = ATf + (size_t)(pp * 16 + (d0 & 15)) * 2; const bool up = (sub & 2) != 0;
#pragma unroll
                    for (int e = 0; e < 8; ++e) { const float o = __shfl_xor(v[e], 2); const float cc = cp[2 * e], sn = cp[2 * e + 1]; v[e] = up ? o * sn + v[e] * cc : v[e] * cc - o * sn; } }
            } else {
                if (lat) { const float* cp = RTf + (size_t)(pos * 32 + (d0 & 31)) * 2; const bool up = (sub & 4) != 0;
#pragma unroll
                    for (int e = 0; e < 8; ++e) { const float o = __shfl_xor(v[e], 4); const float cc = cp[2 * e], sn = cp[2 * e + 1]; v[e] = up ? o * sn + v[e] * cc : v[e] * cc - o * sn; } }
                if (hh < 4) {
#pragma unroll
                    for (int e = 0; e < 8; ++e) v[e] *= 0.125f; }
            }
            u32x4 o; o.x = cvt_pk_bf16(v[0], v[1]); o.y = cvt_pk_bf16(v[2], v[3]); o.z = cvt_pk_bf16(v[4], v[5]); o.w = cvt_pk_bf16(v[6], v[7]);
            *(u32x4*)(Z + (size_t)row * ZM + colv[u]) = o;
        }
    }
    LAS unsigned char* slab = (LAS unsigned char*)lds_raw;
    for (int it = blockIdx.x; it < nrows_pool / 64; it += gridDim.x) {
        const int r0 = it * 64; int sbase, L;
        if (r0 < NLAT) { sbase = r0 & ~2047; L = 2048; } else { sbase = NLAT + ((r0 - NLAT) & ~255); L = 256; }
        const int t0 = r0 - sbase, lo_row = max(t0 - 8, 0), hi_row = min(t0 + 72, L), nchunks = (hi_row - lo_row) * 64;
        __syncthreads();
        for (int e = tid; e < nchunks; e += NTHREADS) { const int rr = e >> 6, cch = e & 63; *(LAS u32x4*)(slab + rr * 1024 + cch * 16) = *(const u32x4*)(Z + (size_t)(sbase + lo_row + rr) * ZM + C_PU + cch * 8); }
        __syncthreads();
#pragma unroll 2
        for (int o = tid; o < 4096; o += NTHREADS) {
            const int rr = o >> 6, cch = o & 63, hw = 1 << (cch >> 4), t = t0 + rr, lo = max(t - hw, 0), hi = min(t + hw, L);
            float sacc[8];
#pragma unroll
            for (int j = 0; j < 8; ++j) sacc[j] = 0.f;
            for (int tt = lo; tt < hi; ++tt) { float v[8]; unpack8(*(const LAS u32x4*)(slab + (tt - lo_row) * 1024 + cch * 16), v);
#pragma unroll
                for (int j = 0; j < 8; ++j) sacc[j] += v[j]; }
            float own[8]; unpack8(*(const LAS u32x4*)(slab + (t - lo_row) * 1024 + cch * 16), own);
            const float inv = 1.0f / (float)(hi - lo);
            u32x4 ow; ow.x = cvt_pk_bf16(sacc[0] * inv - own[0], sacc[1] * inv - own[1]); ow.y = cvt_pk_bf16(sacc[2] * inv - own[2], sacc[3] * inv - own[3]);
            ow.z = cvt_pk_bf16(sacc[4] * inv - own[4], sacc[5] * inv - own[5]); ow.w = cvt_pk_bf16(sacc[6] * inv - own[6], sacc[7] * inv - own[7]);
            *(u32x4*)(YB + (size_t)(sbase + t) * 1536 + 512 + cch * 8) = ow;
        }
    }
    __syncthreads();
}

#define MFMA16(X, Y, ACC) __builtin_amdgcn_mfma_f32_16x16x32_bf16((X), (Y), (ACC), 0, 0, 0)
DEVI bf16x8 mk_frag(unsigned a, unsigned b, unsigned c, unsigned d) { u32x4 w; w.x = a; w.y = b; w.z = c; w.w = d; return __builtin_bit_cast(bf16x8, w); }
typedef short s16x4 __attribute__((ext_vector_type(4)));
DEVI bf16x8 tr_frag(LAS unsigned char* tile, int rs, int rowA, int rowB, int n0, int fr) {
    const s16x4 a = __builtin_amdgcn_ds_read_tr16_b64_v4i16((LAS s16x4*)(tile + (rowA + (fr >> 2)) * rs + n0 * 2 + 8 * (fr & 3)));
    const s16x4 b = __builtin_amdgcn_ds_read_tr16_b64_v4i16((LAS s16x4*)(tile + (rowB + (fr >> 2)) * rs + n0 * 2 + 8 * (fr & 3)));
    return __builtin_shufflevector(a, b, 0, 1, 2, 3, 4, 5, 6, 7);
}
DEVI void lds_put8_t(LAS unsigned char* base, int rowstride, int r0, int j, const u32x4 w) {
    *(LAS unsigned short*)(base + (r0 + 0) * rowstride + 2 * j) = (unsigned short)(w.x & 0xffffu); *(LAS unsigned short*)(base + (r0 + 1) * rowstride + 2 * j) = (unsigned short)(w.x >> 16);
    *(LAS unsigned short*)(base + (r0 + 2) * rowstride + 2 * j) = (unsigned short)(w.y & 0xffffu); *(LAS unsigned short*)(base + (r0 + 3) * rowstride + 2 * j) = (unsigned short)(w.y >> 16);
    *(LAS unsigned short*)(base + (r0 + 4) * rowstride + 2 * j) = (unsigned short)(w.z & 0xffffu); *(LAS unsigned short*)(base + (r0 + 5) * rowstride + 2 * j) = (unsigned short)(w.z >> 16);
    *(LAS unsigned short*)(base + (r0 + 6) * rowstride + 2 * j) = (unsigned short)(w.w & 0xffffu); *(LAS unsigned short*)(base + (r0 + 7) * rowstride + 2 * j) = (unsigned short)(w.w >> 16);
}

DEVI void ph_attn(const int wv, const Params& p, int l, unsigned char* lds_raw, int it_lo = 0) {
    const int tid = opaque_tid(wv), lane = tid & 63, wave = wv, fr = lane & 15, fq = lane >> 4;
    LAS unsigned char* Kl0 = (LAS unsigned char*)lds_raw;
    const bf16_t* Z = (const bf16_t*)(p.ws + OFF_ZG); bf16_t* YB = (bf16_t*)(p.ws + OFF_YB);
    const int nitems = 1024 + (l == 0 ? 128 : 0);
    for (int it = blockIdx.x + it_lo; it < nitems; it += gridDim.x) {
        int b, n, kvh, hp, qrow0; const bool isl = it < 1024;
        if (isl) { b = it >> 6; n = (it >> 2) & 15; kvh = (it >> 1) & 1; hp = it & 1; qrow0 = b * 2048 + n * 128; }
        else { const int i2 = it - 1024; b = i2 >> 3; n = (i2 >> 2) & 1; kvh = (i2 >> 1) & 1; hp = i2 & 1; qrow0 = NLAT + b * 256 + n * 128; }
        const int hq0 = kvh * 4 + hp * 2;
        const int ii = wave * 16 + fr;
        bf16x8 Qf[2][2];
#pragma unroll
        for (int g = 0; g < 2; ++g)
#pragma unroll
            for (int ks = 0; ks < 2; ++ks) Qf[g][ks] = *(const bf16x8*)(Z + (size_t)(qrow0 + ii) * ZM + C_AQ + (hq0 + g) * 64 + ks * 32 + fq * 8);
        {
            const int qpos = (qrow0 + ii) & 2047; const bool up = (fq & 2) != 0;
            float ssq[2]; float qv[2][2][8];
#pragma unroll
            for (int g = 0; g < 2; ++g) { ssq[g] = 0.f;
#pragma unroll
                for (int ks = 0; ks < 2; ++ks) { unpack8(__builtin_bit_cast(u32x4, Qf[g][ks]), qv[g][ks]);
#pragma unroll
                    for (int e = 0; e < 8; ++e) ssq[g] += qv[g][ks][e] * qv[g][ks][e]; }
                ssq[g] += __shfl_xor(ssq[g], 16); ssq[g] += __shfl_xor(ssq[g], 32);
                ssq[g] = rsqrtf(ssq[g] * (1.0f / 64.0f) + EPS) * (0.125f * 1.4426950408889634f); }
#pragma unroll
            for (int ks = 0; ks < 2; ++ks) {
                const float* wp = p.in[12] + l * 64 + ks * 32 + fq * 8;
                const f32x4 w0 = *(const f32x4*)wp, w1 = *(const f32x4*)(wp + 4);
                const float* cp = (const float*)(p.ws + OFF_AT) + (size_t)((ks ? (qpos & 63) : (qpos >> 6)) * 16 + (fq & 1) * 8) * 2;
                f32x4 cs[4];
                if (isl) {
#pragma unroll
                    for (int q4 = 0; q4 < 4; ++q4) cs[q4] = *(const f32x4*)(cp + 4 * q4); }
#pragma unroll
                for (int g = 0; g < 2; ++g) {
#pragma unroll
                    for (int e = 0; e < 8; ++e) { float v = qv[g][ks][e] * ssq[g] * (e < 4 ? w0[e & 3] : w1[e & 3]);
                        if (isl) { const float o = __shfl_xor(v, 32); const float cc = cs[e >> 1][(e & 1) * 2], sn = cs[e >> 1][(e & 1) * 2 + 1]; v = up ? o * sn + v * cc : v * cc - o * sn; }
                        qv[g][ks][e] = v; }
                    Qf[g][ks] = mk_frag(cvt_pk_bf16(qv[g][ks][0], qv[g][ks][1]), cvt_pk_bf16(qv[g][ks][2], qv[g][ks][3]), cvt_pk_bf16(qv[g][ks][4], qv[g][ks][5]), cvt_pk_bf16(qv[g][ks][6], qv[g][ks][7])); }
            }
        }
        float mrun[2], lrun[2]; f32x4 O[2][4];
#pragma unroll
        for (int g = 0; g < 2; ++g) { mrun[g] = p.in[14][l * 8 + hq0 + g] * 1.4426950408889634f; lrun[g] = fq == 0 ? 1.0f : 0.0f;
#pragma unroll
            for (int dt = 0; dt < 4; ++dt) O[g][dt] = (f32x4){0.f, 0.f, 0.f, 0.f}; }
#define AT_NEXT(T) ((isl && (T) == 1 && n == 15) ? 3 : (T) + 1)
#define AT_LOAD(T) do { const int krow0_ = (T) < 3 ? b * 2048 + (n - 1 + (T)) * 128 : NLAT + b * 256 + ((T) - 3) * 128; \
            _Pragma("unroll") for (int rep = 0; rep < 2; ++rep) { const int pi = tid + 512 * rep; \
                pk[rep] = *(const u32x4*)(Z + (size_t)(krow0_ + (pi >> 3)) * ZM + C_AK + kvh * 64 + (pi & 7) * 8); \
                pv[rep] = *(const u32x4*)(Z + (size_t)(krow0_ + (pi >> 3)) * ZM + C_AV + kvh * 64 + (pi & 7) * 8); } } while (0)
#define AT_WRITE(BUF) do { _Pragma("unroll") for (int rep = 0; rep < 2; ++rep) { const int pi = tid + 512 * rep; \
                *(LAS u32x4*)(Kl0 + (BUF) * 36864 + (pi >> 3) * 144 + (pi & 7) * 16) = pk[rep]; \
                *(LAS u32x4*)(Kl0 + (BUF) * 36864 + 18432 + (pi >> 3) * 144 + (pi & 7) * 16) = pv[rep]; } } while (0)
        int t = isl ? (n > 0 ? 0 : 1) : 3, buf = 0;
        u32x4 pk[2], pv[2];
        AT_LOAD(t);
        __syncthreads();
        AT_WRITE(0);
        { const int t1 = AT_NEXT(t); if (t1 < 5) AT_LOAD(t1); }
        while (t < 5) {
            const int tn = AT_NEXT(t);
            const int msgn = t == 0 ? 1 : (t == 2 ? -1 : 0);
            const int dbase = 4 * fq - ii;
            __syncthreads();
            if (tn < 5) { AT_WRITE(buf ^ 1); const int tnn = AT_NEXT(tn); if (tnn < 5) AT_LOAD(tnn); }
            LAS unsigned char* Kl = Kl0 + buf * 36864; LAS unsigned char* Vl = Kl + 18432;
            const int jlo = msgn > 0 ? wave : 0, jhi = msgn < 0 ? wave : 7;
            f32x4 sc[2][8];
#pragma unroll
            for (int jt = 0; jt < 8; ++jt) {
                if (jt < jlo || jt > jhi) { sc[0][jt] = (f32x4){-INFINITY, -INFINITY, -INFINITY, -INFINITY}; sc[1][jt] = sc[0][jt]; continue; }
                sc[0][jt] = (f32x4){0.f, 0.f, 0.f, 0.f}; sc[1][jt] = (f32x4){0.f, 0.f, 0.f, 0.f};
#pragma unroll
                for (int ks = 0; ks < 2; ++ks) { const bf16x8 kf = *(const LAS bf16x8*)(Kl + (jt * 16 + fr) * 144 + ks * 64 + fq * 16);
                    sc[0][jt] = MFMA16(kf, Qf[0][ks], sc[0][jt]); sc[1][jt] = MFMA16(kf, Qf[1][ks], sc[1][jt]); } }
#pragma unroll
            for (int g = 0; g < 2; ++g) {
                float mx = mrun[g];
                if (msgn != 0) {
#pragma unroll
                    for (int jt = 0; jt < 8; ++jt)
#pragma unroll
                        for (int i = 0; i < 4; ++i) { const int d = msgn * (dbase + jt * 16 + i); sc[g][jt][i] = d >= 0 ? sc[g][jt][i] : -INFINITY; }
                }
#pragma unroll
                for (int jt = 0; jt < 8; ++jt) { mx = fmaxf(fmaxf(mx, sc[g][jt][0]), sc[g][jt][1]); mx = fmaxf(fmaxf(mx, sc[g][jt][2]), sc[g][jt][3]); }
                mx = fmaxf(mx, __shfl_xor(mx, 16)); mx = fmaxf(mx, __shfl_xor(mx, 32));
                const float alpha = __builtin_amdgcn_exp2f(mrun[g] - mx); mrun[g] = mx;
                float ps = 0.f;
#pragma unroll
                for (int jt = 0; jt < 8; ++jt)
#pragma unroll
                    for (int i = 0; i < 4; ++i) { const float e = __builtin_amdgcn_exp2f(sc[g][jt][i] - mx); sc[g][jt][i] = e; ps += e; }
                lrun[g] = lrun[g] * alpha + ps;
#pragma unroll
                for (int dt = 0; dt < 4; ++dt) O[g][dt] *= alpha;
            }
#pragma unroll
            for (int sI = 0; sI < 4; ++sI) {
                if (2 * sI + 1 < jlo || 2 * sI > jhi) continue;
                const bf16x8 pf0 = mk_frag(cvt_pk_bf16(sc[0][2 * sI][0], sc[0][2 * sI][1]), cvt_pk_bf16(sc[0][2 * sI][2], sc[0][2 * sI][3]), cvt_pk_bf16(sc[0][2 * sI + 1][0], sc[0][2 * sI + 1][1]), cvt_pk_bf16(sc[0][2 * sI + 1][2], sc[0][2 * sI + 1][3]));
                const bf16x8 pf1 = mk_frag(cvt_pk_bf16(sc[1][2 * sI][0], sc[1][2 * sI][1]), cvt_pk_bf16(sc[1][2 * sI][2], sc[1][2 * sI][3]), cvt_pk_bf16(sc[1][2 * sI + 1][0], sc[1][2 * sI + 1][1]), cvt_pk_bf16(sc[1][2 * sI + 1][2], sc[1][2 * sI + 1][3]));
#pragma unroll
                for (int dt = 0; dt < 4; ++dt) {
                    const bf16x8 vf = tr_frag(Vl, 144, (2 * sI) * 16 + 4 * fq, (2 * sI + 1) * 16 + 4 * fq, dt * 16, fr);
                    O[0][dt] = MFMA16(vf, pf0, O[0][dt]); O[1][dt] = MFMA16(vf, pf1, O[1][dt]); }
            }
            t = tn; buf ^= 1;
        }
#undef AT_NEXT
#undef AT_LOAD
#undef AT_WRITE
#pragma unroll
        for (int g = 0; g < 2; ++g) { float lt = lrun[g]; lt += __shfl_xor(lt, 16); lt += __shfl_xor(lt, 32); const float inv = 1.0f / lt;
#pragma unroll
            for (int dt = 0; dt < 4; ++dt) { u32x2 w; w.x = cvt_pk_bf16(O[g][dt][0] * inv, O[g][dt][1] * inv); w.y = cvt_pk_bf16(O[g][dt][2] * inv, O[g][dt][3] * inv);
                *(u32x2*)(YB + (size_t)(qrow0 + ii) * 1536 + 1024 + (hq0 + g) * 64 + dt * 16 + 4 * fq) = w; } }
    }
    __syncthreads();
}

DEVI void ph_ret_state(const int wv, const Params& p, int l, unsigned char* lds_raw) {
    const int tid = opaque_tid(wv), lane = tid & 63, wave = wv, fr = lane & 15, fq = lane >> 4;
    LAS unsigned char* Kt = (LAS unsigned char*)lds_raw;
    LAS unsigned char* Vt = Kt + 18432;
    const bf16_t* Z = (const bf16_t*)(p.ws + OFF_ZG); bf16_t* RS = (bf16_t*)(p.ws + OFF_RS);
    for (int it = blockIdx.x; it < 256; it += gridDim.x) {
        const int b = it >> 4, h = (it >> 2) & 3, dir = (it >> 1) & 1, half = it & 1;
        const float e_ = p.in[9][(l * 2 + dir) * 4 + h];
        const float lg2 = log1pf(-exp2f(-e_)) * 1.4426950408889634f;
        const float gC = exp2f(128.0f * lg2);
        f32x4 R[2]; R[0] = (f32x4){0.f, 0.f, 0.f, 0.f}; R[1] = R[0];
        const int j0 = tid >> 3, g80 = tid & 7;
        const float wj0 = exp2f((float)(dir == 0 ? 127 - j0 : j0) * lg2), wj1 = exp2f((float)(dir == 0 ? 63 - j0 : j0 + 64) * lg2);
        u32x4 kwr[2], vwr[2];
        { const int cid0 = dir == 0 ? 0 : 1; const int row00 = NLAT + b * 256 + cid0 * 128;
#pragma unroll
          for (int rep = 0; rep < 2; ++rep) { const int jr = j0 + 64 * rep;
              kwr[rep] = *(const u32x4*)(Z + (size_t)(row00 + jr) * ZM + C_RK + h * 64 + g80 * 8);
              vwr[rep] = *(const u32x4*)(Z + (size_t)(row00 + jr) * ZM + C_RV + h * 128 + half * 64 + g80 * 8); } }
        for (int n = 0; n < 18; ++n) {
            const int cid = dir == 0 ? n : (n < 2 ? 1 - n : 19 - n);
#pragma unroll
            for (int tt = 0; tt < 2; ++tt) { const int t = wave * 2 + tt, dkt = t >> 2, dvt = t & 3;
                u32x2 w; w.x = cvt_pk_bf16(R[tt][0], R[tt][1]); w.y = cvt_pk_bf16(R[tt][2], R[tt][3]);
                *(u32x2*)(RS + ((size_t)((b * 4 + h) * 18 + cid) * 128 + half * 64 + dvt * 16 + fr) * 128 + dir * 64 + dkt * 16 + 4 * fq) = w; }
            if (n == 17) break;
            __syncthreads();
#pragma unroll
            for (int rep = 0; rep < 2; ++rep) { const int jr = j0 + 64 * rep; const float wj = rep ? wj1 : wj0;
                const u32x4 kw = kwr[rep];
                u32x4 ks; ks.x = cvt_pk_bf16(bflo(kw.x) * wj, bfhi(kw.x) * wj); ks.y = cvt_pk_bf16(bflo(kw.y) * wj, bfhi(kw.y) * wj); ks.z = cvt_pk_bf16(bflo(kw.z) * wj, bfhi(kw.z) * wj); ks.w = cvt_pk_bf16(bflo(kw.w) * wj, bfhi(kw.w) * wj);
                *(LAS u32x4*)(Kt + jr * 144 + g80 * 16) = ks; *(LAS u32x4*)(Vt + jr * 144 + g80 * 16) = vwr[rep]; }
            __syncthreads();
            if (n + 1 < 17) { const int n1 = n + 1; const int cid1 = dir == 0 ? n1 : (n1 < 2 ? 1 - n1 : 19 - n1);
                const int row01 = cid1 < 2 ? NLAT + b * 256 + cid1 * 128 : b * 2048 + (cid1 - 2) * 128;
#pragma unroll
                for (int rep = 0; rep < 2; ++rep) { const int jr = j0 + 64 * rep;
                    kwr[rep] = *(const u32x4*)(Z + (size_t)(row01 + jr) * ZM + C_RK + h * 64 + g80 * 8);
                    vwr[rep] = *(const u32x4*)(Z + (size_t)(row01 + jr) * ZM + C_RV + h * 128 + half * 64 + g80 * 8); } }
#pragma unroll
            for (int tt = 0; tt < 2; ++tt) { const int t = wave * 2 + tt, dkt = t >> 2, dvt = t & 3;
                f32x4 u = (f32x4){0.f, 0.f, 0.f, 0.f};
#pragma unroll
                for (int ks = 0; ks < 4; ++ks) { const bf16x8 xf = tr_frag(Kt, 144, ks * 32 + 8 * fq, ks * 32 + 8 * fq + 4, dkt * 16, fr), yf = tr_frag(Vt, 144, ks * 32 + 8 * fq, ks * 32 + 8 * fq + 4, dvt * 16, fr); u = MFMA16(xf, yf, u); }
                R[tt] = R[tt] * gC + u; }
        }
        __syncthreads();
    }
}

DEVI void ph_ret_out(const int wv, const Params& p, int l, unsigned char* lds_raw) {
    const int tid = opaque_tid(wv), lane = tid & 63, wave = wv, fr = lane & 15, fq = lane >> 4;
    LAS unsigned char* Kl = (LAS unsigned char*)lds_raw;
    LAS unsigned char* Ql = Kl + 18432;
    LAS unsigned char* Vt = Ql + 18432;
    LAS unsigned char* Rl = Vt + 36864;
    const bf16_t* Z = (const bf16_t*)(p.ws + OFF_ZG); const bf16_t* RS = (const bf16_t*)(p.ws + OFF_RS); bf16_t* YB = (bf16_t*)(p.ws + OFF_YB);
    const int nch = l == 0 ? 18 : 16, nitems = 64 * nch;
    u32x4 pk[2], pq[2], pr[4], pvv[4];
#define RO_LOAD(IT) do { const int bh_ = (IT) / nch, ci_ = (IT) - bh_ * nch, b_ = bh_ >> 2, h_ = bh_ & 3, cid_ = l == 0 ? ci_ : ci_ + 2; \
        const int row0_ = cid_ < 2 ? NLAT + b_ * 256 + cid_ * 128 : b_ * 2048 + (cid_ - 2) * 128; \
        _Pragma("unroll") for (int rep = 0; rep < 2; ++rep) { const int pi = tid + 512 * rep, r = pi >> 3, g8 = pi & 7; \
            pk[rep] = *(const u32x4*)(Z + (size_t)(row0_ + r) * ZM + C_RK + h_ * 64 + g8 * 8); pq[rep] = *(const u32x4*)(Z + (size_t)(row0_ + r) * ZM + C_RQ + h_ * 64 + g8 * 8); } \
        _Pragma("unroll") for (int rep = 0; rep < 4; ++rep) { const int pi = tid + 512 * rep; \
            pr[rep] = *(const u32x4*)(RS + ((size_t)(bh_ * 18 + cid_) * 128 + (pi >> 4)) * 128 + (pi & 15) * 8); \
            pvv[rep] = *(const u32x4*)(Z + (size_t)(row0_ + (pi >> 4)) * ZM + C_RV + h_ * 128 + (pi & 15) * 8); } } while (0)
    if ((int)blockIdx.x < nitems) RO_LOAD((int)blockIdx.x);
    for (int it = blockIdx.x; it < nitems; it += gridDim.x) {
        const int bh = it / nch, ci = it - bh * nch, b = bh >> 2, h = bh & 3, cid = l == 0 ? ci : ci + 2;
        const int row0 = cid < 2 ? NLAT + b * 256 + cid * 128 : b * 2048 + (cid - 2) * 128;
        const float lgf = log1pf(-exp2f(-p.in[9][(l * 2 + 0) * 4 + h])) * 1.4426950408889634f, lgb = log1pf(-exp2f(-p.in[9][(l * 2 + 1) * 4 + h])) * 1.4426950408889634f;
        __syncthreads();
#pragma unroll
        for (int rep = 0; rep < 2; ++rep) { const int pi = tid + 512 * rep, r = pi >> 3, g8 = pi & 7;
            *(LAS u32x4*)(Kl + r * 144 + g8 * 16) = pk[rep]; *(LAS u32x4*)(Ql + r * 144 + g8 * 16) = pq[rep]; }
#pragma unroll
        for (int rep = 0; rep < 4; ++rep) { const int pi = tid + 512 * rep;
            *(LAS u32x4*)(Rl + (pi >> 4) * 272 + (pi & 15) * 16) = pr[rep];
            *(LAS u32x4*)(Vt + (pi >> 4) * 288 + (pi & 15) * 16) = pvv[rep]; }
        __syncthreads();
        if (it + (int)gridDim.x < nitems) RO_LOAD(it + (int)gridDim.x);
        const int ii = wave * 16 + fr;
        bf16x8 Qf[2];
#pragma unroll
        for (int ks = 0; ks < 2; ++ks) Qf[ks] = *(const LAS bf16x8*)(Ql + ii * 144 + ks * 64 + fq * 16);
        if (cid >= 2) {
            const float* cp = (const float*)(p.ws + OFF_RT) + (size_t)(((row0 + ii) & 2047) * 32 + fq * 8) * 2;
            float x1[8], x2[8]; unpack8(__builtin_bit_cast(u32x4, Qf[0]), x1); unpack8(__builtin_bit_cast(u32x4, Qf[1]), x2);
            float y1[8], y2[8];
#pragma unroll
            for (int q4 = 0; q4 < 4; ++q4) { const f32x4 cs = *(const f32x4*)(cp + 4 * q4);
                y1[2 * q4] = x1[2 * q4] * cs[0] - x2[2 * q4] * cs[1]; y2[2 * q4] = x1[2 * q4] * cs[1] + x2[2 * q4] * cs[0];
                y1[2 * q4 + 1] = x1[2 * q4 + 1] * cs[2] - x2[2 * q4 + 1] * cs[3]; y2[2 * q4 + 1] = x1[2 * q4 + 1] * cs[3] + x2[2 * q4 + 1] * cs[2]; }
            Qf[0] = mk_frag(cvt_pk_bf16(y1[0], y1[1]), cvt_pk_bf16(y1[2], y1[3]), cvt_pk_bf16(y1[4], y1[5]), cvt_pk_bf16(y1[6], y1[7]));
            Qf[1] = mk_frag(cvt_pk_bf16(y2[0], y2[1]), cvt_pk_bf16(y2[2], y2[3]), cvt_pk_bf16(y2[4], y2[5]), cvt_pk_bf16(y2[6], y2[7]));
        }
        f32x4 sc[8];
#pragma unroll
        for (int jt = 0; jt < 8; ++jt) { sc[jt] = (f32x4){0.f, 0.f, 0.f, 0.f};
#pragma unroll
            for (int ks = 0; ks < 2; ++ks) { const bf16x8 kf = *(const LAS bf16x8*)(Kl + (jt * 16 + fr) * 144 + ks * 64 + fq * 16); sc[jt] = MFMA16(kf, Qf[ks], sc[jt]); } }
#pragma unroll
        for (int jt = 0; jt < 8; ++jt)
#pragma unroll
            for (int i = 0; i < 4; ++i) { const int d = ii - (jt * 16 + 4 * fq + i); const float f = __builtin_amdgcn_exp2f(d > 0 ? (float)d * lgf : (float)(-d) * lgb); sc[jt][i] *= (d == 0 ? 2.0f : f); }
        f32x4 Y[8];
#pragma unroll
        for (int dt = 0; dt < 8; ++dt) Y[dt] = (f32x4){0.f, 0.f, 0.f, 0.f};
#pragma unroll
        for (int sI = 0; sI < 4; ++sI) {
            const bf16x8 pf = mk_frag(cvt_pk_bf16(sc[2 * sI][0], sc[2 * sI][1]), cvt_pk_bf16(sc[2 * sI][2], sc[2 * sI][3]), cvt_pk_bf16(sc[2 * sI + 1][0], sc[2 * sI + 1][1]), cvt_pk_bf16(sc[2 * sI + 1][2], sc[2 * sI + 1][3]));
#pragma unroll
            for (int dt = 0; dt < 8; ++dt) {
                Y[dt] = MFMA16(tr_frag(Vt, 288, (2 * sI) * 16 + 4 * fq, (2 * sI + 1) * 16 + 4 * fq, dt * 16, fr), pf, Y[dt]); }
        }
        u32x2 gwv[8];
#pragma unroll
        for (int dt = 0; dt < 8; ++dt) gwv[dt] = *(const u32x2*)(Z + (size_t)(row0 + ii) * ZM + C_RG + h * 128 + dt * 16 + 4 * fq);
        const float xf = __builtin_amdgcn_exp2f((float)(ii + 1) * lgf), xb = __builtin_amdgcn_exp2f((float)(128 - ii) * lgb);
#pragma unroll
        for (int ks = 0; ks < 4; ++ks) {
            const u32x4 qw = __builtin_bit_cast(u32x4, Qf[ks & 1]); const float xs = ks < 2 ? xf : xb;
            const bf16x8 qs = mk_frag(cvt_pk_bf16(bflo(qw.x) * xs, bfhi(qw.x) * xs), cvt_pk_bf16(bflo(qw.y) * xs, bfhi(qw.y) * xs), cvt_pk_bf16(bflo(qw.z) * xs, bfhi(qw.z) * xs), cvt_pk_bf16(bflo(qw.w) * xs, bfhi(qw.w) * xs));
#pragma unroll
            for (int dt = 0; dt < 8; ++dt) { const bf16x8 rf = *(const LAS bf16x8*)(Rl + (dt * 16 + fr) * 272 + ks * 64 + fq * 16); Y[dt] = MFMA16(rf, qs, Y[dt]); }
        }
        float ss = 0.f;
#pragma unroll
        for (int dt = 0; dt < 8; ++dt) ss += Y[dt][0] * Y[dt][0] + Y[dt][1] * Y[dt][1] + Y[dt][2] * Y[dt][2] + Y[dt][3] * Y[dt][3];
        ss += __shfl_xor(ss, 16); ss += __shfl_xor(ss, 32);
        const float rstd = rsqrtf(ss * (1.0f / 128.0f) + EPS);
#pragma unroll
        for (int dt = 0; dt < 8; ++dt) {
            const u32x2 gw = gwv[dt];
            const float g0 = bflo(gw.x), g1 = bfhi(gw.x), g2 = bflo(gw.y), g3 = bfhi(gw.y);
            u32x2 w; w.x = cvt_pk_bf16(g0 * sigmoidf_(g0) * Y[dt][0] * rstd, g1 * sigmoidf_(g1) * Y[dt][1] * rstd); w.y = cvt_pk_bf16(g2 * sigmoidf_(g2) * Y[dt][2] * rstd, g3 * sigmoidf_(g3) * Y[dt][3] * rstd);
            *(u32x2*)(YB + (size_t)(row0 + ii) * 1536 + h * 128 + dt * 16 + 4 * fq) = w; }
    }
#undef RO_LOAD
    __syncthreads();
}

#ifndef ATT_MFMA
#define ATT_MFMA 1
#endif
#ifndef RET_MFMA
#define RET_MFMA 1
#endif
constexpr int NPL = 10;
constexpr int NPH = 1 + 2 * NPL;

__global__ void __launch_bounds__(NTHREADS) mega(Params p) {
    extern __shared__ __attribute__((aligned(16))) unsigned char lds_raw[];
    cg::grid_group grid = cg::this_grid();
    const int wv = __builtin_amdgcn_readfirstlane(threadIdx.x >> 6);
    LAS unsigned char* lds = (LAS unsigned char*)lds_raw;
    const int G = gridDim.x, c = blockIdx.x;
    const int lo = p.ph_lo, hi = p.ph_hi;
    if (hi < 0) grid.sync();
    XcdBarrier xb; xb.bar = (unsigned*)(p.ws + OFF_BAR); xb.x = xb_xcc_id(); xb.st = (volatile LAS unsigned*)(lds + LDS_BYTES);
    { const int t0 = opaque_tid(wv); if (t0 == 0) { xb.st[0] = 0u; xb.st[1] = 0u; } __syncthreads(); if (t0 == 0) (void)xb_add(&xb.bar[XB_XCNT(xb.x)], 1u); }
    bf16_t* WB = (bf16_t*)(p.ws + OFF_WB);
    bf16_t* ZG = (bf16_t*)(p.ws + OFF_ZG); bf16_t* YB = (bf16_t*)(p.ws + OFF_YB); bf16_t* UB = (bf16_t*)(p.ws + OFF_UB);
#ifndef DUPMASK
#define DUPMASK 0
#endif
#define PHASE(ph, ...) if ((ph) >= lo && (ph) < hi) { __VA_ARGS__; if ((ph) + 1 < hi) xcd_barrier(xb, wv); }
#define PHASED(flag, ph, ...) if ((ph) >= lo && (ph) < hi) { __VA_ARGS__; if (DUPMASK & (flag)) { xcd_barrier(xb, wv); __VA_ARGS__; } if ((ph) + 1 < hi) xcd_barrier(xb, wv); }
    PHASED(64, 0, ph_setup(wv, p, lds_raw); __syncthreads(); ph_convert(wv, p, 0, lds_raw, 3, 0))
#pragma unroll 1
    for (int l = 0; l < 2; ++l) {
        const int b = 1 + l * NPL;
        const int Mrows = l == 0 ? RT_ : NLAT;
        PHASED(1, b + 0, if (l > 0) ph_convert(wv, p, l, lds_raw, 2, 0); ph_norm(wv, p, l, 0, RT_))
        PHASED(2, b + 1, { pg8::Gemm g{UB, WB + W_IN, 1024, 1024, 1024, 0, 0}; pg8::Order S; if (l == 0) S.init(RT_, ZM, G, c, 1); else { S.init(NLAT, ZM, G, c, 1); S.set_tail(NCTX, 4); }     pg8::EpiBf16<0> E{ZG, ZM, nullptr, nullptr, 0}; pg8::gemm_phase(wv, lds, g, S, E); if (l == 0) ph_convert(wv, p, 0, lds_raw, 4, 48); })
        PHASE(b + 2, ph_prep(wv, p, l, Mrows, lds_raw))
        PHASED(4, b + 3, ph_ret_state(wv, p, l, lds_raw); ph_attn(wv, p, l, lds_raw))
        PHASED(8, b + 4, ph_ret_out(wv, p, l, lds_raw))
        PHASED(2, b + 5, { pg8::Gemm g{UB, WB + W_IN + (size_t)ZM * 1024, 1024, 1024, 1024, 0, 0}; pg8::Order S; S.init(Mrows, ZGW, G, c, 1); pg8::EpiBf16<2> E{ZG, ZGW, nullptr, nullptr, 0}; pg8::gemm_phase(wv, lds, g, S, E); })
        PHASED(32, b + 6, { pg8::Gemm g{YB, WB + W_BR, 1536, 512, 512, 512 * 2, (size_t)1024 * 512 * 2}; pg8::Order S; S.init(Mrows, 1024, G, c, 3); pg8::EpiMerge E{ZG, UB}; pg8::gemm_phase(wv, lds, g, S, E); if (l == 0) ph_shw(wv, p, 0, lds_raw, 64); })
        PHASE(b + 7, { pg8::Gemm g{UB, WB + W_O, 1024, 1024, 1024, 0, 0}; pg8::Order S; S.init(Mrows, 1024, G, c, 1); pg8::EpiRes E{p, l, 2048, 0, 1}; pg8::gemm_phase(wv, lds, g, S, E); })
        PHASED(16, b + 8, { pg8::Gemm g{(const bf16_t*)(p.ws + OFF_U2), WB + W_1, 1024, 1024, 1024, 0, 0}; pg8::Order S; S.init(Mrows, HID, G, c, 1); pg8::EpiBf16<1, true> E{(bf16_t*)(p.ws + OFF_H), HID, (const float*)(p.ws + OFF_SSQ2) + (size_t)l * RT_, (const float*)(p.ws + OFF_SHW2) + (size_t)l * 17 * 4096, 4096}; pg8::gemm_phase(wv, lds, g, S, E); })
        PHASE(b + 9, { pg8::Gemm g{(const bf16_t*)(p.ws + OFF_H), WB + W_2, HID, HID, HID, 0, 0}; pg8::Order S; S.init(Mrows, 1024, G, c, 1); pg8::EpiRes E{p, l, 5120, 1, 0}; pg8::gemm_phase(wv, lds, g, S, E); if (l == 0) { ph_convert(wv, p, 1, lds_raw, 1, 64); ph_shw(wv, p, 1, lds_raw, 64); } })
    }
    if (DUPMASK & 128) { for (int i = 0; i < 20; ++i) xcd_barrier(xb, wv); }
#undef PHASE
#undef PHASED
}

#ifndef MULTI_LAUNCH
#define MULTI_LAUNCH 0
#endif

extern "C" void kernel_launch(void* const* d_in, const int* in_sizes, int n_in, void* d_out, int out_size, void* d_ws, size_t ws_size, hipStream_t stream) {
    static int grid = 0;
    if (grid == 0) {
        if (ws_size < WS_END) { fprintf(stderr, "kernel_launch: workspace too small: %zu < %zu\n", ws_size, (size_t)WS_END); grid = -1; return; }
        int dev = 0, cus = 0, per_cu = 0;
        hipGetDevice(&dev);
        hipDeviceGetAttribute(&cus, hipDeviceAttributeMultiprocessorCount, dev);
        if (hipFuncSetAttribute((const void*)mega, hipFuncAttributeMaxDynamicSharedMemorySize, LDS_TOTAL) != hipSuccess) { fprintf(stderr, "kernel_launch: hipFuncSetAttribute failed\n"); grid = -1; return; }
        if (hipOccupancyMaxActiveBlocksPerMultiprocessor(&per_cu, (const void*)mega, NTHREADS, LDS_TOTAL) != hipSuccess || per_cu < 1) { fprintf(stderr, "kernel_launch: occupancy query gave %d\n", per_cu); per_cu = 1; }
        (void)hipGetLastError();
        grid = cus * per_cu;
        fprintf(stderr, "kernel_launch: grid %d (cus %d x %d)\n", grid, cus, per_cu);
    }
    if (grid < 0) return;
    if (hipMemsetAsync((char*)d_ws + OFF_BAR, 0, BAR_BYTES, stream) != hipSuccess) { fprintf(stderr, "kernel_launch: memset of barrier words failed\n"); return; }
    Params p{};
    for (int i = 0; i < 21; ++i) p.in[i] = (const float*)d_in[i];
    p.out = (float*)d_out; p.ws = (unsigned char*)d_ws;
#if MULTI_LAUNCH
    for (int ph = 0; ph < NPH; ++ph) {
        p.ph_lo = ph; p.ph_hi = ph + 1;
        hipLaunchKernelGGL(mega, dim3(grid), dim3(NTHREADS), LDS_TOTAL, stream, p);
    }
#else
    p.ph_lo = 0; p.ph_hi = NPH;
    void* args[] = {&p};
    hipError_t e = hipLaunchCooperativeKernel((const void*)mega, dim3(grid), dim3(NTHREADS), args, LDS_TOTAL, stream);
    if (e != hipSuccess) fprintf(stderr, "cooperative launch failed: %s (grid %d)\n", hipGetErrorString(e), grid);
#endif
}
```

```cpp
#include <hip/hip_runtime.h>
#include <hip/hip_cooperative_groups.h>
#include <cstdio>
namespace cg = cooperative_groups;

#define DEVI __device__ __forceinline__
#define LAS __attribute__((address_space(3)))
typedef unsigned short bf16_t;
typedef short bf16x8 __attribute__((ext_vector_type(8)));
typedef float f32x4 __attribute__((ext_vector_type(4)));
typedef unsigned u32x4 __attribute__((ext_vector_type(4)));
typedef unsigned u32x2 __attribute__((ext_vector_type(2)));

constexpr int DM = 1024, NB = 16, SEQ = 2048, LCTX = 256, NLAT = NB * SEQ, NCTX = NB * LCTX, RT_ = NLAT + NCTX;
constexpr int ZM = 2816, ZGW = 3072, INC = 5888, HID = 4096;
constexpr int C_RK = 0, C_RV = 256, C_AK = 768, C_AV = 896, C_RQ = 1024, C_RG = 1280, C_AQ = 1792, C_PU = 2304;
constexpr float EPS = 1e-6f;
constexpr int NTHREADS = 512;
constexpr int LDS_BYTES = 131072;
constexpr int LDS_TOTAL = LDS_BYTES + 16;

constexpr size_t OFF_ZG = 0;
constexpr size_t OFF_YB = OFF_ZG + (size_t)RT_ * ZGW * 2;
constexpr size_t OFF_UB = OFF_YB + (size_t)RT_ * 1536 * 2;
constexpr size_t OFF_XC = OFF_UB + (size_t)RT_ * 1024 * 2;
constexpr size_t OFF_WB = OFF_XC + (size_t)NCTX * 1024 * 4;
constexpr size_t W_IN = 0, W_BR = W_IN + (size_t)INC * 1024, W_O = W_BR + 3 * 512 * 1024, W_1 = W_O + 1024 * 1024, W_2 = W_1 + 4096 * 1024, W_END = W_2 + 4096 * 1024;
constexpr size_t OFF_RS = OFF_WB + W_END * 2;
constexpr size_t OFF_MOD = OFF_RS + (size_t)NB * 4 * 2 * 18 * 8192 * 2;
constexpr size_t OFF_RT = OFF_MOD + 2 * 17 * 6144 * 4;
constexpr size_t OFF_AT = OFF_RT + 2048 * 32 * 8;
constexpr size_t OFF_BAR = OFF_AT + 64 * 16 * 8;
constexpr size_t BAR_BYTES = 16384;
constexpr size_t OFF_SSQ2 = OFF_BAR + BAR_BYTES;
constexpr size_t OFF_SHW2 = OFF_SSQ2 + (size_t)2 * RT_ * 4;
constexpr size_t OFF_A2 = OFF_SHW2 + (size_t)2 * 17 * 4096 * 4;
constexpr size_t WS_END = OFF_A2 + (size_t)2 * 17 * 1024 * 4;
constexpr size_t OFF_U2 = OFF_ZG;
constexpr size_t OFF_H = OFF_ZG + (size_t)RT_ * 1024 * 2;
static_assert(OFF_H + (size_t)RT_ * 4096 * 2 <= OFF_XC, "H overlaps the ctx stream");

struct Params { const float* in[21]; float* out; unsigned char* ws; int ph_lo, ph_hi; };

DEVI int opaque_tid(int wv) { int ln; asm volatile("v_mbcnt_lo_u32_b32 %0, -1, 0\n\tv_mbcnt_hi_u32_b32 %0, -1, %0" : "=v"(ln)); return wv * 64 + ln; }
DEVI float bf2f(bf16_t h) { return __uint_as_float(((unsigned)h) << 16); }
DEVI float bflo(unsigned w) { return __uint_as_float(w << 16); }
DEVI float bfhi(unsigned w) { return __uint_as_float(w & 0xffff0000u); }
DEVI unsigned cvt_pk_bf16(float lo, float hi) { unsigned r; asm volatile("v_cvt_pk_bf16_f32 %0, %1, %2" : "=v"(r) : "v"(lo), "v"(hi)); return r; }
DEVI bf16_t f2bf(float f) { return (bf16_t)(cvt_pk_bf16(f, 0.f) & 0xffffu); }
DEVI float wsum(float v) {
#pragma unroll
    for (int o = 32; o > 0; o >>= 1) v += __shfl_xor(v, o);
    return v; }
DEVI float wmax(float v) {
#pragma unroll
    for (int o = 32; o > 0; o >>= 1) v = fmaxf(v, __shfl_xor(v, o));
    return v; }
DEVI float sigmoidf_(float g) { return __builtin_amdgcn_rcpf(1.0f + __expf(-g)); }
DEVI const float* xrow_in(const Params& p, int l, int row) {
    if (l == 0) return row < NLAT ? p.in[0] + (size_t)row * DM : p.in[2] + (size_t)(row - NLAT) * DM;
    return row < NLAT ? p.out + (size_t)row * DM : (const float*)(p.ws + OFF_XC) + (size_t)(row - NLAT) * DM;
}
DEVI float* xrow_out(const Params& p, int row) { return row < NLAT ? p.out + (size_t)row * DM : (float*)(p.ws + OFF_XC) + (size_t)(row - NLAT) * DM; }
DEVI const float* modrow(const Params& p, int l, int row) { const int bi = row < NLAT ? (row >> 11) : 16; return (const float*)(p.ws + OFF_MOD) + (size_t)(l * 17 + bi) * 6144; }

namespace pg8 {
constexpr int BM = 256, BK = 64, HALF = 128, HTB = HALF * BK * 2, NXCD = 8, WGM = 8;
DEVI int lds_byte(int r, int c) { const int st = (r >> 4) * 2 + (c >> 5), rr = r & 15, cc = c & 31, ob = rr * 64 + cc * 2; return st * 1024 + (ob ^ (((ob >> 9) & 1) << 5)); }
DEVI void stage_rc(int b, int& R, int& C) { const int st = b / 1024, sb = b % 1024, swz = sb ^ (((sb >> 9) & 1) << 5); R = (st >> 1) * 16 + swz / 64; C = (st & 1) * 32 + (swz % 64) / 2; }
DEVI int perm32(int rho) { const int n = rho >> 4, i = rho & 15; return 8 * (i >> 2) + 4 * n + (i & 3); }

struct Unit { int pm, pn, pb; };
struct Gemm { const bf16_t* A; const bf16_t* Bt; int lda, ldb, K; size_t a_bs, b_bs; };
struct Order {
    int nM, nN, nwg, G, c, nb, tail_units, tail_nN;
    DEVI void init(int M, int N, int G_, int c_, int nb_) { nM = M / BM; nN = N / BM; nwg = nM * nN; G = G_; c = c_; nb = nb_; tail_units = 0; tail_nN = 1; }
    DEVI void set_tail(int tail_rows, int tail_nN_) { tail_nN = tail_nN_; tail_units = (tail_rows / BM) * tail_nN_; }
    DEVI bool next(int i, Unit& u) const {
        const int ti = i / nb; u.pb = i - ti * nb;
        const long L = (long)ti * G + c;
        if (L >= nwg) { const int t = (int)(L - nwg); if (t >= tail_units) return false; u.pm = nM + t / tail_nN; u.pn = t % tail_nN; return true; }
        int wgid = (int)L; { const int q = nwg / NXCD, r = nwg % NXCD, xcd = wgid % NXCD, off = wgid / NXCD; wgid = (xcd < r ? xcd * (q + 1) : r * (q + 1) + (xcd - r) * q) + off; }
        const int nig = WGM * nN, gid = wgid / nig, fm = gid * WGM, gsz = (nM - fm) < WGM ? (nM - fm) : WGM;
        u.pm = fm + ((wgid % nig) % gsz); u.pn = (wgid % nig) / gsz; return true;
    }
};

template <int ACT  , bool RS = false  > struct EpiBf16 {
    static constexpr bool PERM = true;
    bf16_t* O; int ldc; const float* ssq; const float* shw; int ldshw;
    DEVI bool keep(const Unit&) const { return false; }
    DEVI void operator()(f32x4 (&acc)[2][2][4][2], const Unit& u, int wr, int wc, int fr, int fq) const {
        const int row0 = u.pm * BM + wr * 64 + fr, col0 = u.pn * BM + wc * 32 + 8 * fq;
        f32x4 sh[2][2];
        if (RS) { const int bi = u.pm * BM < NLAT ? (u.pm * BM) >> 11 : 16;
#pragma unroll
            for (int bj = 0; bj < 2; ++bj) { sh[bj][0] = *(const f32x4*)(shw + (size_t)bi * ldshw + col0 + bj * HALF); sh[bj][1] = *(const f32x4*)(shw + (size_t)bi * ldshw + col0 + bj * HALF + 4); } }
#pragma unroll
        for (int ai = 0; ai < 2; ++ai)
#pragma unroll
            for (int m = 0; m < 4; ++m) { bf16_t* rowp = O + (size_t)(row0 + ai * HALF + m * 16) * ldc + col0;
                float rstd = 1.0f; if (RS) rstd = rsqrtf(ssq[row0 + ai * HALF + m * 16] * (1.0f / 1024.0f) + EPS);
#pragma unroll
                for (int bj = 0; bj < 2; ++bj) { f32x4 v0 = acc[ai][bj][m][0], v1 = acc[ai][bj][m][1];
                    if (RS) { v0 = v0 * rstd + sh[bj][0]; v1 = v1 * rstd + sh[bj][1]; }
                    if (ACT == 1) {
#pragma unroll
                        for (int j = 0; j < 4; ++j) { const float a = fmaxf(v0[j], 0.f), b = fmaxf(v1[j], 0.f); v0[j] = a * a; v1[j] = b * b; } }
                    if (ACT == 2) {
#pragma unroll
                        for (int j = 0; j < 4; ++j) { v0[j] = 1.0f + __expf(-fminf(fmaxf(v0[j], -30.f), 30.f)); v1[j] = 1.0f + __expf(-fminf(fmaxf(v1[j], -30.f), 30.f)); } }
                    u32x4 w; w.x = cvt_pk_bf16(v0[0], v0[1]); w.y = cvt_pk_bf16(v0[2], v0[3]); w.z = cvt_pk_bf16(v1[0], v1[1]); w.w = cvt_pk_bf16(v1[2], v1[3]);
                    *(u32x4*)(rowp + bj * HALF) = w; } }
    }
};
struct EpiMerge {
    static constexpr bool PERM = true;
    const bf16_t* Gt; bf16_t* O;
    DEVI bool keep(const Unit& u) const { return u.pb < 2; }
    DEVI void operator()(f32x4 (&acc)[2][2][4][2], const Unit& u, int wr, int wc, int fr, int fq) const {
        const int row0 = u.pm * BM + wr * 64 + fr, col0 = u.pn * BM + wc * 32 + 8 * fq;
        const bool mid = u.pb < 2;
#pragma unroll
        for (int ai = 0; ai < 2; ++ai) {
            u32x4 ga[4][2], gb[4][2];
#pragma unroll
            for (int m = 0; m < 4; ++m)
#pragma unroll
                for (int bj = 0; bj < 2; ++bj) { const bf16_t* gp = Gt + (size_t)(row0 + ai * HALF + m * 16) * ZGW + u.pb * 1024 + col0 + bj * HALF;
                    ga[m][bj] = *(const u32x4*)gp; gb[m][bj] = mid ? *(const u32x4*)(gp + 1024) : (u32x4){0x3f803f80u, 0x3f803f80u, 0x3f803f80u, 0x3f803f80u}; }
#pragma unroll
            for (int m = 0; m < 4; ++m)
#pragma unroll
                for (int bj = 0; bj < 2; ++bj) {
                    const u32x4 a = ga[m][bj], b = gb[m][bj];
                    float sc[8];
                    sc[0] = bflo(b.x) * __builtin_amdgcn_rcpf(bflo(a.x)); sc[1] = bfhi(b.x) * __builtin_amdgcn_rcpf(bfhi(a.x)); sc[2] = bflo(b.y) * __builtin_amdgcn_rcpf(bflo(a.y)); sc[3] = bfhi(b.y) * __builtin_amdgcn_rcpf(bfhi(a.y));
                    sc[4] = bflo(b.z) * __builtin_amdgcn_rcpf(bflo(a.z)); sc[5] = bfhi(b.z) * __builtin_amdgcn_rcpf(bfhi(a.z)); sc[6] = bflo(b.w) * __builtin_amdgcn_rcpf(bflo(a.w)); sc[7] = bfhi(b.w) * __builtin_amdgcn_rcpf(bfhi(a.w));
                    f32x4 v0 = acc[ai][bj][m][0], v1 = acc[ai][bj][m][1];
#pragma unroll
                    for (int j = 0; j < 4; ++j) { v0[j] *= sc[j]; v1[j] *= sc[4 + j]; }
                    if (mid) { acc[ai][bj][m][0] = v0; acc[ai][bj][m][1] = v1; }
                    else { u32x4 w; w.x = cvt_pk_bf16(v0[0], v0[1]); w.y = cvt_pk_bf16(v0[2], v0[3]); w.z = cvt_pk_bf16(v1[0], v1[1]); w.w = cvt_pk_bf16(v1[2], v1[3]);
                        *(u32x4*)(O + (size_t)(row0 + ai * HALF + m * 16) * DM + col0 + bj * HALF) = w; }
                }
        }
    }
};
struct EpiRes {
    static constexpr bool PERM = false;
    Params p; int l, goff;
    int in_is_stream;
    int emit;
    DEVI bool keep(const Unit&) const { return false; }
    DEVI void operator()(f32x4 (&acc)[2][2][4][2], const Unit& u, int wr, int wc, int fr, int fq) const {
        const int row0 = u.pm * BM + wr * 64 + fr, col0 = u.pn * BM + wc * 32 + 4 * fq;
        const float* gr = modrow(p, l, u.pm * BM) + goff + col0;
        f32x4 gv[2][2];
#pragma unroll
        for (int bj = 0; bj < 2; ++bj)
#pragma unroll
            for (int n = 0; n < 2; ++n) gv[bj][n] = *(const f32x4*)(gr + bj * HALF + n * 16);
        f32x4 av[2][2];
        if (emit) { const int bi = u.pm * BM < NLAT ? (u.pm * BM) >> 11 : 16; const float* ar = (const float*)(p.ws + OFF_A2) + (size_t)(l * 17 + bi) * 1024 + col0;
#pragma unroll
            for (int bj = 0; bj < 2; ++bj)
#pragma unroll
                for (int n = 0; n < 2; ++n) av[bj][n] = *(const f32x4*)(ar + bj * HALF + n * 16); }
#pragma unroll
        for (int am = 0; am < 4; ++am) {
            const int ai = am >> 1, mb = (am & 1) * 2;
            f32x4 xv[2][2][2];
#pragma unroll
            for (int mm = 0; mm < 2; ++mm) { const int r = row0 + ai * HALF + (mb + mm) * 16;
                const float* xi = (in_is_stream ? (const float*)xrow_out(p, r) : xrow_in(p, l, r)) + col0;
#pragma unroll
                for (int bj = 0; bj < 2; ++bj)
#pragma unroll
                    for (int n = 0; n < 2; ++n) xv[mm][bj][n] = *(const f32x4*)(xi + bj * HALF + n * 16); }
#pragma unroll
            for (int mm = 0; mm < 2; ++mm) { const int m = mb + mm; const int r = row0 + ai * HALF + m * 16; float* xo = xrow_out(p, r) + col0;
                float ssp = 0.f;
#pragma unroll
                for (int bj = 0; bj < 2; ++bj)
#pragma unroll
                    for (int n = 0; n < 2; ++n) { const f32x4 xn = xv[mm][bj][n] + gv[bj][n] * acc[ai][bj][m][n]; *(f32x4*)(xo + bj * HALF + n * 16) = xn;
                        if (emit) { ssp += xn[0] * xn[0] + xn[1] * xn[1] + xn[2] * xn[2] + xn[3] * xn[3];
                            const f32x4 ua = xn * av[bj][n]; u32x2 w; w.x = cvt_pk_bf16(ua[0], ua[1]); w.y = cvt_pk_bf16(ua[2], ua[3]);
                            *(u32x2*)((bf16_t*)(p.ws + OFF_U2) + (size_t)r * DM + col0 + bj * HALF + n * 16) = w; } }
                if (emit) { ssp += __shfl_xor(ssp, 16); ssp += __shfl_xor(ssp, 32); if (fq == 0) atomicAdd((float*)(p.ws + OFF_SSQ2) + (size_t)l * RT_ + r, ssp); } }
        }
    }
};

template <class Epi>
DEVI void gemm_phase(const int wv, LAS unsigned char* lds, const Gemm g, const Order& S, const Epi& E) {
    const int tid = opaque_tid(wv), wid = wv, lane = tid & 63, wr = wid >> 2, wc = wid & 3, fr = lane & 15, fq = lane >> 4;
    const int K = g.K, nt = K / BK;
    unsigned voffA[2], voffB[2];
#pragma unroll
    for (int i = 0; i < 2; ++i) { int R, C; stage_rc(tid * 16 + i * 8192, R, C); const int Rb = Epi::PERM ? ((R & ~31) + perm32(R & 31)) : R;
        voffA[i] = (unsigned)(R * g.lda + C) * 2u; voffB[i] = (unsigned)(Rb * g.ldb + C) * 2u; }
    const size_t kstep = (size_t)(BK * 2);
    const size_t hstepA = (size_t)HALF * g.lda * 2, hstepB = (size_t)HALF * g.ldb * 2;
    const size_t tstepA = 2 * hstepA, tstepB = 2 * hstepB;
    const unsigned ldsw = (unsigned)wid * 1024u;
    const int aoff = lds_byte(wr * 64 + fr, fq * 8), boff = lds_byte(wc * 32 + fr, fq * 8);
#define PG8_SA(b, h) (((b) * 2 + (h)) * HTB)
#define PG8_SB(b, h) ((4 + (b) * 2 + (h)) * HTB)
#define PG8_STAGE(bufoff, gbase, voff) do { _Pragma("unroll") for (int _i = 0; _i < 2; ++_i) \
        __builtin_amdgcn_global_load_lds((const unsigned*)((const char*)(gbase) + (voff)[_i]), (LAS unsigned*)(lds + (bufoff) + ldsw + _i * 8192), 16, 0, 0); } while (0)
#define PG8_LDA(dst, b, h) do { _Pragma("unroll") for (int m = 0; m < 4; ++m) _Pragma("unroll") for (int k = 0; k < 2; ++k) dst[m][k] = *(const LAS bf16x8*)(lds + PG8_SA(b, h) + aoff + m * 2048 + k * 1024); } while (0)
#define PG8_LDB(dst, b, h) do { _Pragma("unroll") for (int n = 0; n < 2; ++n) _Pragma("unroll") for (int k = 0; k < 2; ++k) dst[n][k] = *(const LAS bf16x8*)(lds + PG8_SB(b, h) + boff + n * 2048 + k * 1024); } while (0)
#define PG8_MMA(ai, bj, At, Bt) do { __builtin_amdgcn_s_setprio(1); _Pragma("unroll") for (int m = 0; m < 4; ++m) _Pragma("unroll") for (int n = 0; n < 2; ++n) _Pragma("unroll") for (int k = 0; k < 2; ++k) \
        acc[ai][bj][m][n] = __builtin_amdgcn_mfma_f32_16x16x32_bf16(Bt[n][k], At[m][k], acc[ai][bj][m][n], 0, 0, 0); __builtin_amdgcn_s_setprio(0); } while (0)
#define PG8_WAIT_V(n) asm volatile("s_waitcnt vmcnt(" #n ")" ::: "memory")
#define PG8_WAIT_L(n) asm volatile("s_waitcnt lgkmcnt(" #n ")" ::: "memory")
#define PG8_BAR __builtin_amdgcn_s_barrier()
#define PG8_SCHED __builtin_amdgcn_sched_barrier(0)
    Unit cur, nxt; int ui = 0;
    if (!S.next(0, cur)) return;
    f32x4 acc[2][2][4][2];
#pragma unroll
    for (int a = 0; a < 2; ++a)
#pragma unroll
        for (int b = 0; b < 2; ++b)
#pragma unroll
            for (int m = 0; m < 4; ++m)
#pragma unroll
                for (int n = 0; n < 2; ++n) acc[a][b][m][n] = (f32x4){0.f, 0.f, 0.f, 0.f};
    bf16x8 At[4][2], B0[2][2], B1[2][2];
    const char* cA = (const char*)g.A + (size_t)cur.pb * g.a_bs + (size_t)cur.pm * tstepA; const char* cB = (const char*)g.Bt + (size_t)cur.pb * g.b_bs + (size_t)cur.pn * tstepB;
    PG8_STAGE(PG8_SB(0, 0), cB, voffB); PG8_STAGE(PG8_SA(0, 0), cA, voffA); PG8_STAGE(PG8_SB(0, 1), cB + hstepB, voffB); PG8_STAGE(PG8_SA(0, 1), cA + hstepA, voffA);
    if (wr == 1) PG8_BAR;
    PG8_WAIT_V(4); PG8_BAR;
    PG8_STAGE(PG8_SB(1, 0), cB + kstep, voffB); PG8_STAGE(PG8_SA(1, 0), cA + kstep, voffA); PG8_STAGE(PG8_SB(1, 1), cB + hstepB + kstep, voffB);
    PG8_WAIT_V(6); PG8_BAR;
    for (;;) {
        const bool has_next = S.next(ui + 1, nxt);
        const char* nA = has_next ? (const char*)g.A + (size_t)nxt.pb * g.a_bs + (size_t)nxt.pm * tstepA : cA;
        const char* nB = has_next ? (const char*)g.Bt + (size_t)nxt.pb * g.b_bs + (size_t)nxt.pn * tstepB : cB;
        for (int t = 0; t < nt; t += 2) {
            const bool last = (t == nt - 2);
            const char* a1 = cA + (size_t)(t + 1) * kstep;
            const char* a2 = last ? nA : cA + (size_t)(t + 2) * kstep; const char* b2 = last ? nB : cB + (size_t)(t + 2) * kstep;
            const char* a3 = a2 + kstep; const char* b3 = b2 + kstep;
            PG8_LDB(B0, 0, 0); PG8_SCHED; PG8_LDA(At, 0, 0); PG8_STAGE(PG8_SA(1, 1), a1 + hstepA, voffA);
            PG8_WAIT_L(8); PG8_BAR; PG8_WAIT_L(0); PG8_MMA(0, 0, At, B0); PG8_BAR; PG8_SCHED;
            PG8_LDB(B1, 0, 1); PG8_STAGE(PG8_SB(0, 0), b2, voffB);
            PG8_BAR; PG8_WAIT_L(0); PG8_MMA(0, 1, At, B1); PG8_BAR;
            PG8_LDA(At, 0, 1); PG8_STAGE(PG8_SA(0, 0), a2, voffA);
            PG8_BAR; PG8_WAIT_L(0); PG8_MMA(1, 0, At, B0); PG8_BAR; PG8_SCHED;
            PG8_STAGE(PG8_SB(0, 1), b2 + hstepB, voffB);
            PG8_WAIT_V(6); PG8_BAR; PG8_MMA(1, 1, At, B1); PG8_BAR;
            PG8_LDB(B0, 1, 0); PG8_SCHED; PG8_LDA(At, 1, 0); PG8_STAGE(PG8_SA(0, 1), a2 + hstepA, voffA);
            PG8_WAIT_L(8); PG8_BAR; PG8_WAIT_L(0); PG8_MMA(0, 0, At, B0); PG8_BAR; PG8_SCHED;
            PG8_LDB(B1, 1, 1); PG8_STAGE(PG8_SB(1, 0), b3, voffB);
            PG8_BAR; PG8_WAIT_L(0); PG8_MMA(0, 1, At, B1); PG8_BAR;
            PG8_LDA(At, 1, 1); PG8_STAGE(PG8_SA(1, 0), a3, voffA);
            PG8_BAR; PG8_WAIT_L(0); PG8_MMA(1, 0, At, B0); PG8_BAR; PG8_SCHED;
            PG8_STAGE(PG8_SB(1, 1), b3 + hstepB, voffB);
            PG8_WAIT_V(6); PG8_BAR; PG8_MMA(1, 1, At, B1); PG8_BAR;
        }
        E(acc, cur, wr, wc, fr, fq);
        if (!E.keep(cur)) {
#pragma unroll
            for (int a = 0; a < 2; ++a)
#pragma unroll
                for (int b = 0; b < 2; ++b)
#pragma unroll
                    for (int m = 0; m < 4; ++m)
#pragma unroll
                        for (int n = 0; n < 2; ++n) acc[a][b][m][n] = (f32x4){0.f, 0.f, 0.f, 0.f};
        }
        if (!has_next) break;
        cur = nxt; cA = nA; cB = nB; ++ui;
    }
    PG8_WAIT_V(0);
    if (wr == 0) PG8_BAR;
    PG8_BAR;
#undef PG8_SA
#undef PG8_SB
#undef PG8_STAGE
#undef PG8_LDA
#undef PG8_LDB
#undef PG8_MMA
#undef PG8_WAIT_V
#undef PG8_WAIT_L
#undef PG8_BAR
#undef PG8_SCHED
}
}

#define XB_TMO      128
#define XB_XCNT(j)  (256  + 64 * (j))
#define XB_XSUB(j)  (1280 + 64 * (j))
#define XB_XGEN(j)  (2304 + 64 * (j))
#define XB_TOP      3328
#define XB_TOPGEN   3392
#define XCD_BAR_WORDS 3456
#define XB_SPIN_CAP (1u << 22)
DEVI unsigned xb_ld(unsigned* p)              { return __hip_atomic_load(p, __ATOMIC_RELAXED, __HIP_MEMORY_SCOPE_AGENT); }
DEVI unsigned xb_add(unsigned* p, unsigned v) { return __hip_atomic_fetch_add(p, v, __ATOMIC_RELAXED, __HIP_MEMORY_SCOPE_AGENT); }
DEVI unsigned xb_xcc_id() { return (unsigned)__builtin_amdgcn_s_getreg((3 << 11) | 20) & 0xFu; }
#define XB_SPIN(cond, bar) do { unsigned _sp = 0; while (cond) { __builtin_amdgcn_s_sleep(1); \
    if ((++_sp & 255u) == 0u) { if (xb_ld(&(bar)[XB_TMO])) break; if (_sp > XB_SPIN_CAP) { atomicAdd(&(bar)[XB_TMO], 1u); break; } } } } while (0)
struct XcdBarrier { unsigned* bar; unsigned x; volatile LAS unsigned* st; };
DEVI void xcd_barrier_complete(unsigned* bar, unsigned x, unsigned& nloc, unsigned& nx) {
    const unsigned G = gridDim.x;
    unsigned sum, cnt, mine, sp = 0u;
    for (;;) {
        sum = 0u; cnt = 0u; mine = 0u;
#pragma unroll
        for (unsigned j = 0; j < 16; ++j) { const unsigned c = xb_ld(&bar[XB_XCNT(j)]); sum += c; cnt += (c > 0u) ? 1u : 0u; mine = (j == x) ? c : mine; }
        if (sum == G) break;
        __builtin_amdgcn_s_sleep(1);
        if ((++sp & 255u) == 0u) { if (xb_ld(&bar[XB_TMO])) break; if (sp > XB_SPIN_CAP) { atomicAdd(&bar[XB_TMO], 1u); break; } }
    }
    nloc = mine > 0u ? mine : 1u; nx = cnt > 0u ? cnt : 1u;
}
DEVI void xcd_barrier(const XcdBarrier& b, const int wv) {
    asm volatile("s_waitcnt vmcnt(0)" ::: "memory");
    __syncthreads();
    if (opaque_tid(wv) == 0) {
        unsigned* bar = b.bar;
        __builtin_amdgcn_s_waitcnt(0);
        unsigned nloc = b.st[0], nx = b.st[1];
        if (nloc == 0u) { xcd_barrier_complete(bar, b.x, nloc, nx); b.st[0] = nloc; b.st[1] = nx; }
        const unsigned old = xb_add(&bar[XB_XSUB(b.x)], 1u);
        const unsigned gen = old / nloc;
        if (old + 1u == (gen + 1u) * nloc) {
            __builtin_amdgcn_fence(__ATOMIC_RELEASE, "agent");
            asm volatile("s_waitcnt vmcnt(0)" ::: "memory");
            const unsigned og = xb_add(&bar[XB_TOP], 1u);
            const unsigned tg = og / nx;
            if (og + 1u == (tg + 1u) * nx) xb_add(&bar[XB_TOPGEN], 1u);
            else XB_SPIN(xb_ld(&bar[XB_TOPGEN]) == tg, bar);
            __builtin_amdgcn_fence(__ATOMIC_ACQUIRE, "agent");
            xb_add(&bar[XB_XGEN(b.x)], 1u);
            asm volatile("s_waitcnt vmcnt(0)" ::: "memory");
        } else {
            XB_SPIN(xb_ld(&bar[XB_XGEN(b.x)]) == gen, bar);
            __builtin_amdgcn_fence(__ATOMIC_ACQUIRE, "agent");
            asm volatile("s_waitcnt vmcnt(0)" ::: "memory");
        }
    }
    __syncthreads();
}

DEVI void ph_setup(const int wv, const Params& p, unsigned char* lds) {
    const int tid = opaque_tid(wv);
    for (int e = blockIdx.x * NTHREADS + tid; e < 2 * RT_; e += gridDim.x * NTHREADS) ((float*)(p.ws + OFF_SSQ2))[e] = 0.f;
    float* scv = (float*)lds;
    float* red = scv + 17 * 1024;
    for (int it = blockIdx.x; it < 192 + 130; it += gridDim.x) {
        if (it < 192) {
            const int l = it / 96, n0 = (it % 96) * 64;
            for (int e = tid; e < 17 * 1024; e += NTHREADS) { const int r = e >> 10, k = e & 1023; const float v = r < 16 ? p.in[1][r * 1024 + k] : p.in[3][k]; scv[e] = v / (1.0f + expf(-v)); }
            __syncthreads();
            const int n = tid & 63, kg = tid >> 6;
            float acc[17];
#pragma unroll
            for (int r = 0; r < 17; ++r) acc[r] = 0.f;
            const float* w = p.in[6] + (size_t)l * 1024 * 6144 + n0 + n;
            for (int k = kg * 128; k < kg * 128 + 128; ++k) { const float wv = w[(size_t)k * 6144];
#pragma unroll
                for (int r = 0; r < 17; ++r) acc[r] += scv[r * 1024 + k] * wv; }
#pragma unroll
            for (int r = 0; r < 17; ++r) red[(kg * 17 + r) * 64 + n] = acc[r];
            __syncthreads();
            float* mod = (float*)(p.ws + OFF_MOD);
            for (int e = tid; e < 17 * 64; e += NTHREADS) { const int r = e >> 6, nn = e & 63; float s = 0.f;
#pragma unroll
                for (int q = 0; q < 8; ++q) s += red[(q * 17 + r) * 64 + nn];
                mod[(size_t)(l * 17 + r) * 6144 + n0 + nn] = s + p.in[7][l * 6144 + n0 + nn]; }
            __syncthreads();
        } else {
            const int e = (it - 192) * NTHREADS + tid;
            if (e < 65536) { const int pos = e >> 5, i = e & 31; const float fr = powf(10000.0f, -(float)i / 32.0f); const float ang = (float)pos * fr;
                const double tr = (double)ang * 0.15915494309189535; const float tf = (float)(tr - floor(tr));
                ((float2*)(p.ws + OFF_RT))[e] = make_float2(__builtin_amdgcn_cosf(tf), __builtin_amdgcn_sinf(tf)); }
            else { const int e2 = e - 65536; const int pos = e2 >> 4, i = e2 & 15; const float fr = powf(10000.0f, -(float)i / 16.0f); const float ang = (float)pos * fr;
                const double tr = (double)ang * 0.15915494309189535; const float tf = (float)(tr - floor(tr));
                ((float2*)(p.ws + OFF_AT))[e2] = make_float2(__builtin_amdgcn_cosf(tf), __builtin_amdgcn_sinf(tf)); }
        }
    }
}

DEVI void ph_shw(const int wv, const Params& p, int l, unsigned char* lds, int blk_lo) {
    const int tid = opaque_tid(wv);
    if ((int)blockIdx.x < blk_lo) return;
    const int bx = blockIdx.x - blk_lo, nbx = gridDim.x - blk_lo;
    float* shv = (float*)lds;
    float* red = shv + 17 * 1024;
    const float* mod = (const float*)(p.ws + OFF_MOD) + (size_t)l * 17 * 6144;
    for (int e = bx * NTHREADS + tid; e < 17 * 1024; e += nbx * NTHREADS) { const int r = e >> 10, k = e & 1023;
        ((float*)(p.ws + OFF_A2))[(size_t)l * 17 * 1024 + e] = p.in[5][l * 1024 + k] * (1.0f + mod[(size_t)r * 6144 + 4096 + k]); }
    for (int it = bx; it < 256; it += nbx) {
        const int n0 = it * 16;
        __syncthreads();
        for (int e = tid; e < 17 * 1024; e += NTHREADS) { const int r = e >> 10, k = e & 1023; shv[e] = mod[(size_t)r * 6144 + 3072 + k]; }
        __syncthreads();
        const int n = tid & 15, kg = tid >> 4;
        float acc[17];
#pragma unroll
        for (int r = 0; r < 17; ++r) acc[r] = 0.f;
        const float* w = p.in[19] + (size_t)l * 1024 * 4096 + n0 + n;
#pragma unroll 8
        for (int k = kg * 32; k < kg * 32 + 32; ++k) { const float wvv = w[(size_t)k * 4096];
#pragma unroll
            for (int r = 0; r < 17; ++r) acc[r] += shv[r * 1024 + k] * wvv; }
#pragma unroll
        for (int r = 0; r < 17; ++r) red[(kg * 17 + r) * 16 + n] = acc[r];
        __syncthreads();
        for (int e = tid; e < 17 * 16; e += NTHREADS) { const int r = e >> 4, nn = e & 15; float sacc = 0.f;
#pragma unroll
            for (int q = 0; q < 32; ++q) sacc += red[(q * 17 + r) * 16 + nn];
            ((float*)(p.ws + OFF_SHW2))[(size_t)(l * 17 + r) * 4096 + n0 + nn] = sacc; }
    }
    __syncthreads();
}

DEVI void ph_convert(const int wv, const Params& p, int l, unsigned char* lds, int mode  , int blk_lo) {
    const int tid = opaque_tid(wv);
    float* tile = (float*)lds;
    bf16_t* WB = (bf16_t*)(p.ws + OFF_WB);
    if ((int)blockIdx.x < blk_lo) return;
    const int nitems = mode == 0 ? 4032 + 64 : (mode == 1 ? 3008 + 64 : (mode == 2 ? 1024 : (mode == 3 ? 1984 + 64 : 2048)));
    for (int j = blockIdx.x - blk_lo; j < nitems; j += gridDim.x - blk_lo) {
        const int it = mode == 0 ? j : (mode == 1 ? (j < 3008 ? j : j + 1024) : (mode == 2 ? j + 3008 : (mode == 3 ? (j < 1984 ? j : j + 2048) : j + 1984)));
        if (it < 4032) {
            const float* src; bf16_t* dst; int K, N, t;
            if (it < 1472) { t = it; src = p.in[8] + (size_t)l * 1024 * INC; dst = WB + W_IN; K = 1024; N = INC; }
            else if (it < 1600) { t = it - 1472; src = p.in[15] + (size_t)l * 512 * 1024; dst = WB + W_BR; K = 512; N = 1024; }
            else if (it < 1728) { t = it - 1600; src = p.in[17] + (size_t)l * 512 * 1024; dst = WB + W_BR + 2 * 512 * 1024; K = 512; N = 1024; }
            else if (it < 1984) { t = it - 1728; src = p.in[18] + (size_t)l * 1024 * 1024; dst = WB + W_O; K = 1024; N = 1024; }
            else if (it < 3008) { t = it - 1984; src = p.in[19] + (size_t)l * 1024 * 4096; dst = WB + W_1; K = 1024; N = 4096; }
            else { t = it - 3008; src = p.in[20] + (size_t)l * 4096 * 1024; dst = WB + W_2; K = 4096; N = 1024; }
            const int nkt = K / 64, k0 = (t % nkt) * 64, n0 = (t / nkt) * 64;
            for (int e = tid; e < 4096; e += NTHREADS) { const int kk = e >> 6, nn = e & 63; tile[kk * 65 + nn] = src[(size_t)(k0 + kk) * N + n0 + nn]; }
            __syncthreads();
            for (int e = tid; e < 4096; e += NTHREADS) { const int nn = e >> 6, kk = e & 63; dst[(size_t)(n0 + nn) * K + k0 + kk] = f2bf(tile[kk * 65 + nn]); }
            __syncthreads();
        } else {
            const int pi = it - 4032, g = pi >> 4, n0 = (pi & 15) * 64;
            const int n = tid & 63, ig = tid >> 6;
            const float* pw = p.in[10] + (size_t)l * 4 * 128 * 128 + (size_t)g * 128 * 128 + (size_t)(ig * 16) * 128;
            const float* ps = p.in[11] + l * 512 + g * 128;
            const float* wpo = p.in[16] + (size_t)l * 512 * 1024 + (size_t)(g * 128) * 1024 + n0 + n;
            float acc[16];
#pragma unroll
            for (int ii = 0; ii < 16; ++ii) acc[ii] = 0.f;
            for (int j = 0; j < 128; ++j) { const float wv = ps[j] * wpo[(size_t)j * 1024];
#pragma unroll
                for (int ii = 0; ii < 16; ++ii) acc[ii] += pw[ii * 128 + j] * wv; }
            bf16_t* dst = WB + W_BR + 512 * 1024 + (size_t)(n0 + n) * 512 + g * 128 + ig * 16;
            u32x4 w0, w1;
            w0.x = cvt_pk_bf16(acc[0], acc[1]); w0.y = cvt_pk_bf16(acc[2], acc[3]); w0.z = cvt_pk_bf16(acc[4], acc[5]); w0.w = cvt_pk_bf16(acc[6], acc[7]);
            w1.x = cvt_pk_bf16(acc[8], acc[9]); w1.y = cvt_pk_bf16(acc[10], acc[11]); w1.z = cvt_pk_bf16(acc[12], acc[13]); w1.w = cvt_pk_bf16(acc[14], acc[15]);
            *(u32x4*)dst = w0; *(u32x4*)(dst + 8) = w1;
        }
    }
}

DEVI void ph_norm(const int wv, const Params& p, int l, int which  , int nrows) {
    const int tid = opaque_tid(wv); const int lane = tid & 63, wave = wv;
    const float* nw = p.in[which ? 5 : 4] + l * 1024;
    const int shoff = which ? 3072 : 0, scoff = which ? 4096 : 1024;
    bf16_t* U = (bf16_t*)(p.ws + OFF_UB);
    const int stride = gridDim.x * 8;
    for (int row0 = blockIdx.x * 8 + wave; row0 < nrows; row0 += 2 * stride) {
        f32x4 v[2][4]; float ss[2];
#pragma unroll
        for (int q = 0; q < 2; ++q) { const int row = row0 + q * stride; ss[q] = 0.f;
            if (row < nrows) { const float* x = which ? (const float*)xrow_out(p, row) : xrow_in(p, l, row);
#pragma unroll
                for (int i = 0; i < 4; ++i) v[q][i] = *(const f32x4*)(x + i * 256 + lane * 4); }
            else {
#pragma unroll
                for (int i = 0; i < 4; ++i) v[q][i] = (f32x4){0.f, 0.f, 0.f, 0.f}; } }
#pragma unroll
        for (int q = 0; q < 2; ++q) {
#pragma unroll
            for (int i = 0; i < 4; ++i) ss[q] += v[q][i][0] * v[q][i][0] + v[q][i][1] * v[q][i][1] + v[q][i][2] * v[q][i][2] + v[q][i][3] * v[q][i][3];
            ss[q] = wsum(ss[q]); }
#pragma unroll
        for (int q = 0; q < 2; ++q) { const int row = row0 + q * stride;
            if (row < nrows) { const float* md = modrow(p, l, row); const float rstd = rsqrtf(ss[q] * (1.0f / 1024.0f) + EPS);
#pragma unroll
                for (int i = 0; i < 4; ++i) { const int c = i * 256 + lane * 4;
                    const f32x4 w = *(const f32x4*)(nw + c), sc = *(const f32x4*)(md + scoff + c), sh = *(const f32x4*)(md + shoff + c);
                    const f32x4 o = v[q][i] * rstd * w * (1.0f + sc) + sh;
                    u32x2 pk; pk.x = cvt_pk_bf16(o[0], o[1]); pk.y = cvt_pk_bf16(o[2], o[3]);
                    *(u32x2*)(U + (size_t)row * 1024 + c) = pk; } } }
    }
}

DEVI void unpack8(const u32x4 w, float (&v)[8]) { v[0] = bflo(w.x); v[1] = bfhi(w.x); v[2] = bflo(w.y); v[3] = bfhi(w.y); v[4] = bflo(w.z); v[5] = bfhi(w.z); v[6] = bflo(w.w); v[7] = bfhi(w.w); }
DEVI void ph_prep(const int wv, const Params& p, int l, int nrows_pool, unsigned char* lds_raw) {
    const int tid = opaque_tid(wv); const int lane = tid & 63;
    bf16_t* Z = (bf16_t*)(p.ws + OFF_ZG); bf16_t* YB = (bf16_t*)(p.ws + OFF_YB);
    const float* RTf = (const float*)(p.ws + OFF_RT); const float* ATf = (const float*)(p.ws + OFF_AT);
    const int sub = lane & 7, hslot = lane >> 3, d0 = sub * 8;
    constexpr int NINST = RT_ * 6;
    for (int base = (blockIdx.x * 8 + wv) * 32; base < NINST; base += gridDim.x * 8 * 32) {
        u32x4 w[4]; int rowv[4], hhv[4], colv[4];
#pragma unroll
        for (int u = 0; u < 4; ++u) { const int hi = base + u * 8 + hslot; const int row = hi / 6, h6 = hi - row * 6, hh = h6 < 4 ? h6 : h6 + 4; rowv[u] = row; hhv[u] = hh;
            colv[u] = (hh < 4 ? C_RK + hh * 64 : hh < 8 ? C_RQ + (hh - 4) * 64 : hh < 10 ? C_AK + (hh - 8) * 64 : C_AQ + (hh - 10) * 64) + d0;
            w[u] = *(const u32x4*)(Z + (size_t)row * ZM + colv[u]); }
#pragma unroll
        for (int u = 0; u < 4; ++u) {
            const int row = rowv[u], hh = hhv[u]; const bool lat = row < NLAT; const int pos = row & 2047;
            float v[8]; unpack8(w[u], v);
            if (hh >= 8) {
                float ss = 0.f;
#pragma unroll
                for (int e = 0; e < 8; ++e) ss += v[e] * v[e];
                ss += __shfl_xor(ss, 1); ss += __shfl_xor(ss, 2); ss += __shfl_xor(ss, 4);
                const float rstd = rsqrtf(ss * (1.0f / 64.0f) + EPS) * (hh >= 10 ? 0.125f * 1.4426950408889634f : 1.0f);
                const float* wp = p.in[hh < 10 ? 13 : 12] + l * 64 + d0;
                const f32x4 w0 = *(const f32x4*)wp, w1 = *(const f32x4*)(wp + 4);
#pragma unroll
                for (int e = 0; e < 4; ++e) { v[e] *= rstd * w0[e]; v[4 + e] *= rstd * w1[e]; }
                if (lat) { const int pp = (sub & 4) ? (pos & 63) : (pos >> 6); const float* cp = ATf + (size_t)(pp * 16 + (d0 & 15)) * 2; const bool up = (sub & 2) != 0;
#pragma unroll
                    for (int e = 0; e < 8; ++e) { const float o = __shfl_xor(v[e], 2); const float cc = cp[2 * e], sn = cp[2 * e + 1]; v[e] = up ? o * sn + v[e] * cc : v[e] * cc - o * sn; } }
            } else {
                if (lat) { const float* cp = RTf + (size_t)(pos * 32 + (d0 & 31)) * 2; const bool up = (sub & 4) != 0;
#pragma unroll
                    for (int e = 0; e < 8; ++e) { const float o = __shfl_xor(v[e], 4); const float cc = cp[2 * e], sn = cp[2 * e + 1]; v[e] = up ? o * sn + v[e] * cc : v[e] * cc - o * sn; } }
                if (hh < 4) {
#pragma unroll
                    for (int e = 0; e < 8; ++e) v[e] *= 0.125f; }
            }
            u32x4 o; o.x = cvt_pk_bf16(v[0], v[1]); o.y = cvt_pk_bf16(v[2], v[3]); o.z = cvt_pk_bf16(v[4], v[5]); o.w = cvt_pk_bf16(v[6], v[7]);
            *(u32x4*)(Z + (size_t)row * ZM + colv[u]) = o;
        }
    }
    LAS unsigned char* slab = (LAS unsigned char*)lds_raw;
    for (int it = blockIdx.x; it < nrows_pool / 64; it += gridDim.x) {
        const int r0 = it * 64; int sbase, L;
        if (r0 < NLAT) { sbase = r0 & ~2047; L = 2048; } else { sbase = NLAT + ((r0 - NLAT) & ~255); L = 256; }
        const int t0 = r0 - sbase, lo_row = max(t0 - 8, 0), hi_row = min(t0 + 72, L), nchunks = (hi_row - lo_row) * 64;
        __syncthreads();
        for (int e = tid; e < nchunks; e += NTHREADS) { const int rr = e >> 6, cch = e & 63; *(LAS u32x4*)(slab + rr * 1024 + cch * 16) = *(const u32x4*)(Z + (size_t)(sbase + lo_row + rr) * ZM + C_PU + cch * 8); }
        __syncthreads();
#pragma unroll 2
        for (int o = tid; o < 4096; o += NTHREADS) {
            const int rr = o >> 6, cch = o & 63, hw = 1 << (cch >> 4), t = t0 + rr, lo = max(t - hw, 0), hi = min(t + hw, L);
            float sacc[8];
#pragma unroll
            for (int j = 0; j < 8; ++j) sacc[j] = 0.f;
            for (int tt = lo; tt < hi; ++tt) { float v[8]; unpack8(*(const LAS u32x4*)(slab + (tt - lo_row) * 1024 + cch * 16), v);
#pragma unroll
                for (int j = 0; j < 8; ++j) sacc[j] += v[j]; }
            float own[8]; unpack8(*(const LAS u32x4*)(slab + (t - lo_row) * 1024 + cch * 16), own);
            const float inv = 1.0f / (float)(hi - lo);
            u32x4 ow; ow.x = cvt_pk_bf16(sacc[0] * inv - own[0], sacc[1] * inv - own[1]); ow.y = cvt_pk_bf16(sacc[2] * inv - own[2], sacc[3] * inv - own[3]);
            ow.z = cvt_pk_bf16(sacc[4] * inv - own[4], sacc[5] * inv - own[5]); ow.w = cvt_pk_bf16(sacc[6] * inv - own[6], sacc[7] * inv - own[7]);
            *(u32x4*)(YB + (size_t)(sbase + t) * 1536 + 512 + cch * 8) = ow;
        }
    }
    __syncthreads();
}

#define MFMA16(X, Y, ACC) __builtin_amdgcn_mfma_f32_16x16x32_bf16((X), (Y), (ACC), 0, 0, 0)
DEVI bf16x8 mk_frag(unsigned a, unsigned b, unsigned c, unsigned d) { u32x4 w; w.x = a; w.y = b; w.z = c; w.w = d; return __builtin_bit_cast(bf16x8, w); }
typedef short s16x4 __attribute__((ext_vector_type(4)));
DEVI bf16x8 tr_frag(LAS unsigned char* tile, int rs, int rowA, int rowB, int n0, int fr) {
    const s16x4 a = __builtin_amdgcn_ds_read_tr16_b64_v4i16((LAS s16x4*)(tile + (rowA + (fr >> 2)) * rs + n0 * 2 + 8 * (fr & 3)));
    const s16x4 b = __builtin_amdgcn_ds_read_tr16_b64_v4i16((LAS s16x4*)(tile + (rowB + (fr >> 2)) * rs + n0 * 2 + 8 * (fr & 3)));
    return __builtin_shufflevector(a, b, 0, 1, 2, 3, 4, 5, 6, 7);
}
DEVI void lds_put8_t(LAS unsigned char* base, int rowstride, int r0, int j, const u32x4 w) {
    *(LAS unsigned short*)(base + (r0 + 0) * rowstride + 2 * j) = (unsigned short)(w.x & 0xffffu); *(LAS unsigned short*)(base + (r0 + 1) * rowstride + 2 * j) = (unsigned short)(w.x >> 16);
    *(LAS unsigned short*)(base + (r0 + 2) * rowstride + 2 * j) = (unsigned short)(w.y & 0xffffu); *(LAS unsigned short*)(base + (r0 + 3) * rowstride + 2 * j) = (unsigned short)(w.y >> 16);
    *(LAS unsigned short*)(base + (r0 + 4) * rowstride + 2 * j) = (unsigned short)(w.z & 0xffffu); *(LAS unsigned short*)(base + (r0 + 5) * rowstride + 2 * j) = (unsigned short)(w.z >> 16);
    *(LAS unsigned short*)(base + (r0 + 6) * rowstride + 2 * j) = (unsigned short)(w.w & 0xffffu); *(LAS unsigned short*)(base + (r0 + 7) * rowstride + 2 * j) = (unsigned short)(w.w >> 16);
}

DEVI void ph_attn(const int wv, const Params& p, int l, unsigned char* lds_raw, int it_lo = 0) {
    const int tid = opaque_tid(wv), lane = tid & 63, wave = wv, fr = lane & 15, fq = lane >> 4;
    LAS unsigned char* Kl0 = (LAS unsigned char*)lds_raw;
    const bf16_t* Z = (const bf16_t*)(p.ws + OFF_ZG); bf16_t* YB = (bf16_t*)(p.ws + OFF_YB);
    const int nitems = 1024 + (l == 0 ? 128 : 0);
    for (int it = blockIdx.x + it_lo; it < nitems; it += gridDim.x) {
        int b, n, kvh, hp, qrow0; const bool isl = it < 1024;
        if (isl) { b = it >> 6; n = (it >> 2) & 15; kvh = (it >> 1) & 1; hp = it & 1; qrow0 = b * 2048 + n * 128; }
        else { const int i2 = it - 1024; b = i2 >> 3; n = (i2 >> 2) & 1; kvh = (i2 >> 1) & 1; hp = i2 & 1; qrow0 = NLAT + b * 256 + n * 128; }
        const int hq0 = kvh * 4 + hp * 2;
        const int ii = wave * 16 + fr;
        bf16x8 Qf[2][2];
#pragma unroll
        for (int g = 0; g < 2; ++g)
#pragma unroll
            for (int ks = 0; ks < 2; ++ks) Qf[g][ks] = *(const bf16x8*)(Z + (size_t)(qrow0 + ii) * ZM + C_AQ + (hq0 + g) * 64 + ks * 32 + fq * 8);
        {
            const int qpos = (qrow0 + ii) & 2047; const bool up = (fq & 2) != 0;
            float ssq[2]; float qv[2][2][8];
#pragma unroll
            for (int g = 0; g < 2; ++g) { ssq[g] = 0.f;
#pragma unroll
                for (int ks = 0; ks < 2; ++ks) { unpack8(__builtin_bit_cast(u32x4, Qf[g][ks]), qv[g][ks]);
#pragma unroll
                    for (int e = 0; e < 8; ++e) ssq[g] += qv[g][ks][e] * qv[g][ks][e]; }
                ssq[g] += __shfl_xor(ssq[g], 16); ssq[g] += __shfl_xor(ssq[g], 32);
                ssq[g] = rsqrtf(ssq[g] * (1.0f / 64.0f) + EPS) * (0.125f * 1.4426950408889634f); }
#pragma unroll
            for (int ks = 0; ks < 2; ++ks) {
                const float* wp = p.in[12] + l * 64 + ks * 32 + fq * 8;
                const f32x4 w0 = *(const f32x4*)wp, w1 = *(const f32x4*)(wp + 4);
                const float* cp = (const float*)(p.ws + OFF_AT) + (size_t)((ks ? (qpos & 63) : (qpos >> 6)) * 16 + (fq & 1) * 8) * 2;
                f32x4 cs[4];
                if (isl) {
#pragma unroll
                    for (int q4 = 0; q4 < 4; ++q4) cs[q4] = *(const f32x4*)(cp + 4 * q4); }
#pragma unroll
                for (int g = 0; g < 2; ++g) {
#pragma unroll
                    for (int e = 0; e < 8; ++e) { float v = qv[g][ks][e] * ssq[g] * (e < 4 ? w0[e & 3] : w1[e & 3]);
                        if (isl) { const float o = __shfl_xor(v, 32); const float cc = cs[e >> 1][(e & 1) * 2], sn = cs[e >> 1][(e & 1) * 2 + 1]; v = up ? o * sn + v * cc : v * cc - o * sn; }
                        qv[g][ks][e] = v; }
                    Qf[g][ks] = mk_frag(cvt_pk_bf16(qv[g][ks][0], qv[g][ks][1]), cvt_pk_bf16(qv[g][ks][2], qv[g][ks][3]), cvt_pk_bf16(qv[g][ks][4], qv[g][ks][5]), cvt_pk_bf16(qv[g][ks][6], qv[g][ks][7])); }
            }
        }
        float mrun[2], lrun[2]; f32x4 O[2][4];
#pragma unroll
        for (int g = 0; g < 2; ++g) { mrun[g] = p.in[14][l * 8 + hq0 + g] * 1.4426950408889634f; lrun[g] = fq == 0 ? 1.0f : 0.0f;
#pragma unroll
            for (int dt = 0; dt < 4; ++dt) O[g][dt] = (f32x4){0.f, 0.f, 0.f, 0.f}; }
#define AT_NEXT(T) ((isl && (T) == 1 && n == 15) ? 3 : (T) + 1)
#define AT_LOAD(T) do { const int krow0_ = (T) < 3 ? b * 2048 + (n - 1 + (T)) * 128 : NLAT + b * 256 + ((T) - 3) * 128; \
            _Pragma("unroll") for (int rep = 0; rep < 2; ++rep) { const int pi = tid + 512 * rep; \
                pk[rep] = *(const u32x4*)(Z + (size_t)(krow0_ + (pi >> 3)) * ZM + C_AK + kvh * 64 + (pi & 7) * 8); \
                pv[rep] = *(const u32x4*)(Z + (size_t)(krow0_ + (pi >> 3)) * ZM + C_AV + kvh * 64 + (pi & 7) * 8); } } while (0)
#define AT_WRITE(BUF) do { _Pragma("unroll") for (int rep = 0; rep < 2; ++rep) { const int pi = tid + 512 * rep; \
                *(LAS u32x4*)(Kl0 + (BUF) * 36864 + (pi >> 3) * 144 + (pi & 7) * 16) = pk[rep]; \
                *(LAS u32x4*)(Kl0 + (BUF) * 36864 + 18432 + (pi >> 3) * 144 + (pi & 7) * 16) = pv[rep]; } } while (0)
        int t = isl ? (n > 0 ? 0 : 1) : 3, buf = 0;
        u32x4 pk[2], pv[2];
        AT_LOAD(t);
        __syncthreads();
        AT_WRITE(0);
        { const int t1 = AT_NEXT(t); if (t1 < 5) AT_LOAD(t1); }
        while (t < 5) {
            const int tn = AT_NEXT(t);
            const int msgn = t == 0 ? 1 : (t == 2 ? -1 : 0);
            const int dbase = 4 * fq - ii;
            __syncthreads();
            if (tn < 5) { AT_WRITE(buf ^ 1); const int tnn = AT_NEXT(tn); if (tnn < 5) AT_LOAD(tnn); }
            LAS unsigned char* Kl = Kl0 + buf * 36864; LAS unsigned char* Vl = Kl + 18432;
            const int jlo = msgn > 0 ? wave : 0, jhi = msgn < 0 ? wave : 7;
            f32x4 sc[2][8];
#pragma unroll
            for (int jt = 0; jt < 8; ++jt) {
                if (jt < jlo || jt > jhi) { sc[0][jt] = (f32x4){-INFINITY, -INFINITY, -INFINITY, -INFINITY}; sc[1][jt] = sc[0][jt]; continue; }
                sc[0][jt] = (f32x4){0.f, 0.f, 0.f, 0.f}; sc[1][jt] = (f32x4){0.f, 0.f, 0.f, 0.f};
#pragma unroll
                for (int ks = 0; ks < 2; ++ks) { const bf16x8 kf = *(const LAS bf16x8*)(Kl + (jt * 16 + fr) * 144 + ks * 64 + fq * 16);
                    sc[0][jt] = MFMA16(kf, Qf[0][ks], sc[0][jt]); sc[1][jt] = MFMA16(kf, Qf[1][ks], sc[1][jt]); } }
#pragma unroll
            for (int g = 0; g < 2; ++g) {
                float mx = mrun[g];
                if (msgn != 0) {
#pragma unroll
                    for (int jt = 0; jt < 8; ++jt)
#pragma unroll
                        for (int i = 0; i < 4; ++i) { const int d = msgn * (dbase + jt * 16 + i); sc[g][jt][i] = d >= 0 ? sc[g][jt][i] : -INFINITY; }
                }
#pragma unroll
                for (int jt = 0; jt < 8; ++jt) { mx = fmaxf(fmaxf(mx, sc[g][jt][0]), sc[g][jt][1]); mx = fmaxf(fmaxf(mx, sc[g][jt][2]), sc[g][jt][3]); }
                mx = fmaxf(mx, __shfl_xor(mx, 16)); mx = fmaxf(mx, __shfl_xor(mx, 32));
                const float alpha = __builtin_amdgcn_exp2f(mrun[g] - mx); mrun[g] = mx;
                float ps = 0.f;
#pragma unroll
                for (int jt = 0; jt < 8; ++jt)
#pragma unroll
                    for (int i = 0; i < 4; ++i) { const float e = __builtin_amdgcn_exp2f(sc[g][jt][i] - mx); sc[g][jt][i] = e; ps += e; }
                lrun[g] = lrun[g] * alpha + ps;
#pragma unroll
                for (int dt = 0; dt < 4; ++dt) O[g][dt] *= alpha;
            }
#pragma unroll
            for (int sI = 0; sI < 4; ++sI) {
                if (2 * sI + 1 < jlo || 2 * sI > jhi) continue;
                const bf16x8 pf0 = mk_frag(cvt_pk_bf16(sc[0][2 * sI][0], sc[0][2 * sI][1]), cvt_pk_bf16(sc[0][2 * sI][2], sc[0][2 * sI][3]), cvt_pk_bf16(sc[0][2 * sI + 1][0], sc[0][2 * sI + 1][1]), cvt_pk_bf16(sc[0][2 * sI + 1][2], sc[0][2 * sI + 1][3]));
                const bf16x8 pf1 = mk_frag(cvt_pk_bf16(sc[1][2 * sI][0], sc[1][2 * sI][1]), cvt_pk_bf16(sc[1][2 * sI][2], sc[1][2 * sI][3]), cvt_pk_bf16(sc[1][2 * sI + 1][0], sc[1][2 * sI + 1][1]), cvt_pk_bf16(sc[1][2 * sI + 1][2], sc[1][2 * sI + 1][3]));
#pragma unroll
                for (int dt = 0; dt < 4; ++dt) {
                    const bf16x8 vf = tr_frag(Vl, 144, (2 * sI) * 16 + 4 * fq, (2 * sI + 1) * 16 + 4 * fq, dt * 16, fr);
                    O[0][dt] = MFMA16(vf, pf0, O[0][dt]); O[1][dt] = MFMA16(vf, pf1, O[1][dt]); }
            }
            t = tn; buf ^= 1;
        }
#undef AT_NEXT
#undef AT_LOAD
#undef AT_WRITE
#pragma unroll
        for (int g = 0; g < 2; ++g) { float lt = lrun[g]; lt += __shfl_xor(lt, 16); lt += __shfl_xor(lt, 32); const float inv = 1.0f / lt;
#pragma unroll
            for (int dt = 0; dt < 4; ++dt) { u32x2 w; w.x = cvt_pk_bf16(O[g][dt][0] * inv, O[g][dt][1] * inv); w.y = cvt_pk_bf16(O[g][dt][2] * inv, O[g][dt][3] * inv);
                *(u32x2*)(YB + (size_t)(qrow0 + ii) * 1536 + 1024 + (hq0 + g) * 64 + dt * 16 + 4 * fq) = w; } }
    }
    __syncthreads();
}

DEVI void ph_ret_state(const int wv, const Params& p, int l, unsigned char* lds_raw) {
    const int tid = opaque_tid(wv), lane = tid & 63, wave = wv, fr = lane & 15, fq = lane >> 4;
    LAS unsigned char* Kt = (LAS unsigned char*)lds_raw;
    const bf16_t* Z = (const bf16_t*)(p.ws + OFF_ZG); bf16_t* RS = (bf16_t*)(p.ws + OFF_RS);
    for (int it = blockIdx.x; it < 256; it += gridDim.x) {
        const int b = it >> 4, h = (it >> 2) & 3, dir = (it >> 1) & 1, half = it & 1;
        const float e_ = p.in[9][(l * 2 + dir) * 4 + h];
        const float lg2 = log1pf(-exp2f(-e_)) * 1.4426950408889634f;
        const float gC = exp2f(128.0f * lg2);
        f32x4 R[2]; R[0] = (f32x4){0.f, 0.f, 0.f, 0.f}; R[1] = R[0];
        const int j0 = tid >> 3, g80 = tid & 7;
        const float wj0 = exp2f((float)(dir == 0 ? 127 - j0 : j0) * lg2), wj1 = exp2f((float)(dir == 0 ? 63 - j0 : j0 + 64) * lg2);
        u32x4 kwr[2], vwr[2];
#define RS_LOAD(N) do { const int c_ = dir == 0 ? (N) : ((N) < 2 ? 1 - (N) : 19 - (N)); const int r_ = c_ < 2 ? NLAT + b * 256 + c_ * 128 : b * 2048 + (c_ - 2) * 128; \
            _Pragma("unroll") for (int rep = 0; rep < 2; ++rep) { const int jr = j0 + 64 * rep; \
                kwr[rep] = *(const u32x4*)(Z + (size_t)(r_ + jr) * ZM + C_RK + h * 64 + g80 * 8); \
                vwr[rep] = *(const u32x4*)(Z + (size_t)(r_ + jr) * ZM + C_RV + h * 128 + half * 64 + g80 * 8); } } while (0)
#define RS_WRITE(BUF) do { _Pragma("unroll") for (int rep = 0; rep < 2; ++rep) { const int jr = j0 + 64 * rep; const float wj = rep ? wj1 : wj0; const u32x4 kw = kwr[rep]; \
                u32x4 ks; ks.x = cvt_pk_bf16(bflo(kw.x) * wj, bfhi(kw.x) * wj); ks.y = cvt_pk_bf16(bflo(kw.y) * wj, bfhi(kw.y) * wj); ks.z = cvt_pk_bf16(bflo(kw.z) * wj, bfhi(kw.z) * wj); ks.w = cvt_pk_bf16(bflo(kw.w) * wj, bfhi(kw.w) * wj); \
                *(LAS u32x4*)(Kt + (BUF) * 36864 + jr * 144 + g80 * 16) = ks; *(LAS u32x4*)(Kt + (BUF) * 36864 + 18432 + jr * 144 + g80 * 16) = vwr[rep]; } } while (0)
        RS_LOAD(0);
        __syncthreads();
        RS_WRITE(0);
        RS_LOAD(1);
        int buf = 0;
        for (int n = 0; n < 18; ++n) {
            const int cid = dir == 0 ? n : (n < 2 ? 1 - n : 19 - n);
#pragma unroll
            for (int tt = 0; tt < 2; ++tt) { const int t = wave * 2 + tt, dkt = t >> 2, dvt = t & 3;
                u32x2 w; w.x = cvt_pk_bf16(R[tt][0], R[tt][1]); w.y = cvt_pk_bf16(R[tt][2], R[tt][3]);
                *(u32x2*)(RS + ((size_t)((b * 4 + h) * 18 + cid) * 128 + half * 64 + dvt * 16 + fr) * 128 + dir * 64 + dkt * 16 + 4 * fq) = w; }
            if (n == 17) break;
            __syncthreads();
            if (n + 1 < 17) { RS_WRITE(buf ^ 1); if (n + 2 < 17) RS_LOAD(n + 2); }
            LAS unsigned char* Kb = Kt + buf * 36864; LAS unsigned char* Vb = Kb + 18432;
#pragma unroll
            for (int tt = 0; tt < 2; ++tt) { const int t = wave * 2 + tt, dkt = t >> 2, dvt = t & 3;
                f32x4 u = (f32x4){0.f, 0.f, 0.f, 0.f};
#pragma unroll
                for (int ks = 0; ks < 4; ++ks) { const bf16x8 xf = tr_frag(Kb, 144, ks * 32 + 8 * fq, ks * 32 + 8 * fq + 4, dkt * 16, fr), yf = tr_frag(Vb, 144, ks * 32 + 8 * fq, ks * 32 + 8 * fq + 4, dvt * 16, fr); u = MFMA16(xf, yf, u); }
                R[tt] = R[tt] * gC + u; }
            buf ^= 1;
        }
#undef RS_LOAD
#undef RS_WRITE
        __syncthreads();
    }
}

DEVI void ph_ret_out(const int wv, const Params& p, int l, unsigned char* lds_raw) {
    const int tid = opaque_tid(wv), lane = tid & 63, wave = wv, fr = lane & 15, fq = lane >> 4;
    LAS unsigned char* Kl = (LAS unsigned char*)lds_raw;
    LAS unsigned char* Ql = Kl + 18432;
    LAS unsigned char* Vt = Ql + 18432;
    LAS unsigned char* Rl = Vt + 36864;
    const bf16_t* Z = (const bf16_t*)(p.ws + OFF_ZG); const bf16_t* RS = (const bf16_t*)(p.ws + OFF_RS); bf16_t* YB = (bf16_t*)(p.ws + OFF_YB);
    const int nch = l == 0 ? 18 : 16, nitems = 64 * nch;
    u32x4 pk[2], pq[2], pr[4], pvv[4];
#define RO_LOAD(IT) do { const int bh_ = (IT) / nch, ci_ = (IT) - bh_ * nch, b_ = bh_ >> 2, h_ = bh_ & 3, cid_ = l == 0 ? ci_ : ci_ + 2; \
        const int row0_ = cid_ < 2 ? NLAT + b_ * 256 + cid_ * 128 : b_ * 2048 + (cid_ - 2) * 128; \
        _Pragma("unroll") for (int rep = 0; rep < 2; ++rep) { const int pi = tid + 512 * rep, r = pi >> 3, g8 = pi & 7; \
            pk[rep] = *(const u32x4*)(Z + (size_t)(row0_ + r) * ZM + C_RK + h_ * 64 + g8 * 8); pq[rep] = *(const u32x4*)(Z + (size_t)(row0_ + r) * ZM + C_RQ + h_ * 64 + g8 * 8); } \
        _Pragma("unroll") for (int rep = 0; rep < 4; ++rep) { const int pi = tid + 512 * rep; \
            pr[rep] = *(const u32x4*)(RS + ((size_t)(bh_ * 18 + cid_) * 128 + (pi >> 4)) * 128 + (pi & 15) * 8); \
            pvv[rep] = *(const u32x4*)(Z + (size_t)(row0_ + (pi >> 4)) * ZM + C_RV + h_ * 128 + (pi & 15) * 8); } } while (0)
    if ((int)blockIdx.x < nitems) RO_LOAD((int)blockIdx.x);
    for (int it = blockIdx.x; it < nitems; it += gridDim.x) {
        const int bh = it / nch, ci = it - bh * nch, b = bh >> 2, h = bh & 3, cid = l == 0 ? ci : ci + 2;
        const int row0 = cid < 2 ? NLAT + b * 256 + cid * 128 : b * 2048 + (cid - 2) * 128;
        const float lgf = log1pf(-exp2f(-p.in[9][(l * 2 + 0) * 4 + h])) * 1.4426950408889634f, lgb = log1pf(-exp2f(-p.in[9][(l * 2 + 1) * 4 + h])) * 1.4426950408889634f;
        __syncthreads();
#pragma unroll
        for (int rep = 0; rep < 2; ++rep) { const int pi = tid + 512 * rep, r = pi >> 3, g8 = pi & 7;
            *(LAS u32x4*)(Kl + r * 144 + g8 * 16) = pk[rep]; *(LAS u32x4*)(Ql + r * 144 + g8 * 16) = pq[rep]; }
#pragma unroll
        for (int rep = 0; rep < 4; ++rep) { const int pi = tid + 512 * rep;
            *(LAS u32x4*)(Rl + (pi >> 4) * 272 + (pi & 15) * 16) = pr[rep];
            *(LAS u32x4*)(Vt + (pi >> 4) * 288 + (pi & 15) * 16) = pvv[rep]; }
        __syncthreads();
        if (it + (int)gridDim.x < nitems) RO_LOAD(it + (int)gridDim.x);
        const int ii = wave * 16 + fr;
        bf16x8 Qf[2];
#pragma unroll
        for (int ks = 0; ks < 2; ++ks) Qf[ks] = *(const LAS bf16x8*)(Ql + ii * 144 + ks * 64 + fq * 16);
        if (cid >= 2) {
            const float* cp = (const float*)(p.ws + OFF_RT) + (size_t)(((row0 + ii) & 2047) * 32 + fq * 8) * 2;
            float x1[8], x2[8]; unpack8(__builtin_bit_cast(u32x4, Qf[0]), x1); unpack8(__builtin_bit_cast(u32x4, Qf[1]), x2);
            float y1[8], y2[8];
#pragma unroll
            for (int q4 = 0; q4 < 4; ++q4) { const f32x4 cs = *(const f32x4*)(cp + 4 * q4);
                y1[2 * q4] = x1[2 * q4] * cs[0] - x2[2 * q4] * cs[1]; y2[2 * q4] = x1[2 * q4] * cs[1] + x2[2 * q4] * cs[0];
                y1[2 * q4 + 1] = x1[2 * q4 + 1] * cs[2] - x2[2 * q4 + 1] * cs[3]; y2[2 * q4 + 1] = x1[2 * q4 + 1] * cs[3] + x2[2 * q4 + 1] * cs[2]; }
            Qf[0] = mk_frag(cvt_pk_bf16(y1[0], y1[1]), cvt_pk_bf16(y1[2], y1[3]), cvt_pk_bf16(y1[4], y1[5]), cvt_pk_bf16(y1[6], y1[7]));
            Qf[1] = mk_frag(cvt_pk_bf16(y2[0], y2[1]), cvt_pk_bf16(y2[2], y2[3]), cvt_pk_bf16(y2[4], y2[5]), cvt_pk_bf16(y2[6], y2[7]));
        }
        f32x4 sc[8];
#pragma unroll
        for (int jt = 0; jt < 8; ++jt) { sc[jt] = (f32x4){0.f, 0.f, 0.f, 0.f};
#pragma unroll
            for (int ks = 0; ks < 2; ++ks) { const bf16x8 kf = *(const LAS bf16x8*)(Kl + (jt * 16 + fr) * 144 + ks * 64 + fq * 16); sc[jt] = MFMA16(kf, Qf[ks], sc[jt]); } }
#pragma unroll
        for (int jt = 0; jt < 8; ++jt)
#pragma unroll
            for (int i = 0; i < 4; ++i) { const int d = ii - (jt * 16 + 4 * fq + i); const float f = __builtin_amdgcn_exp2f(d > 0 ? (float)d * lgf : (float)(-d) * lgb); sc[jt][i] *= (d == 0 ? 2.0f : f); }
        f32x4 Y[8];
#pragma unroll
        for (int dt = 0; dt < 8; ++dt) Y[dt] = (f32x4){0.f, 0.f, 0.f, 0.f};
#pragma unroll
        for (int sI = 0; sI < 4; ++sI) {
            const bf16x8 pf = mk_frag(cvt_pk_bf16(sc[2 * sI][0], sc[2 * sI][1]), cvt_pk_bf16(sc[2 * sI][2], sc[2 * sI][3]), cvt_pk_bf16(sc[2 * sI + 1][0], sc[2 * sI + 1][1]), cvt_pk_bf16(sc[2 * sI + 1][2], sc[2 * sI + 1][3]));
#pragma unroll
            for (int dt = 0; dt < 8; ++dt) {
                Y[dt] = MFMA16(tr_frag(Vt, 288, (2 * sI) * 16 + 4 * fq, (2 * sI + 1) * 16 + 4 * fq, dt * 16, fr), pf, Y[dt]); }
        }
        u32x2 gwv[8];
#pragma unroll
        for (int dt = 0; dt < 8; ++dt) gwv[dt] = *(const u32x2*)(Z + (size_t)(row0 + ii) * ZM + C_RG + h * 128 + dt * 16 + 4 * fq);
        const float xf = __builtin_amdgcn_exp2f((float)(ii + 1) * lgf), xb = __builtin_amdgcn_exp2f((float)(128 - ii) * lgb);
#pragma unroll
        for (int ks = 0; ks < 4; ++ks) {
            const u32x4 qw = __builtin_bit_cast(u32x4, Qf[ks & 1]); const float xs = ks < 2 ? xf : xb;
            const bf16x8 qs = mk_frag(cvt_pk_bf16(bflo(qw.x) * xs, bfhi(qw.x) * xs), cvt_pk_bf16(bflo(qw.y) * xs, bfhi(qw.y) * xs), cvt_pk_bf16(bflo(qw.z) * xs, bfhi(qw.z) * xs), cvt_pk_bf16(bflo(qw.w) * xs, bfhi(qw.w) * xs));
#pragma unroll
            for (int dt = 0; dt < 8; ++dt) { const bf16x8 rf = *(const LAS bf16x8*)(Rl + (dt * 16 + fr) * 272 + ks * 64 + fq * 16); Y[dt] = MFMA16(rf, qs, Y[dt]); }
        }
        float ss = 0.f;
#pragma unroll
        for (int dt = 0; dt < 8; ++dt) ss += Y[dt][0] * Y[dt][0] + Y[dt][1] * Y[dt][1] + Y[dt][2] * Y[dt][2] + Y[dt][3] * Y[dt][3];
        ss += __shfl_xor(ss, 16); ss += __shfl_xor(ss, 32);
        const float rstd = rsqrtf(ss * (1.0f / 128.0f) + EPS);
#pragma unroll
        for (int dt = 0; dt < 8; ++dt) {
            const u32x2 gw = gwv[dt];
            const float g0 = bflo(gw.x), g1 = bfhi(gw.x), g2 = bflo(gw.y), g3 = bfhi(gw.y);
            u32x2 w; w.x = cvt_pk_bf16(g0 * sigmoidf_(g0) * Y[dt][0] * rstd, g1 * sigmoidf_(g1) * Y[dt][1] * rstd); w.y = cvt_pk_bf16(g2 * sigmoidf_(g2) * Y[dt][2] * rstd, g3 * sigmoidf_(g3) * Y[dt][3] * rstd);
            *(u32x2*)(YB + (size_t)(row0 + ii) * 1536 + h * 128 + dt * 16 + 4 * fq) = w; }
    }
#undef RO_LOAD
    __syncthreads();
}

#ifndef ATT_MFMA
#define ATT_MFMA 1
#endif
#ifndef RET_MFMA
#define RET_MFMA 1
#endif
constexpr int NPL = 10;
constexpr int NPH = 1 + 2 * NPL;

__global__ void __launch_bounds__(NTHREADS) mega(Params p) {
    extern __shared__ __attribute__((aligned(16))) unsigned char lds_raw[];
    cg::grid_group grid = cg::this_grid();
    const int wv = __builtin_amdgcn_readfirstlane(threadIdx.x >> 6);
    LAS unsigned char* lds = (LAS unsigned char*)lds_raw;
    const int G = gridDim.x, c = blockIdx.x;
    const int lo = p.ph_lo, hi = p.ph_hi;
    if (hi < 0) grid.sync();
    XcdBarrier xb; xb.bar = (unsigned*)(p.ws + OFF_BAR); xb.x = xb_xcc_id(); xb.st = (volatile LAS unsigned*)(lds + LDS_BYTES);
    { const int t0 = opaque_tid(wv); if (t0 == 0) { xb.st[0] = 0u; xb.st[1] = 0u; } __syncthreads(); if (t0 == 0) (void)xb_add(&xb.bar[XB_XCNT(xb.x)], 1u); }
    bf16_t* WB = (bf16_t*)(p.ws + OFF_WB);
    bf16_t* ZG = (bf16_t*)(p.ws + OFF_ZG); bf16_t* YB = (bf16_t*)(p.ws + OFF_YB); bf16_t* UB = (bf16_t*)(p.ws + OFF_UB);
#ifndef DUPMASK
#define DUPMASK 0
#endif
#define PHASE(ph, ...) if ((ph) >= lo && (ph) < hi) { __VA_ARGS__; if ((ph) + 1 < hi) xcd_barrier(xb, wv); }
#define PHASED(flag, ph, ...) if ((ph) >= lo && (ph) < hi) { __VA_ARGS__; if (DUPMASK & (flag)) { xcd_barrier(xb, wv); __VA_ARGS__; } if ((ph) + 1 < hi) xcd_barrier(xb, wv); }
    PHASED(64, 0, ph_setup(wv, p, lds_raw); __syncthreads(); ph_convert(wv, p, 0, lds_raw, 3, 0))
#pragma unroll 1
    for (int l = 0; l < 2; ++l) {
        const int b = 1 + l * NPL;
        const int Mrows = l == 0 ? RT_ : NLAT;
        PHASED(1, b + 0, if (l > 0) ph_convert(wv, p, l, lds_raw, 2, 0); ph_norm(wv, p, l, 0, RT_))
        PHASED(2, b + 1, { pg8::Gemm g{UB, WB + W_IN, 1024, 1024, 1024, 0, 0}; pg8::Order S; if (l == 0) S.init(RT_, ZM, G, c, 1); else { S.init(NLAT, ZM, G, c, 1); S.set_tail(NCTX, 4); }     pg8::EpiBf16<0> E{ZG, ZM, nullptr, nullptr, 0}; pg8::gemm_phase(wv, lds, g, S, E); if (l == 0) ph_convert(wv, p, 0, lds_raw, 4, 48); })
        PHASE(b + 2, ph_prep(wv, p, l, Mrows, lds_raw))
        PHASED(4, b + 3, ph_ret_state(wv, p, l, lds_raw); ph_attn(wv, p, l, lds_raw))
        PHASED(8, b + 4, ph_ret_out(wv, p, l, lds_raw))
        PHASED(2, b + 5, { pg8::Gemm g{UB, WB + W_IN + (size_t)ZM * 1024, 1024, 1024, 1024, 0, 0}; pg8::Order S; S.init(Mrows, ZGW, G, c, 1); pg8::EpiBf16<2> E{ZG, ZGW, nullptr, nullptr, 0}; pg8::gemm_phase(wv, lds, g, S, E); })
        PHASED(32, b + 6, { pg8::Gemm g{YB, WB + W_BR, 1536, 512, 512, 512 * 2, (size_t)1024 * 512 * 2}; pg8::Order S; S.init(Mrows, 1024, G, c, 3); pg8::EpiMerge E{ZG, UB}; pg8::gemm_phase(wv, lds, g, S, E); if (l == 0) ph_shw(wv, p, 0, lds_raw, 64); })
        PHASE(b + 7, { pg8::Gemm g{UB, WB + W_O, 1024, 1024, 1024, 0, 0}; pg8::Order S; S.init(Mrows, 1024, G, c, 1); pg8::EpiRes E{p, l, 2048, 0, 1}; pg8::gemm_phase(wv, lds, g, S, E); })
        PHASED(16, b + 8, { pg8::Gemm g{(const bf16_t*)(p.ws + OFF_U2), WB + W_1, 1024, 1024, 1024, 0, 0}; pg8::Order S; S.init(Mrows, HID, G, c, 1); pg8::EpiBf16<1, true> E{(bf16_t*)(p.ws + OFF_H), HID, (const float*)(p.ws + OFF_SSQ2) + (size_t)l * RT_, (const float*)(p.ws + OFF_SHW2) + (size_t)l * 17 * 4096, 4096}; pg8::gemm_phase(wv, lds, g, S, E); })
        PHASE(b + 9, { pg8::Gemm g{(const bf16_t*)(p.ws + OFF_H), WB + W_2, HID, HID, HID, 0, 0}; pg8::Order S; S.init(Mrows, 1024, G, c, 1); pg8::EpiRes E{p, l, 5120, 1, 0}; pg8::gemm_phase(wv, lds, g, S, E); if (l == 0) { ph_convert(wv, p, 1, lds_raw, 1, 64); ph_shw(wv, p, 1, lds_raw, 64); } })
    }
    if (DUPMASK & 128) { for (int i = 0; i < 20; ++i) xcd_barrier(xb, wv); }
#undef PHASE
#undef PHASED
}

#ifndef MULTI_LAUNCH
#define MULTI_LAUNCH 0
#endif

extern "C" void kernel_launch(void* const* d_in, const int* in_sizes, int n_in, void* d_out, int out_size, void* d_ws, size_t ws_size, hipStream_t stream) {
    static int grid = 0;
    if (grid == 0) {
        if (ws_size < WS_END) { fprintf(stderr, "kernel_launch: workspace too small: %zu < %zu\n", ws_size, (size_t)WS_END); grid = -1; return; }
        int dev = 0, cus = 0, per_cu = 0;
        hipGetDevice(&dev);
        hipDeviceGetAttribute(&cus, hipDeviceAttributeMultiprocessorCount, dev);
        if (hipFuncSetAttribute((const void*)mega, hipFuncAttributeMaxDynamicSharedMemorySize, LDS_TOTAL) != hipSuccess) { fprintf(stderr, "kernel_launch: hipFuncSetAttribute failed\n"); grid = -1; return; }
        if (hipOccupancyMaxActiveBlocksPerMultiprocessor(&per_cu, (const void*)mega, NTHREADS, LDS_TOTAL) != hipSuccess || per_cu < 1) { fprintf(stderr, "kernel_launch: occupancy query gave %d\n", per_cu); per_cu = 1; }
        (void)hipGetLastError();
        grid = cus * per_cu;
        fprintf(stderr, "kernel_launch: grid %d (cus %d x %d)\n", grid, cus, per_cu);
    }
    if (grid < 0) return;
    if (hipMemsetAsync((char*)d_ws + OFF_BAR, 0, BAR_BYTES, stream) != hipSuccess) { fprintf(stderr, "kernel_launch: memset of barrier words failed\n"); return; }
    Params p{};
    for (int i = 0; i < 21; ++i) p.in[i] = (const float*)d_in[i];
    p.out = (float*)d_out; p.ws = (unsigned char*)d_ws;
#if MULTI_LAUNCH
    for (int ph = 0; ph < NPH; ++ph) {
        p.ph_lo = ph; p.ph_hi = ph + 1;
        hipLaunchKernelGGL(mega, dim3(grid), dim3(NTHREADS), LDS_TOTAL, stream, p);
    }
#else
    p.ph_lo = 0; p.ph_hi = NPH;
    void* args[] = {&p};
    hipError_t e = hipLaunchCooperativeKernel((const void*)mega, dim3(grid), dim3(NTHREADS), args, LDS_TOTAL, stream);
    if (e != hipSuccess) fprintf(stderr, "cooperative launch failed: %s (grid %d)\n", hipGetErrorString(e), grid);
#endif
}
```

```cpp
#include <hip/hip_runtime.h>
#include <hip/hip_cooperative_groups.h>
#include <cstdio>
namespace cg = cooperative_groups;

#define DEVI __device__ __forceinline__
#define LAS __attribute__((address_space(3)))
typedef unsigned short bf16_t;
typedef short bf16x8 __attribute__((ext_vector_type(8)));
typedef float f32x4 __attribute__((ext_vector_type(4)));
typedef unsigned u32x4 __attribute__((ext_vector_type(4)));
typedef unsigned u32x2 __attribute__((ext_vector_type(2)));

constexpr int DM = 1024, NB = 16, SEQ = 2048, LCTX = 256, NLAT = NB * SEQ, NCTX = NB * LCTX, RT_ = NLAT + NCTX;
constexpr int ZM = 2816, ZGW = 3072, INC = 5888, HID = 4096;
constexpr int C_RK = 0, C_RV = 256, C_AK = 768, C_AV = 896, C_RQ = 1024, C_RG = 1280, C_AQ = 1792, C_PU = 2304;
constexpr float EPS = 1e-6f;
constexpr int NTHREADS = 512;
constexpr int LDS_BYTES = 131072;
constexpr int LDS_TOTAL = LDS_BYTES + 16;

constexpr size_t OFF_ZG = 0;
constexpr size_t OFF_YB = OFF_ZG + (size_t)RT_ * ZGW * 2;
constexpr size_t OFF_UB = OFF_YB + (size_t)RT_ * 1536 * 2;
constexpr size_t OFF_XC = OFF_UB + (size_t)RT_ * 1024 * 2;
constexpr size_t OFF_WB = OFF_XC + (size_t)NCTX * 1024 * 4;
constexpr size_t W_IN = 0, W_BR = W_IN + (size_t)INC * 1024, W_O = W_BR + 3 * 512 * 1024, W_1 = W_O + 1024 * 1024, W_2 = W_1 + 4096 * 1024, W_END = W_2 + 4096 * 1024;
constexpr size_t OFF_RS = OFF_WB + W_END * 2;
constexpr size_t OFF_MOD = OFF_RS + (size_t)NB * 4 * 2 * 18 * 8192 * 2;
constexpr size_t OFF_RT = OFF_MOD + 2 * 17 * 6144 * 4;
constexpr size_t OFF_AT = OFF_RT + 2048 * 32 * 8;
constexpr size_t OFF_BAR = OFF_AT + 64 * 16 * 8;
constexpr size_t BAR_BYTES = 16384;
constexpr size_t OFF_SSQ2 = OFF_BAR + BAR_BYTES;
constexpr size_t OFF_SHW2 = OFF_SSQ2 + (size_t)2 * RT_ * 4;
constexpr size_t OFF_A2 = OFF_SHW2 + (size_t)2 * 17 * 4096 * 4;
constexpr size_t WS_END = OFF_A2 + (size_t)2 * 17 * 1024 * 4;
constexpr size_t OFF_U2 = OFF_ZG;
constexpr size_t OFF_H = OFF_ZG + (size_t)RT_ * 1024 * 2;
static_assert(OFF_H + (size_t)RT_ * 4096 * 2 <= OFF_XC, "H overlaps the ctx stream");

struct Params { const float* in[21]; float* out; unsigned char* ws; int ph_lo, ph_hi; };

DEVI int opaque_tid(int wv) { int ln; asm volatile("v_mbcnt_lo_u32_b32 %0, -1, 0\n\tv_mbcnt_hi_u32_b32 %0, -1, %0" : "=v"(ln)); return wv * 64 + ln; }
DEVI float bf2f(bf16_t h) { return __uint_as_float(((unsigned)h) << 16); }
DEVI float bflo(unsigned w) { return __uint_as_float(w << 16); }
DEVI float bfhi(unsigned w) { return __uint_as_float(w & 0xffff0000u); }
DEVI unsigned cvt_pk_bf16(float lo, float hi) { unsigned r; asm volatile("v_cvt_pk_bf16_f32 %0, %1, %2" : "=v"(r) : "v"(lo), "v"(hi)); return r; }
DEVI bf16_t f2bf(float f) { return (bf16_t)(cvt_pk_bf16(f, 0.f) & 0xffffu); }
DEVI float wsum(float v) {
#pragma unroll
    for (int o = 32; o > 0; o >>= 1) v += __shfl_xor(v, o);
    return v; }
DEVI float wmax(float v) {
#pragma unroll
    for (int o = 32; o > 0; o >>= 1) v = fmaxf(v, __shfl_xor(v, o));
    return v; }
DEVI float sigmoidf_(float g) { return __builtin_amdgcn_rcpf(1.0f + __expf(-g)); }
DEVI const float* xrow_in(const Params& p, int l, int row) {
    if (l == 0) return row < NLAT ? p.in[0] + (size_t)row * DM : p.in[2] + (size_t)(row - NLAT) * DM;
    return row < NLAT ? p.out + (size_t)row * DM : (const float*)(p.ws + OFF_XC) + (size_t)(row - NLAT) * DM;
}
DEVI float* xrow_out(const Params& p, int row) { return row < NLAT ? p.out + (size_t)row * DM : (float*)(p.ws + OFF_XC) + (size_t)(row - NLAT) * DM; }
DEVI const float* modrow(const Params& p, int l, int row) { const int bi = row < NLAT ? (row >> 11) : 16; return (const float*)(p.ws + OFF_MOD) + (size_t)(l * 17 + bi) * 6144; }

namespace pg8 {
constexpr int BM = 256, BK = 64, HALF = 128, HTB = HALF * BK * 2, NXCD = 8, WGM = 8;
DEVI int lds_byte(int r, int c) { const int st = (r >> 4) * 2 + (c >> 5), rr = r & 15, cc = c & 31, ob = rr * 64 + cc * 2; return st * 1024 + (ob ^ (((ob >> 9) & 1) << 5)); }
DEVI void stage_rc(int b, int& R, int& C) { const int st = b / 1024, sb = b % 1024, swz = sb ^ (((sb >> 9) & 1) << 5); R = (st >> 1) * 16 + swz / 64; C = (st & 1) * 32 + (swz % 64) / 2; }
DEVI int perm32(int rho) { const int n = rho >> 4, i = rho & 15; return 8 * (i >> 2) + 4 * n + (i & 3); }

struct Unit { int pm, pn, pb; };
struct Gemm { const bf16_t* A; const bf16_t* Bt; int lda, ldb, K; size_t a_bs, b_bs; };
struct Order {
    int nM, nN, nwg, G, c, nb, tail_units, tail_nN;
    DEVI void init(int M, int N, int G_, int c_, int nb_) { nM = M / BM; nN = N / BM; nwg = nM * nN; G = G_; c = c_; nb = nb_; tail_units = 0; tail_nN = 1; }
    DEVI void set_tail(int tail_rows, int tail_nN_) { tail_nN = tail_nN_; tail_units = (tail_rows / BM) * tail_nN_; }
    DEVI bool next(int i, Unit& u) const {
        const int ti = i / nb; u.pb = i - ti * nb;
        const long L = (long)ti * G + c;
        if (L >= nwg) { const int t = (int)(L - nwg); if (t >= tail_units) return false; u.pm = nM + t / tail_nN; u.pn = t % tail_nN; return true; }
        int wgid = (int)L; { const int q = nwg / NXCD, r = nwg % NXCD, xcd = wgid % NXCD, off = wgid / NXCD; wgid = (xcd < r ? xcd * (q + 1) : r * (q + 1) + (xcd - r) * q) + off; }
        const int nig = WGM * nN, gid = wgid / nig, fm = gid * WGM, gsz = (nM - fm) < WGM ? (nM - fm) : WGM;
        u.pm = fm + ((wgid % nig) % gsz); u.pn = (wgid % nig) / gsz; return true;
    }
};

template <int ACT  , bool RS = false  > struct EpiBf16 {
    static constexpr bool PERM = true;
    bf16_t* O; int ldc; const float* ssq; const float* shw; int ldshw;
    DEVI bool keep(const Unit&) const { return false; }
    DEVI void operator()(f32x4 (&acc)[2][2][4][2], const Unit& u, int wr, int wc, int fr, int fq) const {
        const int row0 = u.pm * BM + wr * 64 + fr, col0 = u.pn * BM + wc * 32 + 8 * fq;
        f32x4 sh[2][2];
        if (RS) { const int bi = u.pm * BM < NLAT ? (u.pm * BM) >> 11 : 16;
#pragma unroll
            for (int bj = 0; bj < 2; ++bj) { sh[bj][0] = *(const f32x4*)(shw + (size_t)bi * ldshw + col0 + bj * HALF); sh[bj][1] = *(const f32x4*)(shw + (size_t)bi * ldshw + col0 + bj * HALF + 4); } }
#pragma unroll
        for (int ai = 0; ai < 2; ++ai)
#pragma unroll
            for (int m = 0; m < 4; ++m) { bf16_t* rowp = O + (size_t)(row0 + ai * HALF + m * 16) * ldc + col0;
                float rstd = 1.0f; if (RS) rstd = rsqrtf(ssq[row0 + ai * HALF + m * 16] * (1.0f / 1024.0f) + EPS);
#pragma unroll
                for (int bj = 0; bj < 2; ++bj) { f32x4 v0 = acc[ai][bj][m][0], v1 = acc[ai][bj][m][1];
                    if (RS) { v0 = v0 * rstd + sh[bj][0]; v1 = v1 * rstd + sh[bj][1]; }
                    if (ACT == 1) {
#pragma unroll
                        for (int j = 0; j < 4; ++j) { const float a = fmaxf(v0[j], 0.f), b = fmaxf(v1[j], 0.f); v0[j] = a * a; v1[j] = b * b; } }
                    if (ACT == 2) {
#pragma unroll
                        for (int j = 0; j < 4; ++j) { v0[j] = 1.0f + __expf(-fminf(fmaxf(v0[j], -30.f), 30.f)); v1[j] = 1.0f + __expf(-fminf(fmaxf(v1[j], -30.f), 30.f)); } }
                    u32x4 w; w.x = cvt_pk_bf16(v0[0], v0[1]); w.y = cvt_pk_bf16(v0[2], v0[3]); w.z = cvt_pk_bf16(v1[0], v1[1]); w.w = cvt_pk_bf16(v1[2], v1[3]);
                    *(u32x4*)(rowp + bj * HALF) = w; } }
    }
};
struct EpiMerge {
    static constexpr bool PERM = true;
    const bf16_t* Gt; bf16_t* O;
    DEVI bool keep(const Unit& u) const { return u.pb < 2; }
    DEVI void operator()(f32x4 (&acc)[2][2][4][2], const Unit& u, int wr, int wc, int fr, int fq) const {
        const int row0 = u.pm * BM + wr * 64 + fr, col0 = u.pn * BM + wc * 32 + 8 * fq;
        const bool mid = u.pb < 2;
#pragma unroll
        for (int ai = 0; ai < 2; ++ai) {
            u32x4 ga[4][2], gb[4][2];
#pragma unroll
            for (int m = 0; m < 4; ++m)
#pragma unroll
                for (int bj = 0; bj < 2; ++bj) { const bf16_t* gp = Gt + (size_t)(row0 + ai * HALF + m * 16) * ZGW + u.pb * 1024 + col0 + bj * HALF;
                    ga[m][bj] = *(const u32x4*)gp; gb[m][bj] = mid ? *(const u32x4*)(gp + 1024) : (u32x4){0x3f803f80u, 0x3f803f80u, 0x3f803f80u, 0x3f803f80u}; }
#pragma unroll
            for (int m = 0; m < 4; ++m)
#pragma unroll
                for (int bj = 0; bj < 2; ++bj) {
                    const u32x4 a = ga[m][bj], b = gb[m][bj];
                    float sc[8];
                    sc[0] = bflo(b.x) * __builtin_amdgcn_rcpf(bflo(a.x)); sc[1] = bfhi(b.x) * __builtin_amdgcn_rcpf(bfhi(a.x)); sc[2] = bflo(b.y) * __builtin_amdgcn_rcpf(bflo(a.y)); sc[3] = bfhi(b.y) * __builtin_amdgcn_rcpf(bfhi(a.y));
                    sc[4] = bflo(b.z) * __builtin_amdgcn_rcpf(bflo(a.z)); sc[5] = bfhi(b.z) * __builtin_amdgcn_rcpf(bfhi(a.z)); sc[6] = bflo(b.w) * __builtin_amdgcn_rcpf(bflo(a.w)); sc[7] = bfhi(b.w) * __builtin_amdgcn_rcpf(bfhi(a.w));
                    f32x4 v0 = acc[ai][bj][m][0], v1 = acc[ai][bj][m][1];
#pragma unroll
                    for (int j = 0; j < 4; ++j) { v0[j] *= sc[j]; v1[j] *= sc[4 + j]; }
                    if (mid) { acc[ai][bj][m][0] = v0; acc[ai][bj][m][1] = v1; }
                    else { u32x4 w; w.x = cvt_pk_bf16(v0[0], v0[1]); w.y = cvt_pk_bf16(v0[2], v0[3]); w.z = cvt_pk_bf16(v1[0], v1[1]); w.w = cvt_pk_bf16(v1[2], v1[3]);
                        *(u32x4*)(O + (size_t)(row0 + ai * HALF + m * 16) * DM + col0 + bj * HALF) = w; }
                }
        }
    }
};
struct EpiRes {
    static constexpr bool PERM = false;
    Params p; int l, goff;
    int in_is_stream;
    int emit;
    DEVI bool keep(const Unit&) const { return false; }
    DEVI void operator()(f32x4 (&acc)[2][2][4][2], const Unit& u, int wr, int wc, int fr, int fq) const {
        const int row0 = u.pm * BM + wr * 64 + fr, col0 = u.pn * BM + wc * 32 + 4 * fq;
        const float* gr = modrow(p, l, u.pm * BM) + goff + col0;
        f32x4 gv[2][2];
#pragma unroll
        for (int bj = 0; bj < 2; ++bj)
#pragma unroll
            for (int n = 0; n < 2; ++n) gv[bj][n] = *(const f32x4*)(gr + bj * HALF + n * 16);
        f32x4 av[2][2];
        if (emit) { const int bi = u.pm * BM < NLAT ? (u.pm * BM) >> 11 : 16; const float* ar = (const float*)(p.ws + OFF_A2) + (size_t)(l * 17 + bi) * 1024 + col0;
#pragma unroll
            for (int bj = 0; bj < 2; ++bj)
#pragma unroll
                for (int n = 0; n < 2; ++n) av[bj][n] = *(const f32x4*)(ar + bj * HALF + n * 16); }
#pragma unroll
        for (int am = 0; am < 4; ++am) {
            const int ai = am >> 1, mb = (am & 1) * 2;
            f32x4 xv[2][2][2];
#pragma unroll
            for (int mm = 0; mm < 2; ++mm) { const int r = row0 + ai * HALF + (mb + mm) * 16;
                const float* xi = (in_is_stream ? (const float*)xrow_out(p, r) : xrow_in(p, l, r)) + col0;
#pragma unroll
                for (int bj = 0; bj < 2; ++bj)
#pragma unroll
                    for (int n = 0; n < 2; ++n) xv[mm][bj][n] = *(const f32x4*)(xi + bj * HALF + n * 16); }
#pragma unroll
            for (int mm = 0; mm < 2; ++mm) { const int m = mb + mm; const int r = row0 + ai * HALF + m * 16; float* xo = xrow_out(p, r) + col0;
                float ssp = 0.f;
#pragma unroll
                for (int bj = 0; bj < 2; ++bj)
#pragma unroll
                    for (int n = 0; n < 2; ++n) { const f32x4 xn = xv[mm][bj][n] + gv[bj][n] * acc[ai][bj][m][n]; *(f32x4*)(xo + bj * HALF + n * 16) = xn;
                        if (emit) { ssp += xn[0] * xn[0] + xn[1] * xn[1] + xn[2] * xn[2] + xn[3] * xn[3];
                            const f32x4 ua = xn * av[bj][n]; u32x2 w; w.x = cvt_pk_bf16(ua[0], ua[1]); w.y = cvt_pk_bf16(ua[2], ua[3]);
                            *(u32x2*)((bf16_t*)(p.ws + OFF_U2) + (size_t)r * DM + col0 + bj * HALF + n * 16) = w; } }
                if (emit) { ssp += __shfl_xor(ssp, 16); ssp += __shfl_xor(ssp, 32); if (fq == 0) atomicAdd((float*)(p.ws + OFF_SSQ2) + (size_t)l * RT_ + r, ssp); } }
        }
    }
};

template <class Epi>
DEVI void gemm_phase(const int wv, LAS unsigned char* lds, const Gemm g, const Order& S, const Epi& E) {
    const int tid = opaque_tid(wv), wid = wv, lane = tid & 63, wr = wid >> 2, wc = wid & 3, fr = lane & 15, fq = lane >> 4;
    const int K = g.K, nt = K / BK;
    unsigned voffA[2], voffB[2];
#pragma unroll
    for (int i = 0; i < 2; ++i) { int R, C; stage_rc(tid * 16 + i * 8192, R, C); const int Rb = Epi::PERM ? ((R & ~31) + perm32(R & 31)) : R;
        voffA[i] = (unsigned)(R * g.lda + C) * 2u; voffB[i] = (unsigned)(Rb * g.ldb + C) * 2u; }
    const size_t kstep = (size_t)(BK * 2);
    const size_t hstepA = (size_t)HALF * g.lda * 2, hstepB = (size_t)HALF * g.ldb * 2;
    const size_t tstepA = 2 * hstepA, tstepB = 2 * hstepB;
    const unsigned ldsw = (unsigned)wid * 1024u;
    const int aoff = lds_byte(wr * 64 + fr, fq * 8), boff = lds_byte(wc * 32 + fr, fq * 8);
#define PG8_SA(b, h) (((b) * 2 + (h)) * HTB)
#define PG8_SB(b, h) ((4 + (b) * 2 + (h)) * HTB)
#define PG8_STAGE(bufoff, gbase, voff) do { _Pragma("unroll") for (int _i = 0; _i < 2; ++_i) \
        __builtin_amdgcn_global_load_lds((const unsigned*)((const char*)(gbase) + (voff)[_i]), (LAS unsigned*)(lds + (bufoff) + ldsw + _i * 8192), 16, 0, 0); } while (0)
#define PG8_LDA(dst, b, h) do { _Pragma("unroll") for (int m = 0; m < 4; ++m) _Pragma("unroll") for (int k = 0; k < 2; ++k) dst[m][k] = *(const LAS bf16x8*)(lds + PG8_SA(b, h) + aoff + m * 2048 + k * 1024); } while (0)
#define PG8_LDB(dst, b, h) do { _Pragma("unroll") for (int n = 0; n < 2; ++n) _Pragma("unroll") for (int k = 0; k < 2; ++k) dst[n][k] = *(const LAS bf16x8*)(lds + PG8_SB(b, h) + boff + n * 2048 + k * 1024); } while (0)
#define PG8_MMA(ai, bj, At, Bt) do { __builtin_amdgcn_s_setprio(1); _Pragma("unroll") for (int m = 0; m < 4; ++m) _Pragma("unroll") for (int n = 0; n < 2; ++n) _Pragma("unroll") for (int k = 0; k < 2; ++k) \
        acc[ai][bj][m][n] = __builtin_amdgcn_mfma_f32_16x16x32_bf16(Bt[n][k], At[m][k], acc[ai][bj][m][n], 0, 0, 0); __builtin_amdgcn_s_setprio(0); } while (0)
#define PG8_WAIT_V(n) asm volatile("s_waitcnt vmcnt(" #n ")" ::: "memory")
#define PG8_WAIT_L(n) asm volatile("s_waitcnt lgkmcnt(" #n ")" ::: "memory")
#define PG8_BAR __builtin_amdgcn_s_barrier()
#define PG8_SCHED __builtin_amdgcn_sched_barrier(0)
    Unit cur, nxt; int ui = 0;
    if (!S.next(0, cur)) return;
    f32x4 acc[2][2][4][2];
#pragma unroll
    for (int a = 0; a < 2; ++a)
#pragma unroll
        for (int b = 0; b < 2; ++b)
#pragma unroll
            for (int m = 0; m < 4; ++m)
#pragma unroll
                for (int n = 0; n < 2; ++n) acc[a][b][m][n] = (f32x4){0.f, 0.f, 0.f, 0.f};
    bf16x8 At[4][2], B0[2][2], B1[2][2];
    const char* cA = (const char*)g.A + (size_t)cur.pb * g.a_bs + (size_t)cur.pm * tstepA; const char* cB = (const char*)g.Bt + (size_t)cur.pb * g.b_bs + (size_t)cur.pn * tstepB;
    PG8_STAGE(PG8_SB(0, 0), cB, voffB); PG8_STAGE(PG8_SA(0, 0), cA, voffA); PG8_STAGE(PG8_SB(0, 1), cB + hstepB, voffB); PG8_STAGE(PG8_SA(0, 1), cA + hstepA, voffA);
    if (wr == 1) PG8_BAR;
    PG8_WAIT_V(4); PG8_BAR;
    PG8_STAGE(PG8_SB(1, 0), cB + kstep, voffB); PG8_STAGE(PG8_SA(1, 0), cA + kstep, voffA); PG8_STAGE(PG8_SB(1, 1), cB + hstepB + kstep, voffB);
    PG8_WAIT_V(6); PG8_BAR;
    for (;;) {
        const bool has_next = S.next(ui + 1, nxt);
        const char* nA = has_next ? (const char*)g.A + (size_t)nxt.pb * g.a_bs + (size_t)nxt.pm * tstepA : cA;
        const char* nB = has_next ? (const char*)g.Bt + (size_t)nxt.pb * g.b_bs + (size_t)nxt.pn * tstepB : cB;
        for (int t = 0; t < nt; t += 2) {
            const bool last = (t == nt - 2);
            const char* a1 = cA + (size_t)(t + 1) * kstep;
            const char* a2 = last ? nA : cA + (size_t)(t + 2) * kstep; const char* b2 = last ? nB : cB + (size_t)(t + 2) * kstep;
            const char* a3 = a2 + kstep; const char* b3 = b2 + kstep;
            PG8_LDB(B0, 0, 0); PG8_SCHED; PG8_LDA(At, 0, 0); PG8_STAGE(PG8_SA(1, 1), a1 + hstepA, voffA);
            PG8_WAIT_L(8); PG8_BAR; PG8_WAIT_L(0); PG8_MMA(0, 0, At, B0); PG8_BAR; PG8_SCHED;
            PG8_LDB(B1, 0, 1); PG8_STAGE(PG8_SB(0, 0), b2, voffB);
            PG8_BAR; PG8_WAIT_L(0); PG8_MMA(0, 1, At, B1); PG8_BAR;
            PG8_LDA(At, 0, 1); PG8_STAGE(PG8_SA(0, 0), a2, voffA);
            PG8_BAR; PG8_WAIT_L(0); PG8_MMA(1, 0, At, B0); PG8_BAR; PG8_SCHED;
            PG8_STAGE(PG8_SB(0, 1), b2 + hstepB, voffB);
            PG8_WAIT_V(6); PG8_BAR; PG8_MMA(1, 1, At, B1); PG8_BAR;
            PG8_LDB(B0, 1, 0); PG8_SCHED; PG8_LDA(At, 1, 0); PG8_STAGE(PG8_SA(0, 1), a2 + hstepA, voffA);
            PG8_WAIT_L(8); PG8_BAR; PG8_WAIT_L(0); PG8_MMA(0, 0, At, B0); PG8_BAR; PG8_SCHED;
            PG8_LDB(B1, 1, 1); PG8_STAGE(PG8_SB(1, 0), b3, voffB);
            PG8_BAR; PG8_WAIT_L(0); PG8_MMA(0, 1, At, B1); PG8_BAR;
            PG8_LDA(At, 1, 1); PG8_STAGE(PG8_SA(1, 0), a3, voffA);
            PG8_BAR; PG8_WAIT_L(0); PG8_MMA(1, 0, At, B0); PG8_BAR; PG8_SCHED;
            PG8_STAGE(PG8_SB(1, 1), b3 + hstepB, voffB);
            PG8_WAIT_V(6); PG8_BAR; PG8_MMA(1, 1, At, B1); PG8_BAR;
        }
        E(acc, cur, wr, wc, fr, fq);
        if (!E.keep(cur)) {
#pragma unroll
            for (int a = 0; a < 2; ++a)
#pragma unroll
                for (int b = 0; b < 2; ++b)
#pragma unroll
                    for (int m = 0; m < 4; ++m)
#pragma unroll
                        for (int n = 0; n < 2; ++n) acc[a][b][m][n] = (f32x4){0.f, 0.f, 0.f, 0.f};
        }
        if (!has_next) break;
        cur = nxt; cA = nA; cB = nB; ++ui;
    }
    PG8_WAIT_V(0);
    if (wr == 0) PG8_BAR;
    PG8_BAR;
#undef PG8_SA
#undef PG8_SB
#undef PG8_STAGE
#undef PG8_LDA
#undef PG8_LDB
#undef PG8_MMA
#undef PG8_WAIT_V
#undef PG8_WAIT_L
#undef PG8_BAR
#undef PG8_SCHED
}
}

#define XB_TMO      128
#define XB_XCNT(j)  (256  + 64 * (j))
#define XB_XSUB(j)  (1280 + 64 * (j))
#define XB_XGEN(j)  (2304 + 64 * (j))
#define XB_TOP      3328
#define XB_TOPGEN   3392
#define XCD_BAR_WORDS 3456
#define XB_SPIN_CAP (1u << 22)
DEVI unsigned xb_ld(unsigned* p)              { return __hip_atomic_load(p, __ATOMIC_RELAXED, __HIP_MEMORY_SCOPE_AGENT); }
DEVI unsigned xb_add(unsigned* p, unsigned v) { return __hip_atomic_fetch_add(p, v, __ATOMIC_RELAXED, __HIP_MEMORY_SCOPE_AGENT); }
DEVI unsigned xb_xcc_id() { return (unsigned)__builtin_amdgcn_s_getreg((3 << 11) | 20) & 0xFu; }
#define XB_SPIN(cond, bar) do { unsigned _sp = 0; while (cond) { __builtin_amdgcn_s_sleep(1); \
    if ((++_sp & 255u) == 0u) { if (xb_ld(&(bar)[XB_TMO])) break; if (_sp > XB_SPIN_CAP) { atomicAdd(&(bar)[XB_TMO], 1u); break; } } } } while (0)
struct XcdBarrier { unsigned* bar; unsigned x; volatile LAS unsigned* st; };
DEVI void xcd_barrier_complete(unsigned* bar, unsigned x, unsigned& nloc, unsigned& nx) {
    const unsigned G = gridDim.x;
    unsigned sum, cnt, mine, sp = 0u;
    for (;;) {
        sum = 0u; cnt = 0u; mine = 0u;
#pragma unroll
        for (unsigned j = 0; j < 16; ++j) { const unsigned c = xb_ld(&bar[XB_XCNT(j)]); sum += c; cnt += (c > 0u) ? 1u : 0u; mine = (j == x) ? c : mine; }
        if (sum == G) break;
        __builtin_amdgcn_s_sleep(1);
        if ((++sp & 255u) == 0u) { if (xb_ld(&bar[XB_TMO])) break; if (sp > XB_SPIN_CAP) { atomicAdd(&bar[XB_TMO], 1u); break; } }
    }
    nloc = mine > 0u ? mine : 1u; nx = cnt > 0u ? cnt : 1u;
}
DEVI void xcd_barrier(const XcdBarrier& b, const int wv) {
    asm volatile("s_waitcnt vmcnt(0)" ::: "memory");
    __syncthreads();
    if (opaque_tid(wv) == 0) {
        unsigned* bar = b.bar;
        __builtin_amdgcn_s_waitcnt(0);
        unsigned nloc = b.st[0], nx = b.st[1];
        if (nloc == 0u) { xcd_barrier_complete(bar, b.x, nloc, nx); b.st[0] = nloc; b.st[1] = nx; }
        const unsigned old = xb_add(&bar[XB_XSUB(b.x)], 1u);
        const unsigned gen = old / nloc;
        if (old + 1u == (gen + 1u) * nloc) {
            __builtin_amdgcn_fence(__ATOMIC_RELEASE, "agent");
            asm volatile("s_waitcnt vmcnt(0)" ::: "memory");
            const unsigned og = xb_add(&bar[XB_TOP], 1u);
            const unsigned tg = og / nx;
            if (og + 1u == (tg + 1u) * nx) xb_add(&bar[XB_TOPGEN], 1u);
            else XB_SPIN(xb_ld(&bar[XB_TOPGEN]) == tg, bar);
            __builtin_amdgcn_fence(__ATOMIC_ACQUIRE, "agent");
            xb_add(&bar[XB_XGEN(b.x)], 1u);
            asm volatile("s_waitcnt vmcnt(0)" ::: "memory");
        } else {
            XB_SPIN(xb_ld(&bar[XB_XGEN(b.x)]) == gen, bar);
            __builtin_amdgcn_fence(__ATOMIC_ACQUIRE, "agent");
            asm volatile("s_waitcnt vmcnt(0)" ::: "memory");
        }
    }
    __syncthreads();
}

DEVI void ph_setup(const int wv, const Params& p, unsigned char* lds) {
    const int tid = opaque_tid(wv);
    for (int e = blockIdx.x * NTHREADS + tid; e < 2 * RT_; e += gridDim.x * NTHREADS) ((float*)(p.ws + OFF_SSQ2))[e] = 0.f;
    float* scv = (float*)lds;
    float* red = scv + 17 * 1024;
    for (int it = blockIdx.x; it < 192 + 130; it += gridDim.x) {
        if (it < 192) {
            const int l = it / 96, n0 = (it % 96) * 64;
            for (int e = tid; e < 17 * 1024; e += NTHREADS) { const int r = e >> 10, k = e & 1023; const float v = r < 16 ? p.in[1][r * 1024 + k] : p.in[3][k]; scv[e] = v / (1.0f + expf(-v)); }
            __syncthreads();
            const int n = tid & 63, kg = tid >> 6;
            float acc[17];
#pragma unroll
            for (int r = 0; r < 17; ++r) acc[r] = 0.f;
            const float* w = p.in[6] + (size_t)l * 1024 * 6144 + n0 + n;
            for (int k = kg * 128; k < kg * 128 + 128; ++k) { const float wv = w[(size_t)k * 6144];
#pragma unroll
                for (int r = 0; r < 17; ++r) acc[r] += scv[r * 1024 + k] * wv; }
#pragma unroll
            for (int r = 0; r < 17; ++r) red[(kg * 17 + r) * 64 + n] = acc[r];
            __syncthreads();
            float* mod = (float*)(p.ws + OFF_MOD);
            for (int e = tid; e < 17 * 64; e += NTHREADS) { const int r = e >> 6, nn = e & 63; float s = 0.f;
#pragma unroll
                for (int q = 0; q < 8; ++q) s += red[(q * 17 + r) * 64 + nn];
                mod[(size_t)(l * 17 + r) * 6144 + n0 + nn] = s + p.in[7][l * 6144 + n0 + nn]; }
            __syncthreads();
        } else {
            const int e = (it - 192) * NTHREADS + tid;
            if (e < 65536) { const int pos = e >> 5, i = e & 31; const float fr = powf(10000.0f, -(float)i / 32.0f); const float ang = (float)pos * fr;
                const double tr = (double)ang * 0.15915494309189535; const float tf = (float)(tr - floor(tr));
                ((float2*)(p.ws + OFF_RT))[e] = make_float2(__builtin_amdgcn_cosf(tf), __builtin_amdgcn_sinf(tf)); }
            else { const int e2 = e - 65536; const int pos = e2 >> 4, i = e2 & 15; const float fr = powf(10000.0f, -(float)i / 16.0f); const float ang = (float)pos * fr;
                const double tr = (double)ang * 0.15915494309189535; const float tf = (float)(tr - floor(tr));
                ((float2*)(p.ws + OFF_AT))[e2] = make_float2(__builtin_amdgcn_cosf(tf), __builtin_amdgcn_sinf(tf)); }
        }
    }
}

DEVI void ph_shw(const int wv, const Params& p, int l, unsigned char* lds, int blk_lo) {
    const int tid = opaque_tid(wv);
    if ((int)blockIdx.x < blk_lo) return;
    const int bx = blockIdx.x - blk_lo, nbx = gridDim.x - blk_lo;
    float* shv = (float*)lds;
    float* red = shv + 17 * 1024;
    const float* mod = (const float*)(p.ws + OFF_MOD) + (size_t)l * 17 * 6144;
    for (int e = bx * NTHREADS + tid; e < 17 * 1024; e += nbx * NTHREADS) { const int r = e >> 10, k = e & 1023;
        ((float*)(p.ws + OFF_A2))[(size_t)l * 17 * 1024 + e] = p.in[5][l * 1024 + k] * (1.0f + mod[(size_t)r * 6144 + 4096 + k]); }
    for (int it = bx; it < 256; it += nbx) {
        const int n0 = it * 16;
        __syncthreads();
        for (int e = tid; e < 17 * 1024; e += NTHREADS) { const int r = e >> 10, k = e & 1023; shv[e] = mod[(size_t)r * 6144 + 3072 + k]; }
        __syncthreads();
        const int n = tid & 15, kg = tid >> 4;
        float acc[17];
#pragma unroll
        for (int r = 0; r < 17; ++r) acc[r] = 0.f;
        const float* w = p.in[19] + (size_t)l * 1024 * 4096 + n0 + n;
#pragma unroll 8
        for (int k = kg * 32; k < kg * 32 + 32; ++k) { const float wvv = w[(size_t)k * 4096];
#pragma unroll
            for (int r = 0; r < 17; ++r) acc[r] += shv[r * 1024 + k] * wvv; }
#pragma unroll
        for (int r = 0; r < 17; ++r) red[(kg * 17 + r) * 16 + n] = acc[r];
        __syncthreads();
        for (int e = tid; e < 17 * 16; e += NTHREADS) { const int r = e >> 4, nn = e & 15; float sacc = 0.f;
#pragma unroll
            for (int q = 0; q < 32; ++q) sacc += red[(q * 17 + r) * 16 + nn];
            ((float*)(p.ws + OFF_SHW2))[(size_t)(l * 17 + r) * 4096 + n0 + nn] = sacc; }
    }
    __syncthreads();
}

DEVI void ph_convert(const int wv, const Params& p, int l, unsigned char* lds, int mode  , int blk_lo) {
    const int tid = opaque_tid(wv);
    float* tile = (float*)lds;
    bf16_t* WB = (bf16_t*)(p.ws + OFF_WB);
    if ((int)blockIdx.x < blk_lo) return;
    const int nitems = mode == 0 ? 4032 + 64 : (mode == 1 ? 3008 + 64 : (mode == 2 ? 1024 : (mode == 3 ? 1984 + 64 : 2048)));
    for (int j = blockIdx.x - blk_lo; j < nitems; j += gridDim.x - blk_lo) {
        const int it = mode == 0 ? j : (mode == 1 ? (j < 3008 ? j : j + 1024) : (mode == 2 ? j + 3008 : (mode == 3 ? (j < 1984 ? j : j + 2048) : j + 1984)));
        if (it < 4032) {
            const float* src; bf16_t* dst; int K, N, t;
            if (it < 1472) { t = it; src = p.in[8] + (size_t)l * 1024 * INC; dst = WB + W_IN; K = 1024; N = INC; }
            else if (it < 1600) { t = it - 1472; src = p.in[15] + (size_t)l * 512 * 1024; dst = WB + W_BR; K = 512; N = 1024; }
            else if (it < 1728) { t = it - 1600; src = p.in[17] + (size_t)l * 512 * 1024; dst = WB + W_BR + 2 * 512 * 1024; K = 512; N = 1024; }
            else if (it < 1984) { t = it - 1728; src = p.in[18] + (size_t)l * 1024 * 1024; dst = WB + W_O; K = 1024; N = 1024; }
            else if (it < 3008) { t = it - 1984; src = p.in[19] + (size_t)l * 1024 * 4096; dst = WB + W_1; K = 1024; N = 4096; }
            else { t = it - 3008; src = p.in[20] + (size_t)l * 4096 * 1024; dst = WB + W_2; K = 4096; N = 1024; }
            const int nkt = K / 64, k0 = (t % nkt) * 64, n0 = (t / nkt) * 64;
            for (int e = tid; e < 4096; e += NTHREADS) { const int kk = e >> 6, nn = e & 63; tile[kk * 65 + nn] = src[(size_t)(k0 + kk) * N + n0 + nn]; }
            __syncthreads();
            for (int e = tid; e < 4096; e += NTHREADS) { const int nn = e >> 6, kk = e & 63; dst[(size_t)(n0 + nn) * K + k0 + kk] = f2bf(tile[kk * 65 + nn]); }
            __syncthreads();
        } else {
            const int pi = it - 4032, g = pi >> 4, n0 = (pi & 15) * 64;
            const int n = tid & 63, ig = tid >> 6;
            const float* pw = p.in[10] + (size_t)l * 4 * 128 * 128 + (size_t)g * 128 * 128 + (size_t)(ig * 16) * 128;
            const float* ps = p.in[11] + l * 512 + g * 128;
            const float* wpo = p.in[16] + (size_t)l * 512 * 1024 + (size_t)(g * 128) * 1024 + n0 + n;
            float acc[16];
#pragma unroll
            for (int ii = 0; ii < 16; ++ii) acc[ii] = 0.f;
            for (int j = 0; j < 128; ++j) { const float wv = ps[j] * wpo[(size_t)j * 1024];
#pragma unroll
                for (int ii = 0; ii < 16; ++ii) acc[ii] += pw[ii * 128 + j] * wv; }
            bf16_t* dst = WB + W_BR + 512 * 1024 + (size_t)(n0 + n) * 512 + g * 128 + ig * 16;
            u32x4 w0, w1;
            w0.x = cvt_pk_bf16(acc[0], acc[1]); w0.y = cvt_pk_bf16(acc[2], acc[3]); w0.z = cvt_pk_bf16(acc[4], acc[5]); w0.w = cvt_pk_bf16(acc[6], acc[7]);
            w1.x = cvt_pk_bf16(acc[8], acc[9]); w1.y = cvt_pk_bf16(acc[10], acc[11]); w1.z = cvt_pk_bf16(acc[12], acc[13]); w1.w = cvt_pk_bf16(acc[14], acc[15]);
            *(u32x4*)dst = w0; *(u32x4*)(dst + 8) = w1;
        }
    }
}

DEVI void ph_norm(const int wv, const Params& p, int l, int which  , int nrows) {
    const int tid = opaque_tid(wv); const int lane = tid & 63, wave = wv;
    const float* nw = p.in[which ? 5 : 4] + l * 1024;
    const int shoff = which ? 3072 : 0, scoff = which ? 4096 : 1024;
    bf16_t* U = (bf16_t*)(p.ws + OFF_UB);
    const int stride = gridDim.x * 8;
    for (int row0 = blockIdx.x * 8 + wave; row0 < nrows; row0 += 2 * stride) {
        f32x4 v[2][4]; float ss[2];
#pragma unroll
        for (int q = 0; q < 2; ++q) { const int row = row0 + q * stride; ss[q] = 0.f;
            if (row < nrows) { const float* x = which ? (const float*)xrow_out(p, row) : xrow_in(p, l, row);
#pragma unroll
                for (int i = 0; i < 4; ++i) v[q][i] = *(const f32x4*)(x + i * 256 + lane * 4); }
            else {
#pragma unroll
                for (int i = 0; i < 4; ++i) v[q][i] = (f32x4){0.f, 0.f, 0.f, 0.f}; } }
#pragma unroll
        for (int q = 0; q < 2; ++q) {
#pragma unroll
            for (int i = 0; i < 4; ++i) ss[q] += v[q][i][0] * v[q][i][0] + v[q][i][1] * v[q][i][1] + v[q][i][2] * v[q][i][2] + v[q][i][3] * v[q][i][3];
            ss[q] = wsum(ss[q]); }
#pragma unroll
        for (int q = 0; q < 2; ++q) { const int row = row0 + q * stride;
            if (row < nrows) { const float* md = modrow(p, l, row); const float rstd = rsqrtf(ss[q] * (1.0f / 1024.0f) + EPS);
#pragma unroll
                for (int i = 0; i < 4; ++i) { const int c = i * 256 + lane * 4;
                    const f32x4 w = *(const f32x4*)(nw + c), sc = *(const f32x4*)(md + scoff + c), sh = *(const f32x4*)(md + shoff + c);
                    const f32x4 o = v[q][i] * rstd * w * (1.0f + sc) + sh;
                    u32x2 pk; pk.x = cvt_pk_bf16(o[0], o[1]); pk.y = cvt_pk_bf16(o[2], o[3]);
                    *(u32x2*)(U + (size_t)row * 1024 + c) = pk; } } }
    }
}

DEVI void unpack8(const u32x4 w, float (&v)[8]) { v[0] = bflo(w.x); v[1] = bfhi(w.x); v[2] = bflo(w.y); v[3] = bfhi(w.y); v[4] = bflo(w.z); v[5] = bfhi(w.z); v[6] = bflo(w.w); v[7] = bfhi(w.w); }
DEVI void ph_prep(const int wv, const Params& p, int l, int nrows_pool, unsigned char* lds_raw) {
    const int tid = opaque_tid(wv); const int lane = tid & 63;
    bf16_t* Z = (bf16_t*)(p.ws + OFF_ZG); bf16_t* YB = (bf16_t*)(p.ws + OFF_YB);
    const float* RTf = (const float*)(p.ws + OFF_RT); const float* ATf = (const float*)(p.ws + OFF_AT);
    const int sub = lane & 7, hslot = lane >> 3, d0 = sub * 8;
    constexpr int NINST = RT_ * 6;
    for (int base = (blockIdx.x * 8 + wv) * 32; base < NINST; base += gridDim.x * 8 * 32) {
        u32x4 w[4]; int rowv[4], hhv[4], colv[4];
#pragma unroll
        for (int u = 0; u < 4; ++u) { const int hi = base + u * 8 + hslot; const int row = hi / 6, h6 = hi - row * 6, hh = h6 < 4 ? h6 : h6 + 4; rowv[u] = row; hhv[u] = hh;
            colv[u] = (hh < 4 ? C_RK + hh * 64 : hh < 8 ? C_RQ + (hh - 4) * 64 : hh < 10 ? C_AK + (hh - 8) * 64 : C_AQ + (hh - 10) * 64) + d0;
            w[u] = *(const u32x4*)(Z + (size_t)row * ZM + colv[u]); }
#pragma unroll
        for (int u = 0; u < 4; ++u) {
            const int row = rowv[u], hh = hhv[u]; const bool lat = row < NLAT; const int pos = row & 2047;
            float v[8]; unpack8(w[u], v);
            if (hh >= 8) {
                float ss = 0.f;
#pragma unroll
                for (int e = 0; e < 8; ++e) ss += v[e] * v[e];
                ss += __shfl_xor(ss, 1); ss += __shfl_xor(ss, 2); ss += __shfl_xor(ss, 4);
                const float rstd = rsqrtf(ss * (1.0f / 64.0f) + EPS) * (hh >= 10 ? 0.125f * 1.4426950408889634f : 1.0f);
                const float* wp = p.in[hh < 10 ? 13 : 12] + l * 64 + d0;
                const f32x4 w0 = *(const f32x4*)wp, w1 = *(const f32x4*)(wp + 4);
#pragma unroll
                for (int e = 0; e < 4; ++e) { v[e] *= rstd * w0[e]; v[4 + e] *= rstd * w1[e]; }
                if (lat) { const int pp = (sub & 4) ? (pos & 63) : (pos >> 6); const float* cp = ATf + (size_t)(pp * 16 + (d0 & 15)) * 2; const bool up = (sub & 2) != 0;
#pragma unroll
                    for (int e = 0; e < 8; ++e) { const float o = __shfl_xor(v[e], 2); const float cc = cp[2 * e], sn = cp[2 * e + 1]; v[e] = up ? o * sn + v[e] * cc : v[e] * cc - o * sn; } }
            } else {
                if (lat) { const float* cp = RTf + (size_t)(pos * 32 + (d0 & 31)) * 2; const bool up = (sub & 4) != 0;
#pragma unroll
                    for (int e = 0; e < 8; ++e) { const float o = __shfl_xor(v[e], 4); const float cc = cp[2 * e], sn = cp[2 * e + 1]; v[e] = up ? o * sn + v[e] * cc : v[e] * cc - o * sn; } }
                if (hh < 4) {
#pragma unroll
                    for (int e = 0; e < 8; ++e) v[e] *= 0.125f; }
            }
            u32x4 o; o.x = cvt_pk_bf16(v[0], v[1]); o.y = cvt_pk_bf16(v[2], v[3]); o.z = cvt_pk_bf16(v[4], v[5]); o.w = cvt_pk_bf16(v[6], v[7]);
            *(u32x4*)(Z + (size_t)row * ZM + colv[u]) = o;
        }
    }
    LAS unsigned char* slab = (LAS unsigned char*)lds_raw;
    for (int it = blockIdx.x; it < nrows_pool / 64; it += gridDim.x) {
        const int r0 = it * 64; int sbase, L;
        if (r0 < NLAT) { sbase = r0 & ~2047; L = 2048; } else { sbase = NLAT + ((r0 - NLAT) & ~255); L = 256; }
        const int t0 = r0 - sbase, lo_row = max(t0 - 8, 0), hi_row = min(t0 + 72, L), nchunks = (hi_row - lo_row) * 64;
        __syncthreads();
        for (int e = tid; e < nchunks; e += NTHREADS) { const int rr = e >> 6, cch = e & 63; *(LAS u32x4*)(slab + rr * 1024 + cch * 16) = *(const u32x4*)(Z + (size_t)(sbase + lo_row + rr) * ZM + C_PU + cch * 8); }
        __syncthreads();
#pragma unroll 2
        for (int o = tid; o < 4096; o += NTHREADS) {
            const int rr = o >> 6, cch = o & 63, hw = 1 << (cch >> 4), t = t0 + rr, lo = max(t - hw, 0), hi = min(t + hw, L);
            float sacc[8];
#pragma unroll
            for (int j = 0; j < 8; ++j) sacc[j] = 0.f;
            for (int tt = lo; tt < hi; ++tt) { float v[8]; unpack8(*(const LAS u32x4*)(slab + (tt - lo_row) * 1024 + cch * 16), v);
#pragma unroll
                for (int j = 0; j < 8; ++j) sacc[j] += v[j]; }
            float own[8]; unpack8(*(const LAS u32x4*)(slab + (t - lo_row) * 1024 + cch * 16), own);
            const float inv = 1.0f / (float)(hi - lo);
            u32x4 ow; ow.x = cvt_pk_bf16(sacc[0] * inv - own[0], sacc[1] * inv - own[1]); ow.y = cvt_pk_bf16(sacc[2] * inv - own[2], sacc[3] * inv - own[3]);
            ow.z = cvt_pk_bf16(sacc[4] * inv - own[4], sacc[5] * inv - own[5]); ow.w = cvt_pk_bf16(sacc[6] * inv - own[6], sacc[7] * inv - own[7]);
            *(u32x4*)(YB + (size_t)(sbase + t) * 1536 + 512 + cch * 8) = ow;
        }
    }
    __syncthreads();
}

#define MFMA16(X, Y, ACC) __builtin_amdgcn_mfma_f32_16x16x32_bf16((X), (Y), (ACC), 0, 0, 0)
DEVI bf16x8 mk_frag(unsigned a, unsigned b, unsigned c, unsigned d) { u32x4 w; w.x = a; w.y = b; w.z = c; w.w = d; return __builtin_bit_cast(bf16x8, w); }
typedef short s16x4 __attribute__((ext_vector_type(4)));
DEVI bf16x8 tr_frag(LAS unsigned char* tile, int rs, int rowA, int rowB, int n0, int fr) {
    const s16x4 a = __builtin_amdgcn_ds_read_tr16_b64_v4i16((LAS s16x4*)(tile + (rowA + (fr >> 2)) * rs + n0 * 2 + 8 * (fr & 3)));
    const s16x4 b = __builtin_amdgcn_ds_read_tr16_b64_v4i16((LAS s16x4*)(tile + (rowB + (fr >> 2)) * rs + n0 * 2 + 8 * (fr & 3)));
    return __builtin_shufflevector(a, b, 0, 1, 2, 3, 4, 5, 6, 7);
}
DEVI void lds_put8_t(LAS unsigned char* base, int rowstride, int r0, int j, const u32x4 w) {
    *(LAS unsigned short*)(base + (r0 + 0) * rowstride + 2 * j) = (unsigned short)(w.x & 0xffffu); *(LAS unsigned short*)(base + (r0 + 1) * rowstride + 2 * j) = (unsigned short)(w.x >> 16);
    *(LAS unsigned short*)(base + (r0 + 2) * rowstride + 2 * j) = (unsigned short)(w.y & 0xffffu); *(LAS unsigned short*)(base + (r0 + 3) * rowstride + 2 * j) = (unsigned short)(w.y >> 16);
    *(LAS unsigned short*)(base + (r0 + 4) * rowstride + 2 * j) = (unsigned short)(w.z & 0xffffu); *(LAS unsigned short*)(base + (r0 + 5) * rowstride + 2 * j) = (unsigned short)(w.z >> 16);
    *(LAS unsigned short*)(base + (r0 + 6) * rowstride + 2 * j) = (unsigned short)(w.w & 0xffffu); *(LAS unsigned short*)(base + (r0 + 7) * rowstride + 2 * j) = (unsigned short)(w.w >> 16);
}

DEVI void ph_attn(const int wv, const Params& p, int l, unsigned char* lds_raw, int it_lo = 0) {
    const int tid = opaque_tid(wv), lane = tid & 63, wave = wv, fr = lane & 15, fq = lane >> 4;
    LAS unsigned char* Kl0 = (LAS unsigned char*)lds_raw;
    const bf16_t* Z = (const bf16_t*)(p.ws + OFF_ZG); bf16_t* YB = (bf16_t*)(p.ws + OFF_YB);
    const int nitems = 1024 + (l == 0 ? 128 : 0);
    for (int it = blockIdx.x + it_lo; it < nitems; it += gridDim.x) {
        int b, n, kvh, hp, qrow0; const bool isl = it < 1024;
        if (isl) { b = it >> 6; n = (it >> 2) & 15; kvh = (it >> 1) & 1; hp = it & 1; qrow0 = b * 2048 + n * 128; }
        else { const int i2 = it - 1024; b = i2 >> 3; n = (i2 >> 2) & 1; kvh = (i2 >> 1) & 1; hp = i2 & 1; qrow0 = NLAT + b * 256 + n * 128; }
        const int hq0 = kvh * 4 + hp * 2;
        const int ii = wave * 16 + fr;
        bf16x8 Qf[2][2];
#pragma unroll
        for (int g = 0; g < 2; ++g)
#pragma unroll
            for (int ks = 0; ks < 2; ++ks) Qf[g][ks] = *(const bf16x8*)(Z + (size_t)(qrow0 + ii) * ZM + C_AQ + (hq0 + g) * 64 + ks * 32 + fq * 8);
        {
            const int qpos = (qrow0 + ii) & 2047; const bool up = (fq & 2) != 0;
            float ssq[2]; float qv[2][2][8];
#pragma unroll
            for (int g = 0; g < 2; ++g) { ssq[g] = 0.f;
#pragma unroll
                for (int ks = 0; ks < 2; ++ks) { unpack8(__builtin_bit_cast(u32x4, Qf[g][ks]), qv[g][ks]);
#pragma unroll
                    for (int e = 0; e < 8; ++e) ssq[g] += qv[g][ks][e] * qv[g][ks][e]; }
                ssq[g] += __shfl_xor(ssq[g], 16); ssq[g] += __shfl_xor(ssq[g], 32);
                ssq[g] = rsqrtf(ssq[g] * (1.0f / 64.0f) + EPS) * (0.125f * 1.4426950408889634f); }
#pragma unroll
            for (int ks = 0; ks < 2; ++ks) {
                const float* wp = p.in[12] + l * 64 + ks * 32 + fq * 8;
                const f32x4 w0 = *(const f32x4*)wp, w1 = *(const f32x4*)(wp + 4);
                const float* cp = (const float*)(p.ws + OFF_AT) + (size_t)((ks ? (qpos & 63) : (qpos >> 6)) * 16 + (fq & 1) * 8) * 2;
                f32x4 cs[4];
                if (isl) {
#pragma unroll
                    for (int q4 = 0; q4 < 4; ++q4) cs[q4] = *(const f32x4*)(cp + 4 * q4); }
#pragma unroll
                for (int g = 0; g < 2; ++g) {
#pragma unroll
                    for (int e = 0; e < 8; ++e) { float v = qv[g][ks][e] * ssq[g] * (e < 4 ? w0[e & 3] : w1[e & 3]);
                        if (isl) { const float o = __shfl_xor(v, 32); const float cc = cs[e >> 1][(e & 1) * 2], sn = cs[e >> 1][(e & 1) * 2 + 1]; v = up ? o * sn + v * cc : v * cc - o * sn; }
                        qv[g][ks][e] = v; }
                    Qf[g][ks] = mk_frag(cvt_pk_bf16(qv[g][ks][0], qv[g][ks][1]), cvt_pk_bf16(qv[g][ks][2], qv[g][ks][3]), cvt_pk_bf16(qv[g][ks][4], qv[g][ks][5]), cvt_pk_bf16(qv[g][ks][6], qv[g][ks][7])); }
            }
        }
        float mrun[2], lrun[2]; f32x4 O[2][4];
#pragma unroll
        for (int g = 0; g < 2; ++g) { mrun[g] = p.in[14][l * 8 + hq0 + g] * 1.4426950408889634f; lrun[g] = fq == 0 ? 1.0f : 0.0f;
#pragma unroll
            for (int dt = 0; dt < 4; ++dt) O[g][dt] = (f32x4){0.f, 0.f, 0.f, 0.f}; }
#define AT_NEXT(T) ((isl && (T) == 1 && n == 15) ? 3 : (T) + 1)
#define AT_LOAD(T) do { const int krow0_ = (T) < 3 ? b * 2048 + (n - 1 + (T)) * 128 : NLAT + b * 256 + ((T) - 3) * 128; \
            _Pragma("unroll") for (int rep = 0; rep < 2; ++rep) { const int pi = tid + 512 * rep; \
                pk[rep] = *(const u32x4*)(Z + (size_t)(krow0_ + (pi >> 3)) * ZM + C_AK + kvh * 64 + (pi & 7) * 8); \
                pv[rep] = *(const u32x4*)(Z + (size_t)(krow0_ + (pi >> 3)) * ZM + C_AV + kvh * 64 + (pi & 7) * 8); } } while (0)
#define AT_WRITE(BUF) do { _Pragma("unroll") for (int rep = 0; rep < 2; ++rep) { const int pi = tid + 512 * rep; \
                *(LAS u32x4*)(Kl0 + (BUF) * 36864 + (pi >> 3) * 144 + (pi & 7) * 16) = pk[rep]; \
                *(LAS u32x4*)(Kl0 + (BUF) * 36864 + 18432 + (pi >> 3) * 144 + (pi & 7) * 16) = pv[rep]; } } while (0)
        int t = isl ? (n > 0 ? 0 : 1) : 3, buf = 0;
        u32x4 pk[2], pv[2];
        AT_LOAD(t);
        __syncthreads();
        AT_WRITE(0);
        { const int t1 = AT_NEXT(t); if (t1 < 5) AT_LOAD(t1); }
        while (t < 5) {
            const int tn = AT_NEXT(t);
            const int msgn = t == 0 ? 1 : (t == 2 ? -1 : 0);
            const int dbase = 4 * fq - ii;
            __syncthreads();
            if (tn < 5) { AT_WRITE(buf ^ 1); const int tnn = AT_NEXT(tn); if (tnn < 5) AT_LOAD(tnn); }
            LAS unsigned char* Kl = Kl0 + buf * 36864; LAS unsigned char* Vl = Kl + 18432;
            const int jlo = msgn > 0 ? wave : 0, jhi = msgn < 0 ? wave : 7;
            f32x4 sc[2][8];
#pragma unroll
            for (int jt = 0; jt < 8; ++jt) {
                if (jt < jlo || jt > jhi) { sc[0][jt] = (f32x4){-INFINITY, -INFINITY, -INFINITY, -INFINITY}; sc[1][jt] = sc[0][jt]; continue; }
                sc[0][jt] = (f32x4){0.f, 0.f, 0.f, 0.f}; sc[1][jt] = (f32x4){0.f, 0.f, 0.f, 0.f};
#pragma unroll
                for (int ks = 0; ks < 2; ++ks) { const bf16x8 kf = *(const LAS bf16x8*)(Kl + (jt * 16 + fr) * 144 + ks * 64 + fq * 16);
                    sc[0][jt] = MFMA16(kf, Qf[0][ks], sc[0][jt]); sc[1][jt] = MFMA16(kf, Qf[1][ks], sc[1][jt]); } }
#pragma unroll
            for (int g = 0; g < 2; ++g) {
                float mx = mrun[g];
                if (msgn != 0) {
#pragma unroll
                    for (int jt = 0; jt < 8; ++jt)
#pragma unroll
                        for (int i = 0; i < 4; ++i) { const int d = msgn * (dbase + jt * 16 + i); sc[g][jt][i] = d >= 0 ? sc[g][jt][i] : -INFINITY; }
                }
#pragma unroll
                for (int jt = 0; jt < 8; ++jt) { mx = fmaxf(fmaxf(mx, sc[g][jt][0]), sc[g][jt][1]); mx = fmaxf(fmaxf(mx, sc[g][jt][2]), sc[g][jt][3]); }
                mx = fmaxf(mx, __shfl_xor(mx, 16)); mx = fmaxf(mx, __shfl_xor(mx, 32));
                if (__builtin_amdgcn_ballot_w64(mx - mrun[g] > 8.0f) != 0ull) {
                    const float alpha = __builtin_amdgcn_exp2f(mrun[g] - mx); mrun[g] = mx; lrun[g] *= alpha;
#pragma unroll
                    for (int dt = 0; dt < 4; ++dt) O[g][dt] *= alpha;
                }
                const float mref = mrun[g];
                float ps = 0.f;
#pragma unroll
                for (int jt = 0; jt < 8; ++jt)
#pragma unroll
                    for (int i = 0; i < 4; ++i) { const float e = __builtin_amdgcn_exp2f(sc[g][jt][i] - mref); sc[g][jt][i] = e; ps += e; }
                lrun[g] += ps;
            }
#pragma unroll
            for (int sI = 0; sI < 4; ++sI) {
                if (2 * sI + 1 < jlo || 2 * sI > jhi) continue;
                const bf16x8 pf0 = mk_frag(cvt_pk_bf16(sc[0][2 * sI][0], sc[0][2 * sI][1]), cvt_pk_bf16(sc[0][2 * sI][2], sc[0][2 * sI][3]), cvt_pk_bf16(sc[0][2 * sI + 1][0], sc[0][2 * sI + 1][1]), cvt_pk_bf16(sc[0][2 * sI + 1][2], sc[0][2 * sI + 1][3]));
                const bf16x8 pf1 = mk_frag(cvt_pk_bf16(sc[1][2 * sI][0], sc[1][2 * sI][1]), cvt_pk_bf16(sc[1][2 * sI][2], sc[1][2 * sI][3]), cvt_pk_bf16(sc[1][2 * sI + 1][0], sc[1][2 * sI + 1][1]), cvt_pk_bf16(sc[1][2 * sI + 1][2], sc[1][2 * sI + 1][3]));
#pragma unroll
                for (int dt = 0; dt < 4; ++dt) {
                    const bf16x8 vf = tr_frag(Vl, 144, (2 * sI) * 16 + 4 * fq, (2 * sI + 1) * 16 + 4 * fq, dt * 16, fr);
                    O[0][dt] = MFMA16(vf, pf0, O[0][dt]); O[1][dt] = MFMA16(vf, pf1, O[1][dt]); }
            }
            t = tn; buf ^= 1;
        }
#undef AT_NEXT
#undef AT_LOAD
#undef AT_WRITE
#pragma unroll
        for (int g = 0; g < 2; ++g) { float lt = lrun[g]; lt += __shfl_xor(lt, 16); lt += __shfl_xor(lt, 32); const float inv = 1.0f / lt;
#pragma unroll
            for (int dt = 0; dt < 4; ++dt) { u32x2 w; w.x = cvt_pk_bf16(O[g][dt][0] * inv, O[g][dt][1] * inv); w.y = cvt_pk_bf16(O[g][dt][2] * inv, O[g][dt][3] * inv);
                *(u32x2*)(YB + (size_t)(qrow0 + ii) * 1536 + 1024 + (hq0 + g) * 64 + dt * 16 + 4 * fq) = w; } }
    }
    __syncthreads();
}

DEVI void ph_ret_state(const int wv, const Params& p, int l, unsigned char* lds_raw) {
    const int tid = opaque_tid(wv), lane = tid & 63, wave = wv, fr = lane & 15, fq = lane >> 4;
    LAS unsigned char* Kt = (LAS unsigned char*)lds_raw;
    const bf16_t* Z = (const bf16_t*)(p.ws + OFF_ZG); bf16_t* RS = (bf16_t*)(p.ws + OFF_RS);
    for (int it = blockIdx.x; it < 256; it += gridDim.x) {
        const int b = it >> 4, h = (it >> 2) & 3, dir = (it >> 1) & 1, half = it & 1;
        const float e_ = p.in[9][(l * 2 + dir) * 4 + h];
        const float lg2 = log1pf(-exp2f(-e_)) * 1.4426950408889634f;
        const float gC = exp2f(128.0f * lg2);
        f32x4 R[2]; R[0] = (f32x4){0.f, 0.f, 0.f, 0.f}; R[1] = R[0];
        const int j0 = tid >> 3, g80 = tid & 7;
        const float wj0 = exp2f((float)(dir == 0 ? 127 - j0 : j0) * lg2), wj1 = exp2f((float)(dir == 0 ? 63 - j0 : j0 + 64) * lg2);
        u32x4 kwr[2], vwr[2];
#define RS_LOAD(N) do { const int c_ = dir == 0 ? (N) : ((N) < 2 ? 1 - (N) : 19 - (N)); const int r_ = c_ < 2 ? NLAT + b * 256 + c_ * 128 : b * 2048 + (c_ - 2) * 128; \
            _Pragma("unroll") for (int rep = 0; rep < 2; ++rep) { const int jr = j0 + 64 * rep; \
                kwr[rep] = *(const u32x4*)(Z + (size_t)(r_ + jr) * ZM + C_RK + h * 64 + g80 * 8); \
                vwr[rep] = *(const u32x4*)(Z + (size_t)(r_ + jr) * ZM + C_RV + h * 128 + half * 64 + g80 * 8); } } while (0)
#define RS_WRITE(BUF) do { _Pragma("unroll") for (int rep = 0; rep < 2; ++rep) { const int jr = j0 + 64 * rep; const float wj = rep ? wj1 : wj0; const u32x4 kw = kwr[rep]; \
                u32x4 ks; ks.x = cvt_pk_bf16(bflo(kw.x) * wj, bfhi(kw.x) * wj); ks.y = cvt_pk_bf16(bflo(kw.y) * wj, bfhi(kw.y) * wj); ks.z = cvt_pk_bf16(bflo(kw.z) * wj, bfhi(kw.z) * wj); ks.w = cvt_pk_bf16(bflo(kw.w) * wj, bfhi(kw.w) * wj); \
                *(LAS u32x4*)(Kt + (BUF) * 36864 + jr * 144 + g80 * 16) = ks; *(LAS u32x4*)(Kt + (BUF) * 36864 + 18432 + jr * 144 + g80 * 16) = vwr[rep]; } } while (0)
        RS_LOAD(0);
        __syncthreads();
        RS_WRITE(0);
        RS_LOAD(1);
        int buf = 0;
        for (int n = 0; n < 18; ++n) {
            const int cid = dir == 0 ? n : (n < 2 ? 1 - n : 19 - n);
#pragma unroll
            for (int tt = 0; tt < 2; ++tt) { const int t = wave * 2 + tt, dkt = t >> 2, dvt = t & 3;
                u32x2 w; w.x = cvt_pk_bf16(R[tt][0], R[tt][1]); w.y = cvt_pk_bf16(R[tt][2], R[tt][3]);
                *(u32x2*)(RS + ((size_t)((b * 4 + h) * 18 + cid) * 128 + half * 64 + dvt * 16 + fr) * 128 + dir * 64 + dkt * 16 + 4 * fq) = w; }
            if (n == 17) break;
            __syncthreads();
            if (n + 1 < 17) { RS_WRITE(buf ^ 1); if (n + 2 < 17) RS_LOAD(n + 2); }
            LAS unsigned char* Kb = Kt + buf * 36864; LAS unsigned char* Vb = Kb + 18432;
#pragma unroll
            for (int tt = 0; tt < 2; ++tt) { const int t = wave * 2 + tt, dkt = t >> 2, dvt = t & 3;
                f32x4 u = (f32x4){0.f, 0.f, 0.f, 0.f};
#pragma unroll
                for (int ks = 0; ks < 4; ++ks) { const bf16x8 xf = tr_frag(Kb, 144, ks * 32 + 8 * fq, ks * 32 + 8 * fq + 4, dkt * 16, fr), yf = tr_frag(Vb, 144, ks * 32 + 8 * fq, ks * 32 + 8 * fq + 4, dvt * 16, fr); u = MFMA16(xf, yf, u); }
                R[tt] = R[tt] * gC + u; }
            buf ^= 1;
        }
#undef RS_LOAD
#undef RS_WRITE
        __syncthreads();
    }
}

DEVI void ph_ret_out(const int wv, const Params& p, int l, unsigned char* lds_raw) {
    const int tid = opaque_tid(wv), lane = tid & 63, wave = wv, fr = lane & 15, fq = lane >> 4;
    LAS unsigned char* Kl = (LAS unsigned char*)lds_raw;
    LAS unsigned char* Ql = Kl + 18432;
    LAS unsigned char* Vt = Ql + 18432;
    LAS unsigned char* Rl = Vt + 36864;
    const bf16_t* Z = (const bf16_t*)(p.ws + OFF_ZG); const bf16_t* RS = (const bf16_t*)(p.ws + OFF_RS); bf16_t* YB = (bf16_t*)(p.ws + OFF_YB);
    const int nch = l == 0 ? 18 : 16, nitems = 64 * nch;
    u32x4 pk[2], pq[2], pr[4], pvv[4];
#define RO_LOAD(IT) do { const int bh_ = (IT) / nch, ci_ = (IT) - bh_ * nch, b_ = bh_ >> 2, h_ = bh_ & 3, cid_ = l == 0 ? ci_ : ci_ + 2; \
        const int row0_ = cid_ < 2 ? NLAT + b_ * 256 + cid_ * 128 : b_ * 2048 + (cid_ - 2) * 128; \
        _Pragma("unroll") for (int rep = 0; rep < 2; ++rep) { const int pi = tid + 512 * rep, r = pi >> 3, g8 = pi & 7; \
            pk[rep] = *(const u32x4*)(Z + (size_t)(row0_ + r) * ZM + C_RK + h_ * 64 + g8 * 8); pq[rep] = *(const u32x4*)(Z + (size_t)(row0_ + r) * ZM + C_RQ + h_ * 64 + g8 * 8); } \
        _Pragma("unroll") for (int rep = 0; rep < 4; ++rep) { const int pi = tid + 512 * rep; \
            pr[rep] = *(const u32x4*)(RS + ((size_t)(bh_ * 18 + cid_) * 128 + (pi >> 4)) * 128 + (pi & 15) * 8); \
            pvv[rep] = *(const u32x4*)(Z + (size_t)(row0_ + (pi >> 4)) * ZM + C_RV + h_ * 128 + (pi & 15) * 8); } } while (0)
    if ((int)blockIdx.x < nitems) RO_LOAD((int)blockIdx.x);
    for (int it = blockIdx.x; it < nitems; it += gridDim.x) {
        const int bh = it / nch, ci = it - bh * nch, b = bh >> 2, h = bh & 3, cid = l == 0 ? ci : ci + 2;
        const int row0 = cid < 2 ? NLAT + b * 256 + cid * 128 : b * 2048 + (cid - 2) * 128;
        const float lgf = log1pf(-exp2f(-p.in[9][(l * 2 + 0) * 4 + h])) * 1.4426950408889634f, lgb = log1pf(-exp2f(-p.in[9][(l * 2 + 1) * 4 + h])) * 1.4426950408889634f;
        __syncthreads();
#pragma unroll
        for (int rep = 0; rep < 2; ++rep) { const int pi = tid + 512 * rep, r = pi >> 3, g8 = pi & 7;
            *(LAS u32x4*)(Kl + r * 144 + g8 * 16) = pk[rep]; *(LAS u32x4*)(Ql + r * 144 + g8 * 16) = pq[rep]; }
#pragma unroll
        for (int rep = 0; rep < 4; ++rep) { const int pi = tid + 512 * rep;
            *(LAS u32x4*)(Rl + (pi >> 4) * 272 + (pi & 15) * 16) = pr[rep];
            *(LAS u32x4*)(Vt + (pi >> 4) * 288 + (pi & 15) * 16) = pvv[rep]; }
        __syncthreads();
        if (it + (int)gridDim.x < nitems) RO_LOAD(it + (int)gridDim.x);
        const int ii = wave * 16 + fr;
        bf16x8 Qf[2];
#pragma unroll
        for (int ks = 0; ks < 2; ++ks) Qf[ks] = *(const LAS bf16x8*)(Ql + ii * 144 + ks * 64 + fq * 16);
        if (cid >= 2) {
            const float* cp = (const float*)(p.ws + OFF_RT) + (size_t)(((row0 + ii) & 2047) * 32 + fq * 8) * 2;
            float x1[8], x2[8]; unpack8(__builtin_bit_cast(u32x4, Qf[0]), x1); unpack8(__builtin_bit_cast(u32x4, Qf[1]), x2);
            float y1[8], y2[8];
#pragma unroll
            for (int q4 = 0; q4 < 4; ++q4) { const f32x4 cs = *(const f32x4*)(cp + 4 * q4);
                y1[2 * q4] = x1[2 * q4] * cs[0] - x2[2 * q4] * cs[1]; y2[2 * q4] = x1[2 * q4] * cs[1] + x2[2 * q4] * cs[0];
                y1[2 * q4 + 1] = x1[2 * q4 + 1] * cs[2] - x2[2 * q4 + 1] * cs[3]; y2[2 * q4 + 1] = x1[2 * q4 + 1] * cs[3] + x2[2 * q4 + 1] * cs[2]; }
            Qf[0] = mk_frag(cvt_pk_bf16(y1[0], y1[1]), cvt_pk_bf16(y1[2], y1[3]), cvt_pk_bf16(y1[4], y1[5]), cvt_pk_bf16(y1[6], y1[7]));
            Qf[1] = mk_frag(cvt_pk_bf16(y2[0], y2[1]), cvt_pk_bf16(y2[2], y2[3]), cvt_pk_bf16(y2[4], y2[5]), cvt_pk_bf16(y2[6], y2[7]));
        }
        f32x4 sc[8];
#pragma unroll
        for (int jt = 0; jt < 8; ++jt) { sc[jt] = (f32x4){0.f, 0.f, 0.f, 0.f};
#pragma unroll
            for (int ks = 0; ks < 2; ++ks) { const bf16x8 kf = *(const LAS bf16x8*)(Kl + (jt * 16 + fr) * 144 + ks * 64 + fq * 16); sc[jt] = MFMA16(kf, Qf[ks], sc[jt]); } }
#pragma unroll
        for (int jt = 0; jt < 8; ++jt)
#pragma unroll
            for (int i = 0; i < 4; ++i) { const int d = ii - (jt * 16 + 4 * fq + i); const float f = __builtin_amdgcn_exp2f(d > 0 ? (float)d * lgf : (float)(-d) * lgb); sc[jt][i] *= (d == 0 ? 2.0f : f); }
        f32x4 Y[8];
#pragma unroll
        for (int dt = 0; dt < 8; ++dt) Y[dt] = (f32x4){0.f, 0.f, 0.f, 0.f};
#pragma unroll
        for (int sI = 0; sI < 4; ++sI) {
            const bf16x8 pf = mk_frag(cvt_pk_bf16(sc[2 * sI][0], sc[2 * sI][1]), cvt_pk_bf16(sc[2 * sI][2], sc[2 * sI][3]), cvt_pk_bf16(sc[2 * sI + 1][0], sc[2 * sI + 1][1]), cvt_pk_bf16(sc[2 * sI + 1][2], sc[2 * sI + 1][3]));
#pragma unroll
            for (int dt = 0; dt < 8; ++dt) {
                Y[dt] = MFMA16(tr_frag(Vt, 288, (2 * sI) * 16 + 4 * fq, (2 * sI + 1) * 16 + 4 * fq, dt * 16, fr), pf, Y[dt]); }
        }
        u32x2 gwv[8];
#pragma unroll
        for (int dt = 0; dt < 8; ++dt) gwv[dt] = *(const u32x2*)(Z + (size_t)(row0 + ii) * ZM + C_RG + h * 128 + dt * 16 + 4 * fq);
        const float xf = __builtin_amdgcn_exp2f((float)(ii + 1) * lgf), xb = __builtin_amdgcn_exp2f((float)(128 - ii) * lgb);
#pragma unroll
        for (int ks = 0; ks < 4; ++ks) {
            const u32x4 qw = __builtin_bit_cast(u32x4, Qf[ks & 1]); const float xs = ks < 2 ? xf : xb;
            const bf16x8 qs = mk_frag(cvt_pk_bf16(bflo(qw.x) * xs, bfhi(qw.x) * xs), cvt_pk_bf16(bflo(qw.y) * xs, bfhi(qw.y) * xs), cvt_pk_bf16(bflo(qw.z) * xs, bfhi(qw.z) * xs), cvt_pk_bf16(bflo(qw.w) * xs, bfhi(qw.w) * xs));
#pragma unroll
            for (int dt = 0; dt < 8; ++dt) { const bf16x8 rf = *(const LAS bf16x8*)(Rl + (dt * 16 + fr) * 272 + ks * 64 + fq * 16); Y[dt] = MFMA16(rf, qs, Y[dt]); }
        }
        float ss = 0.f;
#pragma unroll
        for (int dt = 0; dt < 8; ++dt) ss += Y[dt][0] * Y[dt][0] + Y[dt][1] * Y[dt][1] + Y[dt][2] * Y[dt][2] + Y[dt][3] * Y[dt][3];
        ss += __shfl_xor(ss, 16); ss += __shfl_xor(ss, 32);
        const float rstd = rsqrtf(ss * (1.0f / 128.0f) + EPS);
#pragma unroll
        for (int dt = 0; dt < 8; ++dt) {
            const u32x2 gw = gwv[dt];
            const float g0 = bflo(gw.x), g1 = bfhi(gw.x), g2 = bflo(gw.y), g3 = bfhi(gw.y);
            u32x2 w; w.x = cvt_pk_bf16(g0 * sigmoidf_(g0) * Y[dt][0] * rstd, g1 * sigmoidf_(g1) * Y[dt][1] * rstd); w.y = cvt_pk_bf16(g2 * sigmoidf_(g2) * Y[dt][2] * rstd, g3 * sigmoidf_(g3) * Y[dt][3] * rstd);
            *(u32x2*)(YB + (size_t)(row0 + ii) * 1536 + h * 128 + dt * 16 + 4 * fq) = w; }
    }
#undef RO_LOAD
    __syncthreads();
}

#ifndef ATT_MFMA
#define ATT_MFMA 1
#endif
#ifndef RET_MFMA
#define RET_MFMA 1
#endif
constexpr int NPL = 10;
constexpr int NPH = 1 + 2 * NPL;

__global__ void __launch_bounds__(NTHREADS) mega(Params p) {
    extern __shared__ __attribute__((aligned(16))) unsigned char lds_raw[];
    cg::grid_group grid = cg::this_grid();
    const int wv = __builtin_amdgcn_readfirstlane(threadIdx.x >> 6);
    LAS unsigned char* lds = (LAS unsigned char*)lds_raw;
    const int G = gridDim.x, c = blockIdx.x;
    const int lo = p.ph_lo, hi = p.ph_hi;
    if (hi < 0) grid.sync();
    XcdBarrier xb; xb.bar = (unsigned*)(p.ws + OFF_BAR); xb.x = xb_xcc_id(); xb.st = (volatile LAS unsigned*)(lds + LDS_BYTES);
    { const int t0 = opaque_tid(wv); if (t0 == 0) { xb.st[0] = 0u; xb.st[1] = 0u; } __syncthreads(); if (t0 == 0) (void)xb_add(&xb.bar[XB_XCNT(xb.x)], 1u); }
    bf16_t* WB = (bf16_t*)(p.ws + OFF_WB);
    bf16_t* ZG = (bf16_t*)(p.ws + OFF_ZG); bf16_t* YB = (bf16_t*)(p.ws + OFF_YB); bf16_t* UB = (bf16_t*)(p.ws + OFF_UB);
#ifndef DUPMASK
#define DUPMASK 0
#endif
#define PHASE(ph, ...) if ((ph) >= lo && (ph) < hi) { __VA_ARGS__; if ((ph) + 1 < hi) xcd_barrier(xb, wv); }
#define PHASED(flag, ph, ...) if ((ph) >= lo && (ph) < hi) { __VA_ARGS__; if (DUPMASK & (flag)) { xcd_barrier(xb, wv); __VA_ARGS__; } if ((ph) + 1 < hi) xcd_barrier(xb, wv); }
    PHASED(64, 0, ph_setup(wv, p, lds_raw); __syncthreads(); ph_convert(wv, p, 0, lds_raw, 3, 0))
#pragma unroll 1
    for (int l = 0; l < 2; ++l) {
        const int b = 1 + l * NPL;
        const int Mrows = l == 0 ? RT_ : NLAT;
        PHASED(1, b + 0, if (l > 0) ph_convert(wv, p, l, lds_raw, 2, 0); ph_norm(wv, p, l, 0, RT_))
        PHASED(2, b + 1, { pg8::Gemm g{UB, WB + W_IN, 1024, 1024, 1024, 0, 0}; pg8::Order S; if (l == 0) S.init(RT_, ZM, G, c, 1); else { S.init(NLAT, ZM, G, c, 1); S.set_tail(NCTX, 4); }     pg8::EpiBf16<0> E{ZG, ZM, nullptr, nullptr, 0}; pg8::gemm_phase(wv, lds, g, S, E); if (l == 0) ph_convert(wv, p, 0, lds_raw, 4, 48); })
        PHASE(b + 2, ph_prep(wv, p, l, Mrows, lds_raw))
        PHASED(4, b + 3, ph_ret_state(wv, p, l, lds_raw); ph_attn(wv, p, l, lds_raw))
        PHASED(8, b + 4, ph_ret_out(wv, p, l, lds_raw))
        PHASED(2, b + 5, { pg8::Gemm g{UB, WB + W_IN + (size_t)ZM * 1024, 1024, 1024, 1024, 0, 0}; pg8::Order S; S.init(Mrows, ZGW, G, c, 1); pg8::EpiBf16<2> E{ZG, ZGW, nullptr, nullptr, 0}; pg8::gemm_phase(wv, lds, g, S, E); })
        PHASED(32, b + 6, { pg8::Gemm g{YB, WB + W_BR, 1536, 512, 512, 512 * 2, (size_t)1024 * 512 * 2}; pg8::Order S; S.init(Mrows, 1024, G, c, 3); pg8::EpiMerge E{ZG, UB}; pg8::gemm_phase(wv, lds, g, S, E); if (l == 0) ph_shw(wv, p, 0, lds_raw, 64); })
        PHASE(b + 7, { pg8::Gemm g{UB, WB + W_O, 1024, 1024, 1024, 0, 0}; pg8::Order S; S.init(Mrows, 1024, G, c, 1); pg8::EpiRes E{p, l, 2048, 0, 1}; pg8::gemm_phase(wv, lds, g, S, E); })
        PHASED(16, b + 8, { pg8::Gemm g{(const bf16_t*)(p.ws + OFF_U2), WB + W_1, 1024, 1024, 1024, 0, 0}; pg8::Order S; S.init(Mrows, HID, G, c, 1); pg8::EpiBf16<1, true> E{(bf16_t*)(p.ws + OFF_H), HID, (const float*)(p.ws + OFF_SSQ2) + (size_t)l * RT_, (const float*)(p.ws + OFF_SHW2) + (size_t)l * 17 * 4096, 4096}; pg8::gemm_phase(wv, lds, g, S, E); })
        PHASE(b + 9, { pg8::Gemm g{(const bf16_t*)(p.ws + OFF_H), WB + W_2, HID, HID, HID, 0, 0}; pg8::Order S; S.init(Mrows, 1024, G, c, 1); pg8::EpiRes E{p, l, 5120, 1, 0}; pg8::gemm_phase(wv, lds, g, S, E); if (l == 0) { ph_convert(wv, p, 1, lds_raw, 1, 64); ph_shw(wv, p, 1, lds_raw, 64); } })
    }
    if (DUPMASK & 128) { for (int i = 0; i < 20; ++i) xcd_barrier(xb, wv); }
#undef PHASE
#undef PHASED
}

#ifndef MULTI_LAUNCH
#define MULTI_LAUNCH 0
#endif

extern "C" void kernel_launch(void* const* d_in, const int* in_sizes, int n_in, void* d_out, int out_size, void* d_ws, size_t ws_size, hipStream_t stream) {
    static int grid = 0;
    if (grid == 0) {
        if (ws_size < WS_END) { fprintf(stderr, "kernel_launch: workspace too small: %zu < %zu\n", ws_size, (size_t)WS_END); grid = -1; return; }
        int dev = 0, cus = 0, per_cu = 0;
        hipGetDevice(&dev);
        hipDeviceGetAttribute(&cus, hipDeviceAttributeMultiprocessorCount, dev);
        if (hipFuncSetAttribute((const void*)mega, hipFuncAttributeMaxDynamicSharedMemorySize, LDS_TOTAL) != hipSuccess) { fprintf(stderr, "kernel_launch: hipFuncSetAttribute failed\n"); grid = -1; return; }
        if (hipOccupancyMaxActiveBlocksPerMultiprocessor(&per_cu, (const void*)mega, NTHREADS, LDS_TOTAL) != hipSuccess || per_cu < 1) { fprintf(stderr, "kernel_launch: occupancy query gave %d\n", per_cu); per_cu = 1; }
        (void)hipGetLastError();
        grid = cus * per_cu;
        fprintf(stderr, "kernel_launch: grid %d (cus %d x %d)\n", grid, cus, per_cu);
    }
    if (grid < 0) return;
    if (hipMemsetAsync((char*)d_ws + OFF_BAR, 0, BAR_BYTES, stream) != hipSuccess) { fprintf(stderr, "kernel_launch: memset of barrier words failed\n"); return; }
    Params p{};
    for (int i = 0; i < 21; ++i) p.in[i] = (const float*)d_in[i];
    p.out = (float*)d_out; p.ws = (unsigned char*)d_ws;
#if MULTI_LAUNCH
    for (int ph = 0; ph < NPH; ++ph) {
        p.ph_lo = ph; p.ph_hi = ph + 1;
        hipLaunchKernelGGL(mega, dim3(grid), dim3(NTHREADS), LDS_TOTAL, stream, p);
    }
#else
    p.ph_lo = 0; p.ph_hi = NPH;
    void* args[] = {&p};
    hipError_t e = hipLaunchCooperativeKernel((const void*)mega, dim3(grid), dim3(NTHREADS), args, LDS_TOTAL, stream);
    if (e != hipSuccess) fprintf(stderr, "cooperative launch failed: %s (grid %d)\n", hipGetErrorString(e), grid);
#endif
}
```
